# Optimizing an MI355X kernel written in HIP

```python
import jax
import jax.numpy as jnp
from jax import lax
import numpy as np

D_MODEL = 1024
BATCH = 2
SEQ = 8192
DEPTH = 2

GRID_W = 64
CTX_LEN = 256
EPS = 1e-6
D_FF = 4 * D_MODEL
N_MOD = 6

NA_HEADS = 8
NA_HEAD_DIM = D_MODEL // 16
NA_WIDTH = NA_HEADS * NA_HEAD_DIM
NA_KH = 8
NA_KW = 16

LRU_WIDTH = D_MODEL // 2
LRU_HEADS = 8
LRU_BLOCK = LRU_WIDTH // LRU_HEADS
LRU_CONV = 4
LRU_C = 8.0

GLA_HEADS = 4
GLA_DK = D_MODEL // 16
GLA_DV = D_MODEL // 8
GLA_KEY = GLA_HEADS * GLA_DK
GLA_VAL = GLA_HEADS * GLA_DV
GLA_RANK = 16
GLA_TAU = 16.0
GLA_CHUNK = 64

GQA_HEADS = 8
GQA_KV_HEADS = 2
GQA_HEAD_DIM = D_MODEL // 16
GQA_Q = GQA_HEADS * GQA_HEAD_DIM
GQA_KV = GQA_KV_HEADS * GQA_HEAD_DIM
Q_BLOCK = 128
ROPE_THETA = 10000.0

EVEN_IN = 3 * NA_WIDTH + 2 * LRU_WIDTH
EVEN_SPLITS = (NA_WIDTH, 2 * NA_WIDTH, 3 * NA_WIDTH, 3 * NA_WIDTH + LRU_WIDTH)
ODD_IN = 2 * GLA_KEY + 2 * GLA_VAL + 2 * GLA_RANK + GQA_Q + 2 * GQA_KV
ODD_SPLITS = (GLA_KEY, 2 * GLA_KEY, 2 * GLA_KEY + GLA_VAL, 2 * GLA_KEY + 2 * GLA_VAL,
              2 * GLA_KEY + 2 * GLA_VAL + 2 * GLA_RANK,
              2 * GLA_KEY + 2 * GLA_VAL + 2 * GLA_RANK + GQA_Q,
              2 * GLA_KEY + 2 * GLA_VAL + 2 * GLA_RANK + GQA_Q + GQA_KV)

kernel_name = 'hybrid_natten_rglru_gla_gqa_prefix'

F32 = jnp.float32


def rms_norm(x, w):
    xf = x.astype(F32)
    y = xf * lax.rsqrt(jnp.mean(xf * xf, axis=-1, keepdims=True) + EPS)
    return (y * w.astype(F32)).astype(x.dtype)


def modulate(x, shift, scale):
    return x * (1.0 + scale) + shift


def _split_heads(t, n_heads):
    return t.reshape(*t.shape[:-1], n_heads, t.shape[-1] // n_heads)


def _flip(t, direction):
    return t[:, ::-1] if direction else t


def squared_relu_mlp(u, w1, w2):
    return jnp.square(jax.nn.relu(u @ w1)) @ w2


def _rope_1d(x, pos):
    f = x.shape[-1] // 2
    inv = ROPE_THETA ** (-jnp.arange(f, dtype=F32) / f)
    ang = pos.astype(F32)[:, None] * inv[None, :]
    cos = jnp.cos(ang)[None, :, None, :]
    sin = jnp.sin(ang)[None, :, None, :]
    x1 = x[..., :f].astype(F32)
    x2 = x[..., f:].astype(F32)
    return jnp.concatenate([x1 * cos - x2 * sin, x2 * cos + x1 * sin], axis=-1)


def rope_2d(x, pos_row, pos_col):
    half = x.shape[-1] // 2
    return jnp.concatenate([_rope_1d(x[..., :half], pos_row),
                            _rope_1d(x[..., half:], pos_col)], axis=-1).astype(x.dtype)


def neighbourhood_attention(q_c, k_c, v_c, q_l, k_l, v_l, rpb, need_ctx):
    bsz, s, h, dh = q_l.shape
    rows = s // GRID_W
    kh = min(NA_KH, rows)
    scale = dh ** -0.5
    kg = k_l.reshape(bsz, rows, GRID_W, h, dh)
    vg = v_l.reshape(bsz, rows, GRID_W, h, dh)
    cols = jnp.arange(GRID_W)
    col_start = jnp.clip(cols - NA_KW // 2, 0, GRID_W - NA_KW)
    col_valid = (cols[None, :] >= col_start[:, None]) & (cols[None, :] < col_start[:, None] + NA_KW)
    d_col = jnp.clip(cols[None, :] - cols[:, None], 1 - NA_KW, NA_KW - 1) + (NA_KW - 1)

    def row_block(args):
        q_row, r = args
        start = jnp.clip(r - kh // 2, 0, rows - kh)
        k_rows = lax.dynamic_slice_in_dim(kg, start, kh, axis=1)
        v_rows = lax.dynamic_slice_in_dim(vg, start, kh, axis=1)
        d_row = start + jnp.arange(kh) - r + (NA_KH - 1)
        bias = rpb[:, d_row[None, :, None], d_col[:, None, :]]
        s_loc = jnp.einsum('bwhd,bkvhd->bhwkv', q_row, k_rows).astype(F32) * scale + bias.astype(F32)
        s_loc = jnp.where(col_valid[:, None, :], s_loc, -jnp.inf)
        s_ctx = jnp.einsum('bwhd,bchd->bhwc', q_row, k_c).astype(F32) * scale
        n_loc = kh * GRID_W
        p = jax.nn.softmax(jnp.concatenate([s_loc.reshape(bsz, h, GRID_W, n_loc), s_ctx], axis=-1), axis=-1)
        p = p.astype(v_l.dtype)
        p_loc = p[..., :n_loc].reshape(bsz, h, GRID_W, kh, GRID_W)
        return (jnp.einsum('bhwkv,bkvhd->bwhd', p_loc, v_rows)
                + jnp.einsum('bhwc,bchd->bwhd', p[..., n_loc:], v_c))

    q_rows = jnp.moveaxis(q_l.reshape(bsz, rows, GRID_W, h, dh), 1, 0)
    o = lax.map(row_block, (q_rows, jnp.arange(rows)))
    o_l = jnp.moveaxis(o, 0, 1).reshape(bsz, s, h * dh)
    o_c = None
    if need_ctx:
        sc = jnp.einsum('bqhd,bkhd->bhqk', q_c, k_c).astype(F32) * scale
        pc = jax.nn.softmax(sc, axis=-1).astype(v_c.dtype)
        o_c = jnp.einsum('bhqk,bkhd->bqhd', pc, v_c).reshape(bsz, q_c.shape[1], h * dh)
    return o_c, o_l


def depthwise_conv_centred(x, w, b):
    k, ch = w.shape
    y = lax.conv_general_dilated(x, w[:, None, :].astype(x.dtype), window_strides=(1,),
                                 padding=[(k // 2, k - 1 - k // 2)],
                                 dimension_numbers=('NWC', 'WIO', 'NWC'),
                                 feature_group_count=ch)
    return y + b


def rglru_gates(x, wa, ba, wx, bx, lam):
    bsz, t, ch = x.shape
    xb = x.reshape(bsz, t, LRU_HEADS, LRU_BLOCK)
    r = jax.nn.sigmoid((jnp.einsum('bthi,hij->bthj', xb, wa).reshape(bsz, t, ch) + ba).astype(F32))
    i = jax.nn.sigmoid((jnp.einsum('bthi,hij->bthj', xb, wx).reshape(bsz, t, ch) + bx).astype(F32))
    log_a = -LRU_C * r * jax.nn.softplus(-lam.astype(F32))
    a = jnp.exp(log_a)
    b = jnp.sqrt(-jnp.expm1(2.0 * log_a)) * (i * x.astype(F32))
    return a, b


def linear_recurrence(a, b, h0):
    b = b.at[:, 0].add(a[:, 0] * h0)

    def combine(left, right):
        a_l, b_l = left
        a_r, b_r = right
        return a_l * a_r, a_r * b_l + b_r

    _, h = lax.associative_scan(combine, (a, b), axis=1)
    return h


def rglru_mixer(x_c, g_c, x_l, g_l, conv_w, conv_b, wa, ba, wx, bx, lam, need_ctx):
    xc = depthwise_conv_centred(x_c, conv_w, conv_b)
    xl = depthwise_conv_centred(x_l, conv_w, conv_b)
    bsz = x_l.shape[0]
    ys_c, ys_l = [], []
    for d in range(2):
        a_c, b_c = rglru_gates(_flip(xc, d), wa[d], ba[d], wx[d], bx[d], lam[d])
        h_c = linear_recurrence(a_c, b_c, jnp.zeros((bsz, LRU_WIDTH), F32))
        a_l, b_l = rglru_gates(_flip(xl, d), wa[d], ba[d], wx[d], bx[d], lam[d])
        h_l = linear_recurrence(a_l, b_l, h_c[:, -1])
        ys_c.append(_flip(h_c, d))
        ys_l.append(_flip(h_l, d))
    out_l = (ys_l[0] + ys_l[1]).astype(x_l.dtype) * jax.nn.gelu(g_l)
    out_c = (ys_c[0] + ys_c[1]).astype(x_c.dtype) * jax.nn.gelu(g_c) if need_ctx else None
    return out_c, out_l


def even_mixer(u_c, u_l, w_in, rpb, conv_w, conv_b, wa, ba, wx, bx, lam, w_out, need_ctx):
    qc, kc, vc, xc, gc = jnp.split(u_c @ w_in, EVEN_SPLITS, axis=-1)
    ql, kl, vl, xl, gl = jnp.split(u_l @ w_in, EVEN_SPLITS, axis=-1)
    hs = lambda t: _split_heads(t, NA_HEADS)
    na_c, na_l = neighbourhood_attention(hs(qc), hs(kc), hs(vc), hs(ql), hs(kl), hs(vl), rpb, need_ctx)
    lru_c, lru_l = rglru_mixer(xc, gc, xl, gl, conv_w, conv_b, wa, ba, wx, bx, lam, need_ctx)
    y_l = jnp.concatenate([na_l, lru_l], axis=-1) @ w_out
    y_c = jnp.concatenate([na_c, lru_c], axis=-1) @ w_out if need_ctx else None
    return y_c, y_l


def gla_chunked(q, k, v, log_a, s0):
    bsz, t, h, dk = q.shape
    dv = v.shape[-1]
    n = t // GLA_CHUNK
    rs = lambda z: z.reshape(bsz, n, GLA_CHUNK, h, z.shape[-1]).transpose(1, 0, 3, 2, 4)
    q, k, v, g = rs(q), rs(k), rs(v), rs(log_a)
    b = jnp.cumsum(g, axis=3)
    b_last = b[..., -1:, :]
    q_in = q * jnp.exp(b)
    k_in = k * jnp.exp(-b)
    mask = jnp.tril(jnp.ones((GLA_CHUNK, GLA_CHUNK), dtype=bool))
    att = jnp.where(mask, jnp.einsum('nbhtd,nbhsd->nbhts', q_in, k_in), 0.0)
    o_intra = jnp.einsum('nbhts,nbhsv->nbhtv', att, v)
    u = jnp.einsum('nbhsd,nbhsv->nbhdv', k * jnp.exp(b_last - b), v)
    decay = jnp.exp(b_last[..., 0, :])

    def step(state, inp):
        dec, u_c = inp
        return dec[..., None] * state + u_c, state

    s_final, s_prev = lax.scan(step, s0, (decay, u))
    o = o_intra + jnp.einsum('nbhtd,nbhdv->nbhtv', q_in, s_prev)
    return o.transpose(1, 0, 3, 2, 4).reshape(bsz, t, h, dv), s_final


def gla_mixer(zc, zl, wa2, ba, norm_w, need_ctx):
    def prep(z, d):
        q, k, v, _, lr = z
        qf = _split_heads(q, GLA_HEADS).astype(F32) * (GLA_DK ** -0.5)
        kf = _split_heads(k, GLA_HEADS).astype(F32)
        vf = _split_heads(v, GLA_HEADS).astype(F32)
        lr_d = lr[..., d * GLA_RANK:(d + 1) * GLA_RANK]
        log_a = jax.nn.log_sigmoid((lr_d @ wa2[d] + ba[d]).astype(F32)) / GLA_TAU
        log_a = _split_heads(log_a, GLA_HEADS)
        return _flip(qf, d), _flip(kf, d), _flip(vf, d), _flip(log_a, d)

    bsz = zl[0].shape[0]
    outs_c, outs_l = [], []
    for d in range(2):
        s0 = jnp.zeros((bsz, GLA_HEADS, GLA_DK, GLA_DV), F32)
        o_c, s_ctx = gla_chunked(*prep(zc, d), s0)
        o_l, _ = gla_chunked(*prep(zl, d), s_ctx)
        outs_c.append(_flip(o_c, d))
        outs_l.append(_flip(o_l, d))

    def finish(o, gate):
        o = rms_norm(o.astype(gate.dtype), norm_w) * jax.nn.silu(_split_heads(gate, GLA_HEADS))
        return o.reshape(*o.shape[:-2], GLA_VAL)

    y_l = finish(outs_l[0] + outs_l[1], zl[3])
    y_c = finish(outs_c[0] + outs_c[1], zc[3]) if need_ctx else None
    return y_c, y_l


def gqa_mixer(zc, zl, q_norm_w, k_norm_w, pos_row, pos_col, need_ctx):
    group = GQA_HEADS // GQA_KV_HEADS
    scale = GQA_HEAD_DIM ** -0.5

    def heads(z):
        q, k, v = z
        q = rms_norm(_split_heads(q, GQA_HEADS), q_norm_w)
        k = rms_norm(_split_heads(k, GQA_KV_HEADS), k_norm_w)
        return q, k, _split_heads(v, GQA_KV_HEADS)

    qc, kc, vc = heads(zc)
    ql, kl, vl = heads(zl)
    ql = rope_2d(ql, pos_row, pos_col)
    kl = rope_2d(kl, pos_row, pos_col)
    bsz, s = ql.shape[:2]
    k_all = jnp.concatenate([kc, kl], axis=1)
    v_all = jnp.concatenate([vc, vl], axis=1)

    def to_groups(q):
        return q.reshape(q.shape[0], q.shape[1], GQA_KV_HEADS, group, GQA_HEAD_DIM).transpose(0, 2, 3, 1, 4)

    def attend(q_grp, k, v):
        sc = jnp.einsum('bkgqd,bskd->bkgqs', q_grp, k).astype(F32) * scale
        p = jax.nn.softmax(sc, axis=-1).astype(v.dtype)
        return jnp.einsum('bkgqs,bskd->bkgqd', p, v)

    nb = s // Q_BLOCK
    q_blocks = to_groups(ql).reshape(bsz, GQA_KV_HEADS, group, nb, Q_BLOCK, GQA_HEAD_DIM).transpose(3, 0, 1, 2, 4, 5)
    o = lax.map(lambda qb: attend(qb, k_all, v_all), q_blocks)
    o_l = o.transpose(1, 0, 4, 2, 3, 5).reshape(bsz, s, GQA_Q)
    o_c = None
    if need_ctx:
        oc = attend(to_groups(qc), kc, vc)
        o_c = oc.transpose(0, 3, 1, 2, 4).reshape(bsz, qc.shape[1], GQA_Q)
    return o_c, o_l


def odd_mixer(u_c, u_l, w_in, wa2, ba, gla_norm_w, q_norm_w, k_norm_w, w_out, pos_row, pos_col, need_ctx):
    zc = jnp.split(u_c @ w_in, ODD_SPLITS, axis=-1)
    zl = jnp.split(u_l @ w_in, ODD_SPLITS, axis=-1)
    gla_c, gla_l = gla_mixer(zc[:5], zl[:5], wa2, ba, gla_norm_w, need_ctx)
    gqa_c, gqa_l = gqa_mixer(zc[5:], zl[5:], q_norm_w, k_norm_w, pos_row, pos_col, need_ctx)
    y_l = jnp.concatenate([gla_l, gqa_l], axis=-1) @ w_out
    y_c = jnp.concatenate([gla_c, gqa_c], axis=-1) @ w_out if need_ctx else None
    return y_c, y_l


def setup_inputs(seed: int = 0) -> dict:
    key = jax.random.key(seed)
    keys = jax.random.split(key, 32)
    counter = iter(range(32))
    n_even = (DEPTH + 1) // 2
    n_odd = DEPTH // 2

    def nrm(shape, scale):
        return scale * jax.random.normal(keys[next(counter)], shape, F32)

    def gain(shape):
        return 1.0 + 0.1 * jax.random.normal(keys[next(counter)], shape, F32)

    a_pow = jax.random.uniform(keys[next(counter)], (n_even, 2, LRU_WIDTH), F32, 0.9, 0.999)
    a = a_pow ** (1.0 / LRU_C)
    lru_lambda = jnp.log(a) - jnp.log1p(-a)
    return {
        'x': nrm((BATCH, SEQ, D_MODEL), 1.0),
        'c': nrm((BATCH, D_MODEL), 1.0),
        'ctx': nrm((BATCH, CTX_LEN, D_MODEL), 1.0),
        'c_ctx': nrm((D_MODEL,), 0.5),
        'norm1_w': gain((DEPTH, D_MODEL)),
        'norm2_w': gain((DEPTH, D_MODEL)),
        'w_mod': nrm((DEPTH, D_MODEL, N_MOD * D_MODEL), 0.5 * D_MODEL ** -0.5),
        'b_mod': nrm((DEPTH, N_MOD * D_MODEL), 0.02),
        'w_ff1': nrm((DEPTH, D_MODEL, D_FF), D_MODEL ** -0.5),
        'w_ff2': nrm((DEPTH, D_FF, D_MODEL), D_FF ** -0.5),
        'w_in_even': nrm((n_even, D_MODEL, EVEN_IN), D_MODEL ** -0.5),
        'na_rpb': nrm((n_even, NA_HEADS, 2 * NA_KH - 1, 2 * NA_KW - 1), 0.1),
        'lru_conv_w': nrm((n_even, LRU_CONV, LRU_WIDTH), LRU_CONV ** -0.5),
        'lru_conv_b': nrm((n_even, LRU_WIDTH), 0.02),
        'lru_wa': nrm((n_even, 2, LRU_HEADS, LRU_BLOCK, LRU_BLOCK), LRU_BLOCK ** -0.5),
        'lru_ba': nrm((n_even, 2, LRU_WIDTH), 0.02),
        'lru_wx': nrm((n_even, 2, LRU_HEADS, LRU_BLOCK, LRU_BLOCK), LRU_BLOCK ** -0.5),
        'lru_bx': nrm((n_even, 2, LRU_WIDTH), 0.02),
        'lru_lambda': lru_lambda,
        'w_out_even': nrm((n_even, NA_WIDTH + LRU_WIDTH, D_MODEL), (NA_WIDTH + LRU_WIDTH) ** -0.5),
        'w_in_odd': nrm((n_odd, D_MODEL, ODD_IN), D_MODEL ** -0.5),
        'gla_wa2': nrm((n_odd, 2, GLA_RANK, GLA_KEY), GLA_RANK ** -0.5),
        'gla_ba': nrm((n_odd, 2, GLA_KEY), 0.1),
        'gla_norm_w': gain((n_odd, GLA_DV)),
        'gqa_q_norm_w': gain((n_odd, GQA_HEAD_DIM)),
        'gqa_k_norm_w': gain((n_odd, GQA_HEAD_DIM)),
        'w_out_odd': nrm((n_odd, GLA_VAL + GQA_Q, D_MODEL), (GLA_VAL + GQA_Q) ** -0.5),
        'final_norm_w': gain((D_MODEL,)),
    }


def reference(x, c, ctx, c_ctx, norm1_w, norm2_w, w_mod, b_mod, w_ff1, w_ff2,
              w_in_even, na_rpb, lru_conv_w, lru_conv_b, lru_wa, lru_ba, lru_wx, lru_bx, lru_lambda, w_out_even,
              w_in_odd, gla_wa2, gla_ba, gla_norm_w, gqa_q_norm_w, gqa_k_norm_w, w_out_odd, final_norm_w):
    s = x.shape[1]
    t = jnp.arange(s, dtype=jnp.int32)
    pos_row = t // GRID_W
    pos_col = t % GRID_W
    silu_c = jax.nn.silu(c)
    silu_cc = jax.nn.silu(c_ctx)
    h_l, h_c = x, ctx
    for i in range(DEPTH):
        need_ctx = i < DEPTH - 1
        mod_l = jnp.split((silu_c @ w_mod[i] + b_mod[i])[:, None, :], N_MOD, axis=-1)
        mod_c = jnp.split(silu_cc @ w_mod[i] + b_mod[i], N_MOD, axis=-1)
        u_l = modulate(rms_norm(h_l, norm1_w[i]), mod_l[0], mod_l[1])
        u_c = modulate(rms_norm(h_c, norm1_w[i]), mod_c[0], mod_c[1])
        j = i // 2
        if i % 2 == 0:
            y_c, y_l = even_mixer(u_c, u_l, w_in_even[j], na_rpb[j], lru_conv_w[j], lru_conv_b[j],
                                  lru_wa[j], lru_ba[j], lru_wx[j], lru_bx[j], lru_lambda[j],
                                  w_out_even[j], need_ctx)
        else:
            y_c, y_l = odd_mixer(u_c, u_l, w_in_odd[j], gla_wa2[j], gla_ba[j], gla_norm_w[j],
                                 gqa_q_norm_w[j], gqa_k_norm_w[j], w_out_odd[j], pos_row, pos_col, need_ctx)
        h_l = h_l + mod_l[2] * y_l
        h_l = h_l + mod_l[5] * squared_relu_mlp(
            modulate(rms_norm(h_l, norm2_w[i]), mod_l[3], mod_l[4]), w_ff1[i], w_ff2[i])
        if need_ctx:
            h_c = h_c + mod_c[2] * y_c
            h_c = h_c + mod_c[5] * squared_relu_mlp(
                modulate(rms_norm(h_c, norm2_w[i]), mod_c[3], mod_c[4]), w_ff1[i], w_ff2[i])
    return rms_norm(h_l, final_norm_w)
```

```cpp
#include <hip/hip_runtime.h>
#include <hip/hip_cooperative_groups.h>
#include <hip/hip_fp16.h>
#include <cstdio>
#include <cstdint>
namespace cg = cooperative_groups;

#ifndef MEGA
#define MEGA 0
#endif

typedef unsigned short bf16_t;
typedef short bf16x8 __attribute__((ext_vector_type(8)));
typedef short s16x4 __attribute__((ext_vector_type(4)));
typedef float f32x4 __attribute__((ext_vector_type(4)));
typedef float f32x16 __attribute__((ext_vector_type(16)));
typedef unsigned u32x4 __attribute__((ext_vector_type(4)));
typedef unsigned u32x2 __attribute__((ext_vector_type(2)));

constexpr int DM = 1024, NB = 2, SEQ = 8192, CTX = 256, PP = SEQ + CTX, NR = NB * PP;
constexpr float EPS = 1e-6f;
constexpr float LOG2E = 1.4426950408889634f;
constexpr int LDS_BYTES = 71680;
constexpr int NPHASE = 21;

constexpr size_t WS_WFF1 = 0;
constexpr size_t WS_WFF2 = WS_WFF1 + 2ull * 4096 * 1024 * 2;
constexpr size_t WS_WINE = WS_WFF2 + 2ull * 4096 * 1024 * 2;
constexpr size_t WS_WOUTE = WS_WINE + 2560ull * 1024 * 2;
constexpr size_t WS_WINO = WS_WOUTE + 1024ull * 1024 * 2;
constexpr size_t WS_WOUTO = WS_WINO + 2432ull * 1024 * 2;
constexpr size_t WS_WLRU = WS_WOUTO + 1024ull * 1024 * 2;
constexpr size_t WS_MOD = WS_WLRU + 2048ull * 64 * 2;
constexpr size_t WS_ROPE = WS_MOD + 2ull * 3 * 6144 * 4;
constexpr size_t WS_HC = WS_ROPE + 128ull * 16 * 8;
constexpr size_t WS_U = WS_HC + 512ull * 1024 * 4;
constexpr size_t WS_REG = WS_U + (size_t)NR * 1024 * 2;
constexpr size_t R0_Q = WS_REG;
constexpr size_t R0_K = R0_Q + (size_t)NR * 512 * 2;
constexpr size_t R0_VT = R0_K + (size_t)NR * 512 * 2;
constexpr size_t R0_XL = R0_VT + (size_t)NR * 512 * 2;
constexpr size_t R0_GG = R0_XL + (size_t)NR * 512 * 2;
constexpr size_t R0_XC = R0_GG + (size_t)NR * 512 * 2;
constexpr size_t R0_AB = R0_XC + (size_t)NR * 512 * 2;
constexpr size_t R0_SUM = R0_AB + 2ull * NR * 512 * 4;
constexpr size_t R0_END = R0_SUM + 2ull * 2 * 132 * 512 * 8;
constexpr size_t R_FF = WS_REG;
constexpr size_t RFF_END = R_FF + (size_t)NR * 4096 * 2;
constexpr size_t R1_GQ = WS_REG;
constexpr size_t R1_GK = R1_GQ + (size_t)NR * 256 * 2;
constexpr size_t R1_GV = R1_GK + (size_t)NR * 256 * 2;
constexpr size_t R1_GG = R1_GV + (size_t)NR * 512 * 2;
constexpr size_t R1_LR = R1_GG + (size_t)NR * 512 * 2;
constexpr size_t R1_QG = R1_LR + (size_t)NR * 32 * 4;
constexpr size_t R1_KG = R1_QG + (size_t)NR * 512 * 2;
constexpr size_t R1_VTG = R1_KG + (size_t)NR * 128 * 2;
constexpr size_t R1_UC = R1_VTG + (size_t)NR * 128 * 2;
constexpr size_t R1_DEC = R1_UC + 16ull * 132 * 8192 * 4;
constexpr size_t R1_END = R1_DEC + 16ull * 132 * 64 * 4;
constexpr size_t WS_NEED = (R0_END > RFF_END ? (R0_END > R1_END ? R0_END : R1_END) : (RFF_END > R1_END ? RFF_END : R1_END));

struct Params {
    const float *x, *c, *ctx, *c_ctx, *norm1_w, *norm2_w, *w_mod, *b_mod, *w_ff1, *w_ff2;
    const float *w_in_even, *na_rpb, *lru_conv_w, *lru_conv_b, *lru_wa, *lru_ba, *lru_wx, *lru_bx, *lru_lambda, *w_out_even;
    const float *w_in_odd, *gla_wa2, *gla_ba, *gla_norm_w, *gqa_q_norm_w, *gqa_k_norm_w, *w_out_odd, *final_norm_w;
    float* out;
    unsigned char* ws;
    int ph_lo, ph_hi;
};

__device__ __forceinline__ unsigned f2bf(float f) { unsigned u = __float_as_uint(f); u += 0x7fffu + ((u >> 16) & 1u); return u >> 16; }
__device__ __forceinline__ unsigned pack2(float a, float b) { return f2bf(a) | (f2bf(b) << 16); }
__device__ __forceinline__ float bf2f(unsigned h) { return __uint_as_float(h << 16); }
__device__ __forceinline__ float bflo(unsigned w) { return __uint_as_float(w << 16); }
__device__ __forceinline__ float bfhi(unsigned w) { return __uint_as_float(w & 0xffff0000u); }
__device__ __forceinline__ float sigmoidf_(float z) { return 1.f / (1.f + __expf(-z)); }
__device__ __forceinline__ float wave_sum(float v) {
#pragma unroll
    for (int o = 32; o > 0; o >>= 1) v += __shfl_xor(v, o);
    return v;
}
__device__ __forceinline__ int clampi(int v, int lo, int hi) { return v < lo ? lo : (v > hi ? hi : v); }

__device__ void tr_job(float* tile, const float* __restrict__ src, int Nsrc, bf16_t* __restrict__ dst, int K, int Ndst, int mode) {
    const int tid = threadIdx.x;
    const int nkt = K >> 6, ntiles = (Ndst >> 6) * nkt;
    for (int t = blockIdx.x; t < ntiles; t += gridDim.x) {
        const int n0 = (t / nkt) << 6, k0 = (t % nkt) << 6;
        __syncthreads();
        {
            const int n = tid & 63; const int nn = n0 + n; bool valid = true; int on = nn;
            if (mode == 1) { if (nn >= 2336) valid = false; else if (nn >= 2304) on = nn - 2304 + 1536; else if (nn >= 1536) on = nn + 32; }
#pragma unroll
            for (int i = 0; i < 16; ++i) { const int k = i * 4 + (tid >> 6); tile[k * 65 + n] = valid ? src[(size_t)(k0 + k) * Nsrc + on] : 0.f; }
        }
        __syncthreads();
        {
            const int n = tid >> 2, kq = (tid & 3) * 16; unsigned w[8];
#pragma unroll
            for (int j = 0; j < 8; ++j) w[j] = pack2(tile[(kq + 2 * j) * 65 + n], tile[(kq + 2 * j + 1) * 65 + n]);
            u32x4* d = (u32x4*)(dst + (size_t)(n0 + n) * K + k0 + kq);
            d[0] = (u32x4){w[0], w[1], w[2], w[3]}; d[1] = (u32x4){w[4], w[5], w[6], w[7]};
        }
    }
}

__device__ void phase_prologue(const Params& p, char* smem) {
    const int tid = threadIdx.x, bid = blockIdx.x, nblk = gridDim.x;
    unsigned char* ws = p.ws;
    {
        float* sv = (float*)smem; float* red = sv + 3072; float* MOD = (float*)(ws + WS_MOD);
        for (int i = tid; i < 3072; i += 256) { const int j = i >> 10, k = i & 1023; const float v = j < 2 ? p.c[j * 1024 + k] : p.c_ctx[k]; sv[i] = v / (1.f + __expf(-v)); }
        __syncthreads();
        for (int it = bid; it < 192; it += nblk) {
            const int l = it / 96, n0 = (it % 96) * 64, col = tid & 63, kg = tid >> 6;
            const float* w = p.w_mod + (size_t)l * 1024 * 6144 + n0 + col;
            float a0 = 0.f, a1 = 0.f, a2 = 0.f;
#pragma unroll 8
            for (int k = kg * 256; k < kg * 256 + 256; ++k) { const float wv = w[(size_t)k * 6144]; a0 += sv[k] * wv; a1 += sv[1024 + k] * wv; a2 += sv[2048 + k] * wv; }
            red[(kg * 3 + 0) * 64 + col] = a0; red[(kg * 3 + 1) * 64 + col] = a1; red[(kg * 3 + 2) * 64 + col] = a2;
            __syncthreads();
            if (tid < 192) { const int j = tid >> 6, cc = tid & 63;
                const float s = red[(0 * 3 + j) * 64 + cc] + red[(1 * 3 + j) * 64 + cc] + red[(2 * 3 + j) * 64 + cc] + red[(3 * 3 + j) * 64 + cc];
                MOD[(l * 3 + j) * 6144 + n0 + cc] = s + p.b_mod[l * 6144 + n0 + cc]; }
            __syncthreads();
        }
    }
    {
        const int gt = bid * 256 + tid, gn = nblk * 256;
        float2* rope = (float2*)(ws + WS_ROPE);
        for (int i = gt; i < 2048; i += gn) { const int pos = i >> 4, f = i & 15; const float inv = powf(10000.f, -(float)f / 16.f); const float ang = (float)pos * inv; float s, c; sincosf(ang, &s, &c); rope[i] = make_float2(c, s); }
        bf16_t* wl = (bf16_t*)(ws + WS_WLRU);
        for (int i = gt; i < 2048 * 64; i += gn) { const int n = i >> 6, k = i & 63; const int h = n >> 8, d = (n >> 7) & 1, j = (n & 127) >> 1, g = n & 1;
            const float* W = g ? p.lru_wx : p.lru_wa; wl[i] = (bf16_t)f2bf(W[(((size_t)(d * 8 + h) * 64 + k) * 64) + j]); }
    }
    float* tile = (float*)smem;
    for (int l = 0; l < 2; ++l) {
        tr_job(tile, p.w_ff1 + (size_t)l * 1024 * 4096, 4096, (bf16_t*)(ws + WS_WFF1) + (size_t)l * 4096 * 1024, 1024, 4096, 0);
        tr_job(tile, p.w_ff2 + (size_t)l * 4096 * 1024, 1024, (bf16_t*)(ws + WS_WFF2) + (size_t)l * 4096 * 1024, 4096, 1024, 0);
    }
    tr_job(tile, p.w_in_even, 2560, (bf16_t*)(ws + WS_WINE), 1024, 2560, 0);
    tr_job(tile, p.w_out_even, 1024, (bf16_t*)(ws + WS_WOUTE), 1024, 1024, 0);
    tr_job(tile, p.w_in_odd, 2336, (bf16_t*)(ws + WS_WINO), 1024, 2432, 1);
    tr_job(tile, p.w_out_odd, 1024, (bf16_t*)(ws + WS_WOUTO), 1024, 1024, 0);
}

__device__ void phase_ln(const float* __restrict__ srcL, const float* __restrict__ srcC, const float* __restrict__ nw, const float* __restrict__ mod, int sh_slot, int sc_slot, bool latent_only, bf16_t* __restrict__ U) {
    const int lane = threadIdx.x & 63, gw = blockIdx.x * 4 + (threadIdx.x >> 6), nwt = gridDim.x * 4;
    const int nrows = latent_only ? NB * SEQ : NR;
    for (int idx = gw; idx < nrows; idx += nwt) {
        int b, pi; if (latent_only) { b = idx >> 13; pi = 256 + (idx & 8191); } else { b = idx / PP; pi = idx - b * PP; }
        const int R = b * PP + pi; const bool isc = pi < 256; const int ms = isc ? 2 : b;
        const float* src = isc ? srcC + (size_t)(b * 256 + pi) * 1024 : srcL + (size_t)(b * 8192 + pi - 256) * 1024;
        f32x4 v[4]; float ss = 0.f;
#pragma unroll
        for (int i = 0; i < 4; ++i) { v[i] = *(const f32x4*)(src + i * 256 + lane * 4); ss += v[i][0] * v[i][0] + v[i][1] * v[i][1] + v[i][2] * v[i][2] + v[i][3] * v[i][3]; }
        ss = wave_sum(ss);
        const float rstd = rsqrtf(ss * (1.f / 1024.f) + EPS);
        const float* sh = mod + ms * 6144 + sh_slot * 1024; const float* sc = mod + ms * 6144 + sc_slot * 1024;
#pragma unroll
        for (int i = 0; i < 4; ++i) { const int n = i * 256 + lane * 4;
            const f32x4 w4 = *(const f32x4*)(nw + n), s4 = *(const f32x4*)(sc + n), h4 = *(const f32x4*)(sh + n);
            const f32x4 y = v[i] * rstd * w4 * (s4 + 1.f) + h4;
            *(u32x2*)(U + (size_t)R * 1024 + n) = (u32x2){pack2(y[0], y[1]), pack2(y[2], y[3])}; }
    }
}

__device__ void phase_final(const float* __restrict__ fw, float* __restrict__ out) {
    const int lane = threadIdx.x & 63, gw = blockIdx.x * 4 + (threadIdx.x >> 6), nwt = gridDim.x * 4;
    for (int idx = gw; idx < NB * SEQ; idx += nwt) {
        float* row = out + (size_t)idx * 1024;
        f32x4 v[4]; float ss = 0.f;
#pragma unroll
        for (int i = 0; i < 4; ++i) { v[i] = *(const f32x4*)(row + i * 256 + lane * 4); ss += v[i][0] * v[i][0] + v[i][1] * v[i][1] + v[i][2] * v[i][2] + v[i][3] * v[i][3]; }
        ss = wave_sum(ss);
        const float rstd = rsqrtf(ss * (1.f / 1024.f) + EPS);
#pragma unroll
        for (int i = 0; i < 4; ++i) { const int n = i * 256 + lane * 4; const f32x4 w4 = *(const f32x4*)(fw + n); *(f32x4*)(row + n) = v[i] * rstd * w4; }
    }
}

template <class Epi>
__device__ __forceinline__ void gemm_phase(char* smem, const bf16_t* __restrict__ A, int lda, const bf16_t* __restrict__ WT, int K, int nMt, int nNt, int rowmode, int lru, const Epi& epi) {
    bf16_t* As = (bf16_t*)smem; bf16_t* Bs = As + 128 * 72;
    const int tid = threadIdx.x, lane = tid & 63, wid = tid >> 6, wm = wid >> 1, wn = wid & 1;
    const int lr = lane & 15, lq = lane >> 4;
    const int ntiles = nMt * nNt;
    for (int tile = blockIdx.x; tile < ntiles; tile += gridDim.x) {
        const int mt = tile / nNt, nt = tile - mt * nNt;
        const int row0 = rowmode ? ((mt >> 6) * PP + 256 + (mt & 63) * 128) : mt * 128;
        const bf16_t* Ag = A + (size_t)row0 * lda + (lru ? (nt >> 1) * 64 : 0);
        const bf16_t* Bg = WT + (size_t)nt * 128 * K;
        f32x4 acc[4][4];
#pragma unroll
        for (int i = 0; i < 4; ++i)
#pragma unroll
            for (int j = 0; j < 4; ++j) acc[i][j] = (f32x4){0.f, 0.f, 0.f, 0.f};
        u32x4 ra[4], rb[4];
#pragma unroll
        for (int i = 0; i < 4; ++i) { const int c = tid + 256 * i, r = c >> 3, kc = (c & 7) * 8; ra[i] = *(const u32x4*)(Ag + (size_t)r * lda + kc); rb[i] = *(const u32x4*)(Bg + (size_t)r * K + kc); }
        for (int k0 = 0; k0 < K; k0 += 64) {
            __syncthreads();
#pragma unroll
            for (int i = 0; i < 4; ++i) { const int c = tid + 256 * i, r = c >> 3, kc = (c & 7) * 8; *(u32x4*)(As + r * 72 + kc) = ra[i]; *(u32x4*)(Bs + r * 72 + kc) = rb[i]; }
            __syncthreads();
            if (k0 + 64 < K) {
#pragma unroll
                for (int i = 0; i < 4; ++i) { const int c = tid + 256 * i, r = c >> 3, kc = (c & 7) * 8 + k0 + 64; ra[i] = *(const u32x4*)(Ag + (size_t)r * lda + kc); rb[i] = *(const u32x4*)(Bg + (size_t)r * K + kc); }
            }
#pragma unroll
            for (int ks = 0; ks < 2; ++ks) {
                bf16x8 af[4], bfr[4];
#pragma unroll
                for (int i = 0; i < 4; ++i) { af[i] = *(const bf16x8*)(As + (wm * 64 + i * 16 + lr) * 72 + ks * 32 + lq * 8); bfr[i] = *(const bf16x8*)(Bs + (wn * 64 + i * 16 + lr) * 72 + ks * 32 + lq * 8); }
#pragma unroll
                for (int mi = 0; mi < 4; ++mi)
#pragma unroll
                    for (int ni = 0; ni < 4; ++ni) acc[mi][ni] = __builtin_amdgcn_mfma_f32_16x16x32_bf16(bfr[ni], af[mi], acc[mi][ni], 0, 0, 0);
            }
        }
        epi(acc, row0 + wm * 64, nt * 128 + wn * 64, lane);
    }
}

struct EpiResid {
    const float* srcL; const float* srcC; float* dstL; float* dstC; const float* mod; int slot;
    __device__ __forceinline__ void operator()(const f32x4 (&acc)[4][4], int Rb, int nb, int lane) const {
        const int lr = lane & 15, lq = lane >> 4;
#pragma unroll
        for (int mi = 0; mi < 4; ++mi) {
            const int R = Rb + mi * 16 + lr; const int b = R / PP, pi = R - b * PP; const bool isc = pi < 256; const int ms = isc ? 2 : b;
            const size_t ro = isc ? (size_t)(b * 256 + pi) * 1024 : (size_t)(b * 8192 + pi - 256) * 1024;
            const float* s = (isc ? srcC : srcL) + ro; float* d = (isc ? dstC : dstL) + ro; const float* g = mod + ms * 6144 + slot * 1024;
#pragma unroll
            for (int ni = 0; ni < 4; ++ni) { const int n = nb + ni * 16 + lq * 4; const f32x4 h = *(const f32x4*)(s + n), gg = *(const f32x4*)(g + n); *(f32x4*)(d + n) = h + gg * acc[mi][ni]; }
        }
    }
};
struct EpiFF1 {
    bf16_t* FF;
    __device__ __forceinline__ void operator()(const f32x4 (&acc)[4][4], int Rb, int nb, int lane) const {
        const int lr = lane & 15, lq = lane >> 4;
#pragma unroll
        for (int mi = 0; mi < 4; ++mi) { const int R = Rb + mi * 16 + lr;
#pragma unroll
            for (int ni = 0; ni < 4; ++ni) { const int n = nb + ni * 16 + lq * 4; f32x4 v = acc[mi][ni];
#pragma unroll
                for (int e = 0; e < 4; ++e) { const float r = fmaxf(v[e], 0.f); v[e] = r * r; }
                *(u32x2*)(FF + (size_t)R * 4096 + n) = (u32x2){pack2(v[0], v[1]), pack2(v[2], v[3])}; } }
    }
};
__device__ __forceinline__ float gelu_tanh(float x) { const float u = 0.7978845608028654f * (x + 0.044715f * x * x * x); const float t = 1.f - 2.f / (1.f + __expf(2.f * u)); return 0.5f * x * (1.f + t); }
struct EpiInEven {
    bf16_t *Qn, *Kn, *VTn, *XL, *GG;
    __device__ __forceinline__ void operator()(const f32x4 (&acc)[4][4], int Rb, int nb, int lane) const {
        const int lr = lane & 15, lq = lane >> 4;
#pragma unroll
        for (int mi = 0; mi < 4; ++mi) { const int R = Rb + mi * 16 + lr; const int b = R / PP, pi = R - b * PP;
#pragma unroll
            for (int ni = 0; ni < 4; ++ni) { const int n = nb + ni * 16 + lq * 4; const f32x4 a = acc[mi][ni];
                if (n < 512) *(u32x2*)(Qn + (size_t)R * 512 + n) = (u32x2){pack2(a[0] * 0.125f, a[1] * 0.125f), pack2(a[2] * 0.125f, a[3] * 0.125f)};
                else if (n < 1024) *(u32x2*)(Kn + (size_t)R * 512 + (n - 512)) = (u32x2){pack2(a[0], a[1]), pack2(a[2], a[3])};
                else if (n < 1536) { const int hh = (n - 1024) >> 6, d0 = (n - 1024) & 63; bf16_t* vp = VTn + ((size_t)((b * 8 + hh) * 64 + d0)) * PP + pi;
#pragma unroll
                    for (int e = 0; e < 4; ++e) vp[(size_t)e * PP] = (bf16_t)f2bf(a[e]); }
                else if (n < 2048) *(u32x2*)(XL + (size_t)R * 512 + (n - 1536)) = (u32x2){pack2(a[0], a[1]), pack2(a[2], a[3])};
                else *(u32x2*)(GG + (size_t)R * 512 + (n - 2048)) = (u32x2){pack2(gelu_tanh(a[0]), gelu_tanh(a[1])), pack2(gelu_tanh(a[2]), gelu_tanh(a[3]))};
            } }
    }
};
struct EpiLru {
    const bf16_t* XC; __half2* AB; const float *ba, *bx, *lam;
    __device__ __forceinline__ void operator()(const f32x4 (&acc)[4][4], int Rb, int nb, int lane) const {
        const int lr = lane & 15, lq = lane >> 4;
        const int h = nb >> 8, d = (nb >> 7) & 1, colb = nb & 127;
#pragma unroll
        for (int mi = 0; mi < 4; ++mi) { const int R = Rb + mi * 16 + lr;
#pragma unroll
            for (int ni = 0; ni < 4; ++ni) { const int j0 = (colb + ni * 16 + lq * 4) >> 1; const int c = h * 64 + j0; __half2 o[2];
#pragma unroll
                for (int e2 = 0; e2 < 2; ++e2) { const int cc = c + e2;
                    const float za = acc[mi][ni][2 * e2] + ba[d * 512 + cc], zx = acc[mi][ni][2 * e2 + 1] + bx[d * 512 + cc];
                    const float r = sigmoidf_(za), ig = sigmoidf_(zx);
                    const float sp = log1pf(__expf(-lam[d * 512 + cc]));
                    const float la = -8.f * r * sp;
                    const float xv = bf2f(XC[(size_t)R * 512 + cc]);
                    const float bb = sqrtf(fmaxf(-expm1f(2.f * la), 0.f)) * ig * xv;
                    o[e2] = __floats2half2_rn(la, bb); }
                __half2* dst = AB + ((size_t)d * NR + R) * 512 + c; dst[0] = o[0]; dst[1] = o[1]; } }
    }
};
struct EpiInOdd {
    bf16_t *Gq, *Gk, *Gv, *Gg, *Qg, *Kg, *VTg; float* LR; const float *qnw, *knw; const float2* rope;
    __device__ __forceinline__ void operator()(const f32x4 (&acc)[4][4], int Rb, int nb, int lane) const {
        const int lr = lane & 15, lq = lane >> 4;
        if (nb < 1536) {
#pragma unroll
            for (int mi = 0; mi < 4; ++mi) { const int R = Rb + mi * 16 + lr;
#pragma unroll
                for (int ni = 0; ni < 4; ++ni) { const int n = nb + ni * 16 + lq * 4; const f32x4 a = acc[mi][ni];
                    if (n < 256) *(u32x2*)(Gq + (size_t)R * 256 + n) = (u32x2){pack2(a[0], a[1]), pack2(a[2], a[3])};
                    else if (n < 512) *(u32x2*)(Gk + (size_t)R * 256 + (n - 256)) = (u32x2){pack2(a[0], a[1]), pack2(a[2], a[3])};
                    else if (n < 1024) *(u32x2*)(Gv + (size_t)R * 512 + (n - 512)) = (u32x2){pack2(a[0], a[1]), pack2(a[2], a[3])};
                    else { f32x4 s;
#pragma unroll
                        for (int e = 0; e < 4; ++e) s[e] = a[e] * sigmoidf_(a[e]);
                        *(u32x2*)(Gg + (size_t)R * 512 + (n - 1024)) = (u32x2){pack2(s[0], s[1]), pack2(s[2], s[3])}; } } }
        } else if (nb < 2176) {
            const bool isq = nb < 2048; const float* nwp = isq ? qnw : knw;
#pragma unroll
            for (int mi = 0; mi < 4; ++mi) { const int R = Rb + mi * 16 + lr; const int b = R / PP, pi = R - b * PP;
                float ss = 0.f;
#pragma unroll
                for (int ni = 0; ni < 4; ++ni)
#pragma unroll
                    for (int e = 0; e < 4; ++e) ss += acc[mi][ni][e] * acc[mi][ni][e];
                ss += __shfl_xor(ss, 16); ss += __shfl_xor(ss, 32);
                const float rstd = rsqrtf(ss * (1.f / 64.f) + EPS);
                f32x4 y[4];
#pragma unroll
                for (int ni = 0; ni < 4; ++ni) { const f32x4 w4 = *(const f32x4*)(nwp + ni * 16 + lq * 4); y[ni] = acc[mi][ni] * rstd * w4; }
                if (pi >= 256) { const int t = pi - 256, prow = t >> 6, pcol = t & 63;
#pragma unroll
                    for (int e = 0; e < 4; ++e) { const int i = lq * 4 + e; const float2 cr = rope[prow * 16 + i], cc = rope[pcol * 16 + i];
                        const float a1 = y[0][e], a2 = y[1][e]; y[0][e] = a1 * cr.x - a2 * cr.y; y[1][e] = a2 * cr.x + a1 * cr.y;
                        const float b1 = y[2][e], b2 = y[3][e]; y[2][e] = b1 * cc.x - b2 * cc.y; y[3][e] = b2 * cc.x + b1 * cc.y; } }
                if (isq) {
#pragma unroll
                    for (int ni = 0; ni < 4; ++ni) { const f32x4 v = y[ni] * 0.125f; *(u32x2*)(Qg + (size_t)R * 512 + (nb - 1536) + ni * 16 + lq * 4) = (u32x2){pack2(v[0], v[1]), pack2(v[2], v[3])}; }
                } else {
#pragma unroll
                    for (int ni = 0; ni < 4; ++ni) { const f32x4 v = y[ni]; *(u32x2*)(Kg + (size_t)R * 128 + (nb - 2048) + ni * 16 + lq * 4) = (u32x2){pack2(v[0], v[1]), pack2(v[2], v[3])}; }
                } }
        } else if (nb < 2304) {
            const int kvh = (nb - 2176) >> 6;
#pragma unroll
            for (int mi = 0; mi < 4; ++mi) { const int R = Rb + mi * 16 + lr; const int b = R / PP, pi = R - b * PP;
#pragma unroll
                for (int ni = 0; ni < 4; ++ni) { bf16_t* vp = VTg + ((size_t)((b * 2 + kvh) * 64 + ni * 16 + lq * 4)) * PP + pi;
#pragma unroll
                    for (int e = 0; e < 4; ++e) vp[(size_t)e * PP] = (bf16_t)f2bf(acc[mi][ni][e]); } }
        } else if (nb == 2304) {
#pragma unroll
            for (int mi = 0; mi < 4; ++mi) { const int R = Rb + mi * 16 + lr;
#pragma unroll
                for (int ni = 0; ni < 2; ++ni) *(f32x4*)(LR + (size_t)R * 32 + ni * 16 + lq * 4) = acc[mi][ni]; }
        }
    }
};

__device__ __forceinline__ void attn_unit(char* smem, const bf16_t* __restrict__ Qp, int ldq, const bf16_t* __restrict__ Kp, int ldk, const bf16_t* __restrict__ VTp,
                                          bf16_t* __restrict__ Op, int ldo, int ntiles, int mode, int r0, int rs0, const float* __restrict__ rpb_h) {
    bf16_t* Ks = (bf16_t*)smem;
    bf16_t* Vs = Ks + 2 * 64 * 72;
    float* rp = (float*)(Vs + 2 * 64 * 72);
    const int tid = threadIdx.x, lane = tid & 63, w = tid >> 6, l31 = lane & 31, lh = lane >> 5;
    if (mode == 1) { for (int i = tid; i < 465; i += 256) rp[i] = rpb_h[i]; }
    bf16x8 qf[4];
    { const bf16_t* q = Qp + (size_t)(w * 32 + l31) * ldq + lh * 8;
#pragma unroll
        for (int ks = 0; ks < 4; ++ks) qf[ks] = *(const bf16x8*)(q + ks * 16); }
    f32x16 ot[2];
#pragma unroll
    for (int i = 0; i < 16; ++i) { ot[0][i] = 0.f; ot[1][i] = 0.f; }
    float m = -1e30f, l = 0.f;
    u32x4 rk[2], rv[2];
#define ATT_GLOAD(t_) do { const int t__ = (t_); const int pos__ = (mode == 1) ? (t__ < 4 ? t__ * 64 : 256 + (rs0 + t__ - 4) * 64) : t__ * 64; \
        _Pragma("unroll") for (int i = 0; i < 2; ++i) { const int c = tid + 256 * i, r = c >> 3, cc = (c & 7) * 8; \
            rk[i] = *(const u32x4*)(Kp + (size_t)(pos__ + r) * ldk + cc); rv[i] = *(const u32x4*)(VTp + (size_t)r * PP + pos__ + cc); } } while (0)
#define ATT_SSTORE(buf_) do { _Pragma("unroll") for (int i = 0; i < 2; ++i) { const int c = tid + 256 * i, r = c >> 3, cc = (c & 7) * 8; \
            *(u32x4*)(Ks + (buf_) * 64 * 72 + r * 72 + cc) = rk[i]; *(u32x4*)(Vs + (buf_) * 64 * 72 + r * 72 + cc) = rv[i]; } } while (0)
    ATT_GLOAD(0); ATT_SSTORE(0); __syncthreads();
    for (int t = 0; t < ntiles; ++t) {
        if (t + 1 < ntiles) ATT_GLOAD(t + 1);
        const bf16_t* ks_ = Ks + (t & 1) * 64 * 72; const bf16_t* vs_ = Vs + (t & 1) * 64 * 72;
        bool skip = false; int kr = 0, rq = 0;
        const bool local = (mode == 1) && (t >= 4);
        if (local) { kr = rs0 + t - 4; rq = r0 + (w >> 1); const int rsq = clampi(rq - 4, 0, 120); skip = (kr < rsq) || (kr >= rsq + 8); }
        if (!skip) {
            f32x16 st[2];
#pragma unroll
            for (int i = 0; i < 16; ++i) { st[0][i] = 0.f; st[1][i] = 0.f; }
#pragma unroll
            for (int kt = 0; kt < 2; ++kt)
#pragma unroll
                for (int ks = 0; ks < 4; ++ks) { const bf16x8 kf = *(const bf16x8*)(ks_ + (kt * 32 + l31) * 72 + ks * 16 + lh * 8); st[kt] = __builtin_amdgcn_mfma_f32_32x32x16_bf16(kf, qf[ks], st[kt], 0, 0, 0); }
            if (local) { const int qc = (w & 1) * 32 + l31, cs = clampi(qc - 8, 0, 48); const float* rrow = rp + (kr - rq + 7) * 31;
#pragma unroll
                for (int kt = 0; kt < 2; ++kt)
#pragma unroll
                    for (int i = 0; i < 16; ++i) { const int kc = kt * 32 + (i & 3) + 8 * (i >> 2) + 4 * lh; const bool ok = (kc >= cs) && (kc < cs + 16);
                        const float bias = rrow[clampi(kc - qc + 15, 0, 30)]; st[kt][i] = ok ? st[kt][i] + bias : -1e30f; } }
            float mx = st[0][0];
#pragma unroll
            for (int i = 1; i < 16; ++i) mx = fmaxf(mx, st[0][i]);
#pragma unroll
            for (int i = 0; i < 16; ++i) mx = fmaxf(mx, st[1][i]);
            mx = fmaxf(mx, __shfl_xor(mx, 32));
            const float mn = fmaxf(m, mx); const float alpha = exp2f((m - mn) * LOG2E); m = mn;
            const float mb = mn * LOG2E; float ps = 0.f;
#pragma unroll
            for (int kt = 0; kt < 2; ++kt)
#pragma unroll
                for (int i = 0; i < 16; ++i) { const float pe = exp2f(st[kt][i] * LOG2E - mb); st[kt][i] = pe; ps += pe; }
            l = l * alpha + ps;
#pragma unroll
            for (int i = 0; i < 16; ++i) { ot[0][i] *= alpha; ot[1][i] *= alpha; }
#pragma unroll
            for (int kt = 0; kt < 2; ++kt)
#pragma unroll
                for (int s = 0; s < 2; ++s) {
                    u32x4 pw; pw[0] = pack2(st[kt][8 * s + 0], st[kt][8 * s + 1]); pw[1] = pack2(st[kt][8 * s + 2], st[kt][8 * s + 3]); pw[2] = pack2(st[kt][8 * s + 4], st[kt][8 * s + 5]); pw[3] = pack2(st[kt][8 * s + 6], st[kt][8 * s + 7]);
                    const bf16x8 pf = __builtin_bit_cast(bf16x8, pw);
#pragma unroll
                    for (int dt = 0; dt < 2; ++dt) { const bf16_t* vp = vs_ + (dt * 32 + l31) * 72 + kt * 32 + s * 16 + lh * 4;
                        const u32x2 v0 = *(const u32x2*)vp, v1 = *(const u32x2*)(vp + 8); const u32x4 vw = (u32x4){v0[0], v0[1], v1[0], v1[1]};
                        ot[dt] = __builtin_amdgcn_mfma_f32_32x32x16_bf16(__builtin_bit_cast(bf16x8, vw), pf, ot[dt], 0, 0, 0); } }
        }
        if (t + 1 < ntiles) ATT_SSTORE((t + 1) & 1);
        __syncthreads();
    }
#undef ATT_GLOAD
#undef ATT_SSTORE
    l += __shfl_xor(l, 32);
    const float inv = 1.f / l;
    bf16_t* o = Op + (size_t)(w * 32 + l31) * ldo;
#pragma unroll
    for (int dt = 0; dt < 2; ++dt)
#pragma unroll
        for (int g = 0; g < 4; ++g) { const int d = dt * 32 + 8 * g + 4 * lh;
            *(u32x2*)(o + d) = (u32x2){pack2(ot[dt][4 * g] * inv, ot[dt][4 * g + 1] * inv), pack2(ot[dt][4 * g + 2] * inv, ot[dt][4 * g + 3] * inv)}; }
}

__device__ void phase_na(const Params& p, char* smem) {
    unsigned char* ws = p.ws;
    const bf16_t* Qn = (const bf16_t*)(ws + R0_Q); const bf16_t* Kn = (const bf16_t*)(ws + R0_K); const bf16_t* VTn = (const bf16_t*)(ws + R0_VT);
    bf16_t* MO = (bf16_t*)(ws + WS_U);
    for (int u = blockIdx.x; u < 1024 + 32; u += gridDim.x) {
        if (u < 1024) { const int b = u >> 9, h = (u >> 6) & 7, qb = u & 63; const int r0 = qb * 2;
            const int rs0 = clampi(r0 - 4, 0, 120), rs1 = clampi(r0 - 3, 0, 120); const int nl = rs1 + 8 - rs0;
            const size_t Rq = (size_t)b * PP + 256 + qb * 128;
            attn_unit(smem, Qn + Rq * 512 + h * 64, 512, Kn + (size_t)b * PP * 512 + h * 64, 512, VTn + (size_t)((b * 8 + h) * 64) * PP, MO + Rq * 1024 + h * 64, 1024, 4 + nl, 1, r0, rs0, p.na_rpb + h * 465);
        } else { const int v = u - 1024; const int b = v >> 4, h = (v >> 1) & 7, qb = v & 1;
            const size_t Rq = (size_t)b * PP + qb * 128;
            attn_unit(smem, Qn + Rq * 512 + h * 64, 512, Kn + (size_t)b * PP * 512 + h * 64, 512, VTn + (size_t)((b * 8 + h) * 64) * PP, MO + Rq * 1024 + h * 64, 1024, 4, 0, 0, 0, nullptr);
        }
    }
    const bf16_t* XL = (const bf16_t*)(ws + R0_XL); bf16_t* XC = (bf16_t*)(ws + R0_XC);
    const int gt = blockIdx.x * 256 + threadIdx.x, gn = gridDim.x * 256;
    for (int idx = gt; idx < NR * 64; idx += gn) {
        const int R = idx >> 6, c8 = (idx & 63) * 8; const int b = R / PP, pi = R - b * PP; const int lo = pi < 256 ? 0 : 256, hi = pi < 256 ? 256 : PP;
        float a[8];
        { const f32x4 b0 = *(const f32x4*)(p.lru_conv_b + c8), b1 = *(const f32x4*)(p.lru_conv_b + c8 + 4); a[0] = b0[0]; a[1] = b0[1]; a[2] = b0[2]; a[3] = b0[3]; a[4] = b1[0]; a[5] = b1[1]; a[6] = b1[2]; a[7] = b1[3]; }
#pragma unroll
        for (int j = 0; j < 4; ++j) { const int pj = pi + j - 2;
            if (pj >= lo && pj < hi) { const u32x4 xv = *(const u32x4*)(XL + (size_t)(b * PP + pj) * 512 + c8);
                const f32x4 w0 = *(const f32x4*)(p.lru_conv_w + j * 512 + c8), w1 = *(const f32x4*)(p.lru_conv_w + j * 512 + c8 + 4);
                a[0] += w0[0] * bflo(xv[0]); a[1] += w0[1] * bfhi(xv[0]); a[2] += w0[2] * bflo(xv[1]); a[3] += w0[3] * bfhi(xv[1]);
                a[4] += w1[0] * bflo(xv[2]); a[5] += w1[1] * bfhi(xv[2]); a[6] += w1[2] * bflo(xv[3]); a[7] += w1[3] * bfhi(xv[3]); } }
        *(u32x4*)(XC + (size_t)R * 512 + c8) = (u32x4){pack2(a[0], a[1]), pack2(a[2], a[3]), pack2(a[4], a[5]), pack2(a[6], a[7])};
    }
}

__device__ void phase_scan1(const Params& p) {
    const __half2* AB = (const __half2*)(p.ws + R0_AB); float2* SUM = (float2*)(p.ws + R0_SUM);
    for (int it = blockIdx.x; it < 1056; it += gridDim.x) {
        const int cgp = it & 1, tc = (it >> 1) % 132, db = (it >> 1) / 132, b = db & 1, d = db >> 1;
        const int c = cgp * 256 + threadIdx.x;
        const __half2* ab = AB + ((size_t)d * NR + (size_t)b * PP + tc * 64) * 512 + c;
        float h = 0.f, ap = 0.f;
#pragma unroll 8
        for (int s = 0; s < 64; ++s) { const int tt = d ? 63 - s : s; const __half2 v = ab[(size_t)tt * 512]; const float la = __low2float(v), bb = __high2float(v); h = __expf(la) * h + bb; ap += la; }
        SUM[((size_t)(d * 2 + b) * 132 + tc) * 512 + c] = make_float2(__expf(ap), h);
    }
}
__device__ void phase_scan2(const Params& p) {
    const __half2* AB = (const __half2*)(p.ws + R0_AB); const float2* SUM = (const float2*)(p.ws + R0_SUM);
    const bf16_t* GG = (const bf16_t*)(p.ws + R0_GG); bf16_t* MO = (bf16_t*)(p.ws + WS_U);
    for (int it = blockIdx.x; it < 528; it += gridDim.x) {
        const int cgp = it & 1, tc = (it >> 1) % 132, b = (it >> 1) / 132;
        const int c = cgp * 256 + threadIdx.x; const size_t R0 = (size_t)b * PP + tc * 64;
        float hf[64];
        {
            float h = 0.f; const float2* sm = SUM + ((size_t)(0 * 2 + b) * 132) * 512 + c;
            for (int jj = 0; jj < tc; ++jj) { const float2 s = sm[(size_t)jj * 512]; h = s.x * h + s.y; }
            const __half2* ab = AB + ((size_t)0 * NR + R0) * 512 + c;
#pragma unroll
            for (int s = 0; s < 64; ++s) { const __half2 v = ab[(size_t)s * 512]; h = __expf(__low2float(v)) * h + __high2float(v); hf[s] = h; }
        }
        {
            const int j = tc < 4 ? 3 - tc : 135 - tc;
            float h = 0.f; const float2* sm = SUM + ((size_t)(1 * 2 + b) * 132) * 512 + c;
            for (int jj = 0; jj < j; ++jj) { const int tcj = jj < 4 ? 3 - jj : 135 - jj; const float2 s = sm[(size_t)tcj * 512]; h = s.x * h + s.y; }
            const __half2* ab = AB + ((size_t)1 * NR + R0) * 512 + c;
#pragma unroll
            for (int s = 0; s < 64; ++s) { const int tt = 63 - s; const __half2 v = ab[(size_t)tt * 512]; h = __expf(__low2float(v)) * h + __high2float(v);
                const float g = bf2f(GG[(R0 + tt) * 512 + c]);
                MO[(R0 + tt) * 1024 + 512 + c] = (bf16_t)f2bf((hf[tt] + h) * g); }
        }
    }
}

__device__ __forceinline__ void gla_gates(const Params& p, float* gs, const float* __restrict__ LR, size_t R0, int d, int h) {
    const int tid = threadIdx.x, dk = tid & 63, tg = tid >> 6;
    float wv[16];
#pragma unroll
    for (int r = 0; r < 16; ++r) wv[r] = p.gla_wa2[(d * 16 + r) * 256 + h * 64 + dk];
    const float bav = p.gla_ba[d * 256 + h * 64 + dk];
    for (int ti = 0; ti < 16; ++ti) { const int t = tg * 16 + ti; const float* lrp = LR + (R0 + t) * 32 + d * 16; float z = bav;
#pragma unroll
        for (int r = 0; r < 16; ++r) z += lrp[r] * wv[r];
        const float ls = fminf(z, 0.f) - log1pf(__expf(-fabsf(z))); gs[t * 64 + dk] = ls * (1.f / 16.f); }
    __syncthreads();
    if (tid < 64) { float s = 0.f;
        if (d == 0) { for (int t = 0; t < 64; ++t) { s += gs[t * 64 + tid]; gs[t * 64 + tid] = s; } }
        else { for (int t = 63; t >= 0; --t) { s += gs[t * 64 + tid]; gs[t * 64 + tid] = s; } } }
    __syncthreads();
}
__device__ __forceinline__ void gla_load_vt(bf16_t* VTs, const bf16_t* __restrict__ Gv, size_t R0, int h) {
    const int tid = threadIdx.x, t = tid >> 2, vq = (tid & 3) * 32; const bf16_t* src = Gv + (R0 + t) * 512 + h * 128 + vq;
#pragma unroll
    for (int q = 0; q < 4; ++q) { const u32x4 v = *(const u32x4*)(src + q * 8);
#pragma unroll
        for (int e = 0; e < 4; ++e) { VTs[(vq + q * 8 + 2 * e) * 72 + t] = (bf16_t)(v[e] & 0xffffu); VTs[(vq + q * 8 + 2 * e + 1) * 72 + t] = (bf16_t)(v[e] >> 16); } }
}
__device__ void phase_gla1(const Params& p, char* smem) {
    unsigned char* ws = p.ws;
    const bf16_t* Gk = (const bf16_t*)(ws + R1_GK); const bf16_t* Gv = (const bf16_t*)(ws + R1_GV); const float* LR = (const float*)(ws + R1_LR);
    float* UC = (float*)(ws + R1_UC); float* DEC = (float*)(ws + R1_DEC);
    float* gs = (float*)smem; bf16_t* KD = (bf16_t*)(smem + 16384); bf16_t* VTs = KD + 64 * 72;
    const int tid = threadIdx.x, lane = tid & 63, w = tid >> 6, lr = lane & 15, lq = lane >> 4;
    for (int it = blockIdx.x; it < 2112; it += gridDim.x) {
        const int tc = it % 132, h = (it / 132) & 3, d = (it / 528) & 1, b = it / 1056;
        const size_t R0 = (size_t)b * PP + tc * 64;
        __syncthreads();
        gla_gates(p, gs, LR, R0, d, h);
        const int tl = d ? 0 : 63;
        { const int t = tid >> 2, dq = (tid & 3) * 16; const bf16_t* src = Gk + (R0 + t) * 256 + h * 64 + dq;
#pragma unroll
            for (int q = 0; q < 2; ++q) { const u32x4 v = *(const u32x4*)(src + q * 8);
#pragma unroll
                for (int e = 0; e < 4; ++e) { const int dk0 = dq + q * 8 + 2 * e;
                    const float k0 = bflo(v[e]) * __expf(gs[tl * 64 + dk0] - gs[t * 64 + dk0]); const float k1 = bfhi(v[e]) * __expf(gs[tl * 64 + dk0 + 1] - gs[t * 64 + dk0 + 1]);
                    KD[dk0 * 72 + t] = (bf16_t)f2bf(k0); KD[(dk0 + 1) * 72 + t] = (bf16_t)f2bf(k1); } } }
        gla_load_vt(VTs, Gv, R0, h);
        __syncthreads();
        f32x4 acc[8];
#pragma unroll
        for (int i = 0; i < 8; ++i) acc[i] = (f32x4){0.f, 0.f, 0.f, 0.f};
#pragma unroll
        for (int ks = 0; ks < 2; ++ks) { const bf16x8 a = *(const bf16x8*)(KD + (16 * w + lr) * 72 + ks * 32 + lq * 8);
#pragma unroll
            for (int nt = 0; nt < 8; ++nt) { const bf16x8 bb = *(const bf16x8*)(VTs + (16 * nt + lr) * 72 + ks * 32 + lq * 8); acc[nt] = __builtin_amdgcn_mfma_f32_16x16x32_bf16(a, bb, acc[nt], 0, 0, 0); } }
        const int j = d == 0 ? tc : (tc < 4 ? 3 - tc : 135 - tc);
        const size_t chain = (size_t)((b * 2 + d) * 4 + h);
        float* up = UC + (chain * 132 + j) * 8192;
#pragma unroll
        for (int nt = 0; nt < 8; ++nt)
#pragma unroll
            for (int e = 0; e < 4; ++e) up[(16 * w + 4 * lq + e) * 128 + 16 * nt + lr] = acc[nt][e];
        if (tid < 64) DEC[(chain * 132 + j) * 64 + tid] = __expf(gs[tl * 64 + tid]);
    }
}
__device__ void phase_gla2(const Params& p) {
    float* UC = (float*)(p.ws + R1_UC); const float* DEC = (const float*)(p.ws + R1_DEC);
    const int gt = blockIdx.x * 256 + threadIdx.x, gn = gridDim.x * 256;
    for (int e = gt; e < 16 * 8192; e += gn) { const int chain = e >> 13, el = e & 8191, dk = el >> 7;
        float* u = UC + (size_t)chain * 132 * 8192 + el; const float* dec = DEC + (size_t)chain * 132 * 64 + dk; float S = 0.f;
#pragma unroll 4
        for (int j = 0; j < 132; ++j) { const float uv = u[(size_t)j * 8192]; const float dv = dec[j * 64]; u[(size_t)j * 8192] = S; S = dv * S + uv; } }
}
__device__ void phase_gla3(const Params& p, char* smem) {
    unsigned char* ws = p.ws;
    const bf16_t* Gq = (const bf16_t*)(ws + R1_GQ); const bf16_t* Gk = (const bf16_t*)(ws + R1_GK); const bf16_t* Gv = (const bf16_t*)(ws + R1_GV); const bf16_t* Gg = (const bf16_t*)(ws + R1_GG);
    const float* LR = (const float*)(ws + R1_LR); const float* UC = (const float*)(ws + R1_UC); bf16_t* MO = (bf16_t*)(ws + WS_U);
    float* gs = (float*)smem; bf16_t* ATT = (bf16_t*)smem; bf16_t* QI = (bf16_t*)(smem + 16384); bf16_t* KI = QI + 64 * 72; bf16_t* VTs = KI + 64 * 72; bf16_t* SPT = VTs + 128 * 72;
    const int tid = threadIdx.x, lane = tid & 63, w = tid >> 6, lr = lane & 15, lq = lane >> 4;
    for (int it = blockIdx.x; it < 1024; it += gridDim.x) {
        const int tcl = it & 127, h = (it >> 7) & 3, b = it >> 9; const int tc = 4 + tcl;
        const size_t R0 = (size_t)b * PP + tc * 64;
        __syncthreads();
        gla_load_vt(VTs, Gv, R0, h);
        f32x4 acc[8];
#pragma unroll
        for (int i = 0; i < 8; ++i) acc[i] = (f32x4){0.f, 0.f, 0.f, 0.f};
        for (int d = 0; d < 2; ++d) {
            const int j = d == 0 ? tc : 135 - tc; const size_t chain = (size_t)((b * 2 + d) * 4 + h);
            __syncthreads();
            gla_gates(p, gs, LR, R0, d, h);
            { const int t = tid >> 2, dq = (tid & 3) * 16; const bf16_t* qs = Gq + (R0 + t) * 256 + h * 64 + dq; const bf16_t* ksrc = Gk + (R0 + t) * 256 + h * 64 + dq;
#pragma unroll
                for (int q = 0; q < 2; ++q) { const u32x4 qv = *(const u32x4*)(qs + q * 8), kv = *(const u32x4*)(ksrc + q * 8); u32x4 qo, ko;
#pragma unroll
                    for (int e = 0; e < 4; ++e) { const int dk0 = dq + q * 8 + 2 * e; const float g0 = gs[t * 64 + dk0], g1 = gs[t * 64 + dk0 + 1];
                        const float e0 = __expf(g0), e1 = __expf(g1);
                        qo[e] = pack2(bflo(qv[e]) * 0.125f * e0, bfhi(qv[e]) * 0.125f * e1); ko[e] = pack2(bflo(kv[e]) / e0, bfhi(kv[e]) / e1); }
                    *(u32x4*)(QI + t * 72 + dq + q * 8) = qo; *(u32x4*)(KI + t * 72 + dq + q * 8) = ko; } }
            { const int dk = tid >> 2, vq = (tid & 3) * 32; const float* sp = UC + (chain * 132 + j) * 8192 + dk * 128 + vq;
#pragma unroll
                for (int q = 0; q < 8; ++q) { const f32x4 v = *(const f32x4*)(sp + q * 4);
#pragma unroll
                    for (int e = 0; e < 4; ++e) SPT[(vq + q * 4 + e) * 72 + dk] = (bf16_t)f2bf(v[e]); } }
            __syncthreads();
            f32x4 at[4];
#pragma unroll
            for (int i = 0; i < 4; ++i) at[i] = (f32x4){0.f, 0.f, 0.f, 0.f};
#pragma unroll
            for (int ks = 0; ks < 2; ++ks) { const bf16x8 a = *(const bf16x8*)(QI + (16 * w + lr) * 72 + ks * 32 + lq * 8);
#pragma unroll
                for (int nt = 0; nt < 4; ++nt) { const bf16x8 bb = *(const bf16x8*)(KI + (16 * nt + lr) * 72 + ks * 32 + lq * 8); at[nt] = __builtin_amdgcn_mfma_f32_16x16x32_bf16(a, bb, at[nt], 0, 0, 0); } }
#pragma unroll
            for (int nt = 0; nt < 4; ++nt)
#pragma unroll
                for (int e = 0; e < 4; ++e) { const int t = 16 * w + 4 * lq + e, s = 16 * nt + lr; const bool keep = d == 0 ? (s <= t) : (s >= t); ATT[t * 72 + s] = (bf16_t)f2bf(keep ? at[nt][e] : 0.f); }
            __syncthreads();
#pragma unroll
            for (int ks = 0; ks < 2; ++ks) { const bf16x8 a1 = *(const bf16x8*)(ATT + (16 * w + lr) * 72 + ks * 32 + lq * 8); const bf16x8 a2 = *(const bf16x8*)(QI + (16 * w + lr) * 72 + ks * 32 + lq * 8);
#pragma unroll
                for (int nt = 0; nt < 8; ++nt) { const bf16x8 b1 = *(const bf16x8*)(VTs + (16 * nt + lr) * 72 + ks * 32 + lq * 8); const bf16x8 b2 = *(const bf16x8*)(SPT + (16 * nt + lr) * 72 + ks * 32 + lq * 8);
                    acc[nt] = __builtin_amdgcn_mfma_f32_16x16x32_bf16(a1, b1, acc[nt], 0, 0, 0); acc[nt] = __builtin_amdgcn_mfma_f32_16x16x32_bf16(a2, b2, acc[nt], 0, 0, 0); } }
        }
#pragma unroll
        for (int e = 0; e < 4; ++e) { float ss = 0.f;
#pragma unroll
            for (int nt = 0; nt < 8; ++nt) ss += acc[nt][e] * acc[nt][e];
            ss += __shfl_xor(ss, 1); ss += __shfl_xor(ss, 2); ss += __shfl_xor(ss, 4); ss += __shfl_xor(ss, 8);
            const float rstd = rsqrtf(ss * (1.f / 128.f) + EPS); const size_t R = R0 + 16 * w + 4 * lq + e;
#pragma unroll
            for (int nt = 0; nt < 8; ++nt) { const int v = 16 * nt + lr; const float y = acc[nt][e] * rstd * p.gla_norm_w[v] * bf2f(Gg[R * 512 + h * 128 + v]); MO[R * 1024 + h * 128 + v] = (bf16_t)f2bf(y); } }
    }
}
__device__ void phase_gqa(const Params& p, char* smem) {
    unsigned char* ws = p.ws;
    const bf16_t* Qg = (const bf16_t*)(ws + R1_QG); const bf16_t* Kg = (const bf16_t*)(ws + R1_KG); const bf16_t* VTg = (const bf16_t*)(ws + R1_VTG); bf16_t* MO = (bf16_t*)(ws + WS_U);
    for (int u = blockIdx.x; u < 1024; u += gridDim.x) { const int b = u >> 9, hq = (u >> 6) & 7, qb = u & 63, kvh = hq >> 2;
        const size_t Rq = (size_t)b * PP + 256 + qb * 128;
        attn_unit(smem, Qg + Rq * 512 + hq * 64, 512, Kg + (size_t)b * PP * 128 + kvh * 64, 128, VTg + (size_t)((b * 2 + kvh) * 64) * PP, MO + Rq * 1024 + 512 + hq * 64, 1024, 132, 0, 0, 0, nullptr); }
}

__device__ void run_phase(const Params& p, int ph, char* smem) {
    unsigned char* ws = p.ws;
    float* MOD = (float*)(ws + WS_MOD); float* Hc = (float*)(ws + WS_HC); float* Hl = p.out; bf16_t* U = (bf16_t*)(ws + WS_U);
    switch (ph) {
    case 0: phase_prologue(p, smem); break;
    case 1: phase_ln(p.x, p.ctx, p.norm1_w, MOD, 0, 1, false, U); break;
    case 2: { EpiInEven e{(bf16_t*)(ws + R0_Q), (bf16_t*)(ws + R0_K), (bf16_t*)(ws + R0_VT), (bf16_t*)(ws + R0_XL), (bf16_t*)(ws + R0_GG)};
        gemm_phase(smem, U, 1024, (const bf16_t*)(ws + WS_WINE), 1024, 132, 20, 0, 0, e); } break;
    case 3: phase_na(p, smem); break;
    case 4: { EpiLru e{(const bf16_t*)(ws + R0_XC), (__half2*)(ws + R0_AB), p.lru_ba, p.lru_bx, p.lru_lambda};
        gemm_phase(smem, (const bf16_t*)(ws + R0_XC), 512, (const bf16_t*)(ws + WS_WLRU), 64, 132, 16, 0, 1, e); } break;
    case 5: phase_scan1(p); break;
    case 6: phase_scan2(p); break;
    case 7: { EpiResid e{p.x, p.ctx, Hl, Hc, MOD, 2}; gemm_phase(smem, U, 1024, (const bf16_t*)(ws + WS_WOUTE), 1024, 132, 8, 0, 0, e); } break;
    case 8: phase_ln(Hl, Hc, p.norm2_w, MOD, 3, 4, false, U); break;
    case 9: { EpiFF1 e{(bf16_t*)(ws + R_FF)}; gemm_phase(smem, U, 1024, (const bf16_t*)(ws + WS_WFF1), 1024, 132, 32, 0, 0, e); } break;
    case 10: { EpiResid e{Hl, Hc, Hl, Hc, MOD, 5}; gemm_phase(smem, (const bf16_t*)(ws + R_FF), 4096, (const bf16_t*)(ws + WS_WFF2), 4096, 132, 8, 0, 0, e); } break;
    case 11: phase_ln(Hl, Hc, p.norm1_w + 1024, MOD + 3 * 6144, 0, 1, false, U); break;
    case 12: { EpiInOdd e{(bf16_t*)(ws + R1_GQ), (bf16_t*)(ws + R1_GK), (bf16_t*)(ws + R1_GV), (bf16_t*)(ws + R1_GG), (bf16_t*)(ws + R1_QG), (bf16_t*)(ws + R1_KG), (bf16_t*)(ws + R1_VTG),
                          (float*)(ws + R1_LR), p.gqa_q_norm_w, p.gqa_k_norm_w, (const float2*)(ws + WS_ROPE)};
        gemm_phase(smem, U, 1024, (const bf16_t*)(ws + WS_WINO), 1024, 132, 19, 0, 0, e); } break;
    case 13: phase_gla1(p, smem); break;
    case 14: phase_gla2(p); phase_gqa(p, smem); break;
    case 15: phase_gla3(p, smem); break;
    case 16: { EpiResid e{Hl, Hc, Hl, Hc, MOD + 3 * 6144, 2}; gemm_phase(smem, U, 1024, (const bf16_t*)(ws + WS_WOUTO), 1024, 128, 8, 1, 0, e); } break;
    case 17: phase_ln(Hl, Hc, p.norm2_w + 1024, MOD + 3 * 6144, 3, 4, true, U); break;
    case 18: { EpiFF1 e{(bf16_t*)(ws + R_FF)}; gemm_phase(smem, U, 1024, (const bf16_t*)(ws + WS_WFF1) + (size_t)4096 * 1024, 1024, 128, 32, 1, 0, e); } break;
    case 19: { EpiResid e{Hl, Hc, Hl, Hc, MOD + 3 * 6144, 5}; gemm_phase(smem, (const bf16_t*)(ws + R_FF), 4096, (const bf16_t*)(ws + WS_WFF2) + (size_t)4096 * 1024, 4096, 128, 8, 1, 0, e); } break;
    case 20: phase_final(p.final_norm_w, Hl); break;
    default: break;
    }
}

#if MEGA
template <int PH> __device__ __forceinline__ void run_all(const Params& p, char* smem, cg::grid_group& grid) {
    if constexpr (PH < NPHASE) { run_phase(p, PH, smem); if constexpr (PH + 1 < NPHASE) grid.sync(); run_all<PH + 1>(p, smem, grid); }
}
__global__ void __launch_bounds__(256, 2) hybrid_fwd(Params p) {
    extern __shared__ __attribute__((aligned(16))) char smem[];
    cg::grid_group grid = cg::this_grid();
    run_all<0>(p, smem, grid);
}
#else
template <int PH> __global__ void __launch_bounds__(256, 2) phase_k(Params p) {
    extern __shared__ __attribute__((aligned(16))) char smem[];
    run_phase(p, PH, smem);
}
template <int PH> static bool setup_all() {
    if constexpr (PH < NPHASE) { if (hipFuncSetAttribute((const void*)phase_k<PH>, hipFuncAttributeMaxDynamicSharedMemorySize, LDS_BYTES) != hipSuccess) return false; return setup_all<PH + 1>(); }
    else return true;
}
template <int PH> static void launch_all(const Params& p, int grid, hipStream_t stream) {
    if constexpr (PH < NPHASE) { hipLaunchKernelGGL(phase_k<PH>, dim3(grid), dim3(256), LDS_BYTES, stream, p); launch_all<PH + 1>(p, grid, stream); }
}
#endif

extern "C" void kernel_launch(void* const* d_in, const int* in_sizes, int n_in, void* d_out, int out_size, void* d_ws, size_t ws_size, hipStream_t stream) {
    static int grid_blocks = 0;
    if (grid_blocks == 0) {
        if (n_in != 28 || out_size != NB * SEQ * DM || ws_size < WS_NEED) { fprintf(stderr, "kernel_launch: unexpected shapes (n_in %d out %d ws %zu need %zu)\n", n_in, out_size, ws_size, (size_t)WS_NEED); grid_blocks = -1; return; }
        int dev = 0, cus = 0, per_cu = 0;
        if (hipGetDevice(&dev) != hipSuccess || hipDeviceGetAttribute(&cus, hipDeviceAttributeMultiprocessorCount, dev) != hipSuccess) { grid_blocks = -1; return; }
#if MEGA
        if (hipFuncSetAttribute((const void*)hybrid_fwd, hipFuncAttributeMaxDynamicSharedMemorySize, LDS_BYTES) != hipSuccess) { fprintf(stderr, "kernel_launch: hipFuncSetAttribute failed\n"); grid_blocks = -1; return; }
        if (hipOccupancyMaxActiveBlocksPerMultiprocessor(&per_cu, (const void*)hybrid_fwd, 256, LDS_BYTES) != hipSuccess || per_cu < 1) { fprintf(stderr, "kernel_launch: occupancy query failed (%d)\n", per_cu); grid_blocks = -1; return; }
        if (per_cu > 2) per_cu = 2;
#else
        if (!setup_all<0>()) { fprintf(stderr, "kernel_launch: hipFuncSetAttribute failed\n"); grid_blocks = -1; return; }
        per_cu = 2;
#endif
        grid_blocks = cus * per_cu;
    }
    if (grid_blocks < 0) return;
    Params p{};
    const float** pp = (const float**)&p;
    for (int i = 0; i < 28; ++i) pp[i] = (const float*)d_in[i];
    p.out = (float*)d_out; p.ws = (unsigned char*)d_ws;
    p.ph_lo = 0; p.ph_hi = NPHASE;
#if MEGA
    void* args[] = {&p};
    hipError_t e = hipLaunchCooperativeKernel((const void*)hybrid_fwd, dim3(grid_blocks), dim3(256), args, LDS_BYTES, stream);
    if (e != hipSuccess) fprintf(stderr, "cooperative launch failed: %s (grid %d)\n", hipGetErrorString(e), grid_blocks);
#else
    launch_all<0>(p, grid_blocks, stream);
#endif
}
```

```cpp
#include <hip/hip_runtime.h>
#include <hip/hip_cooperative_groups.h>
#include <hip/hip_fp16.h>
#include <cstdio>
#include <cstdint>
namespace cg = cooperative_groups;

#ifndef MEGA
#define MEGA 1
#endif

typedef unsigned short bf16_t;
typedef short bf16x8 __attribute__((ext_vector_type(8)));
typedef short s16x4 __attribute__((ext_vector_type(4)));
typedef float f32x4 __attribute__((ext_vector_type(4)));
typedef float f32x16 __attribute__((ext_vector_type(16)));
typedef unsigned u32x4 __attribute__((ext_vector_type(4)));
typedef unsigned u32x2 __attribute__((ext_vector_type(2)));

constexpr int DM = 1024, NB = 2, SEQ = 8192, CTX = 256, PP = SEQ + CTX, NR = NB * PP;
constexpr float EPS = 1e-6f;
constexpr float LOG2E = 1.4426950408889634f;
constexpr int LDS_BYTES = 71680;
constexpr int NPHASE = 21;

constexpr size_t WS_WFF1 = 0;
constexpr size_t WS_WFF2 = WS_WFF1 + 2ull * 4096 * 1024 * 2;
constexpr size_t WS_WINE = WS_WFF2 + 2ull * 4096 * 1024 * 2;
constexpr size_t WS_WOUTE = WS_WINE + 2560ull * 1024 * 2;
constexpr size_t WS_WINO = WS_WOUTE + 1024ull * 1024 * 2;
constexpr size_t WS_WOUTO = WS_WINO + 2432ull * 1024 * 2;
constexpr size_t WS_WLRU = WS_WOUTO + 1024ull * 1024 * 2;
constexpr size_t WS_MOD = WS_WLRU + 2048ull * 64 * 2;
constexpr size_t WS_ROPE = WS_MOD + 2ull * 3 * 6144 * 4;
constexpr size_t WS_HC = WS_ROPE + 128ull * 16 * 8;
constexpr size_t WS_U = WS_HC + 512ull * 1024 * 4;
constexpr size_t WS_REG = WS_U + (size_t)NR * 1024 * 2;
constexpr size_t R0_Q = WS_REG;
constexpr size_t R0_K = R0_Q + (size_t)NR * 512 * 2;
constexpr size_t R0_VT = R0_K + (size_t)NR * 512 * 2;
constexpr size_t R0_XL = R0_VT + (size_t)NR * 512 * 2;
constexpr size_t R0_GG = R0_XL + (size_t)NR * 512 * 2;
constexpr size_t R0_XC = R0_GG + (size_t)NR * 512 * 2;
constexpr size_t R0_AB = R0_XC + (size_t)NR * 512 * 2;
constexpr size_t R0_SUM = R0_AB + 2ull * NR * 512 * 4;
constexpr size_t R0_END = R0_SUM + 2ull * 2 * 132 * 512 * 8;
constexpr size_t R_FF = WS_REG;
constexpr size_t RFF_END = R_FF + (size_t)NR * 4096 * 2;
constexpr size_t R1_GQ = WS_REG;
constexpr size_t R1_GK = R1_GQ + (size_t)NR * 256 * 2;
constexpr size_t R1_GV = R1_GK + (size_t)NR * 256 * 2;
constexpr size_t R1_GG = R1_GV + (size_t)NR * 512 * 2;
constexpr size_t R1_LR = R1_GG + (size_t)NR * 512 * 2;
constexpr size_t R1_QG = R1_LR + (size_t)NR * 32 * 4;
constexpr size_t R1_KG = R1_QG + (size_t)NR * 512 * 2;
constexpr size_t R1_VTG = R1_KG + (size_t)NR * 128 * 2;
constexpr size_t R1_UC = R1_VTG + (size_t)NR * 128 * 2;
constexpr size_t R1_DEC = R1_UC + 16ull * 132 * 8192 * 4;
constexpr size_t R1_END = R1_DEC + 16ull * 132 * 64 * 4;
constexpr size_t WS_NEED = (R0_END > RFF_END ? (R0_END > R1_END ? R0_END : R1_END) : (RFF_END > R1_END ? RFF_END : R1_END));

struct Params {
    const float *x, *c, *ctx, *c_ctx, *norm1_w, *norm2_w, *w_mod, *b_mod, *w_ff1, *w_ff2;
    const float *w_in_even, *na_rpb, *lru_conv_w, *lru_conv_b, *lru_wa, *lru_ba, *lru_wx, *lru_bx, *lru_lambda, *w_out_even;
    const float *w_in_odd, *gla_wa2, *gla_ba, *gla_norm_w, *gqa_q_norm_w, *gqa_k_norm_w, *w_out_odd, *final_norm_w;
    float* out;
    unsigned char* ws;
    int ph_lo, ph_hi;
};

__device__ __forceinline__ unsigned f2bf(float f) { unsigned u = __float_as_uint(f); u += 0x7fffu + ((u >> 16) & 1u); return u >> 16; }
__device__ __forceinline__ unsigned pack2(float a, float b) { return f2bf(a) | (f2bf(b) << 16); }
__device__ __forceinline__ float bf2f(unsigned h) { return __uint_as_float(h << 16); }
__device__ __forceinline__ float bflo(unsigned w) { return __uint_as_float(w << 16); }
__device__ __forceinline__ float bfhi(unsigned w) { return __uint_as_float(w & 0xffff0000u); }
__device__ __forceinline__ float sigmoidf_(float z) { return 1.f / (1.f + __expf(-z)); }
__device__ __forceinline__ float wave_sum(float v) {
#pragma unroll
    for (int o = 32; o > 0; o >>= 1) v += __shfl_xor(v, o);
    return v;
}
__device__ __forceinline__ int clampi(int v, int lo, int hi) { return v < lo ? lo : (v > hi ? hi : v); }

__device__ __forceinline__ void tr_job(float* tile, const float* __restrict__ src, int Nsrc, bf16_t* __restrict__ dst, int K, int Ndst, int mode) {
    const int tid = threadIdx.x;
    const int nkt = K >> 6, ntiles = (Ndst >> 6) * nkt;
    for (int t = blockIdx.x; t < ntiles; t += gridDim.x) {
        const int n0 = (t / nkt) << 6, k0 = (t % nkt) << 6;
        __syncthreads();
        {
            const int n = tid & 63; const int nn = n0 + n; bool valid = true; int on = nn;
            if (mode == 1) { if (nn >= 2336) valid = false; else if (nn >= 2304) on = nn - 2304 + 1536; else if (nn >= 1536) on = nn + 32; }
#pragma unroll
            for (int i = 0; i < 16; ++i) { const int k = i * 4 + (tid >> 6); tile[k * 65 + n] = valid ? src[(size_t)(k0 + k) * Nsrc + on] : 0.f; }
        }
        __syncthreads();
        {
            const int n = tid >> 2, kq = (tid & 3) * 16; unsigned w[8];
#pragma unroll
            for (int j = 0; j < 8; ++j) w[j] = pack2(tile[(kq + 2 * j) * 65 + n], tile[(kq + 2 * j + 1) * 65 + n]);
            u32x4* d = (u32x4*)(dst + (size_t)(n0 + n) * K + k0 + kq);
            d[0] = (u32x4){w[0], w[1], w[2], w[3]}; d[1] = (u32x4){w[4], w[5], w[6], w[7]};
        }
    }
}

__device__ __forceinline__ void phase_prologue(const Params& p, char* smem) {
    const int tid = threadIdx.x, bid = blockIdx.x, nblk = gridDim.x;
    unsigned char* ws = p.ws;
    {
        float* sv = (float*)smem; float* red = sv + 3072; float* MOD = (float*)(ws + WS_MOD);
        for (int i = tid; i < 3072; i += 256) { const int j = i >> 10, k = i & 1023; const float v = j < 2 ? p.c[j * 1024 + k] : p.c_ctx[k]; sv[i] = v / (1.f + __expf(-v)); }
        __syncthreads();
        for (int it = bid; it < 192; it += nblk) {
            const int l = it / 96, n0 = (it % 96) * 64, col = tid & 63, kg = tid >> 6;
            const float* w = p.w_mod + (size_t)l * 1024 * 6144 + n0 + col;
            float a0 = 0.f, a1 = 0.f, a2 = 0.f;
#pragma unroll 8
            for (int k = kg * 256; k < kg * 256 + 256; ++k) { const float wv = w[(size_t)k * 6144]; a0 += sv[k] * wv; a1 += sv[1024 + k] * wv; a2 += sv[2048 + k] * wv; }
            red[(kg * 3 + 0) * 64 + col] = a0; red[(kg * 3 + 1) * 64 + col] = a1; red[(kg * 3 + 2) * 64 + col] = a2;
            __syncthreads();
            if (tid < 192) { const int j = tid >> 6, cc = tid & 63;
                const float s = red[(0 * 3 + j) * 64 + cc] + red[(1 * 3 + j) * 64 + cc] + red[(2 * 3 + j) * 64 + cc] + red[(3 * 3 + j) * 64 + cc];
                MOD[(l * 3 + j) * 6144 + n0 + cc] = s + p.b_mod[l * 6144 + n0 + cc]; }
            __syncthreads();
        }
    }
    {
        const int gt = bid * 256 + tid, gn = nblk * 256;
        float2* rope = (float2*)(ws + WS_ROPE);
        for (int i = gt; i < 2048; i += gn) { const int pos = i >> 4, f = i & 15; const float inv = powf(10000.f, -(float)f / 16.f); const float ang = (float)pos * inv; float s, c; sincosf(ang, &s, &c); rope[i] = make_float2(c, s); }
        bf16_t* wl = (bf16_t*)(ws + WS_WLRU);
        for (int i = gt; i < 2048 * 64; i += gn) { const int n = i >> 6, k = i & 63; const int h = n >> 8, d = (n >> 7) & 1, j = (n & 127) >> 1, g = n & 1;
            const float* W = g ? p.lru_wx : p.lru_wa; wl[i] = (bf16_t)f2bf(W[(((size_t)(d * 8 + h) * 64 + k) * 64) + j]); }
    }
    float* tile = (float*)smem;
    for (int l = 0; l < 2; ++l) {
        tr_job(tile, p.w_ff1 + (size_t)l * 1024 * 4096, 4096, (bf16_t*)(ws + WS_WFF1) + (size_t)l * 4096 * 1024, 1024, 4096, 0);
        tr_job(tile, p.w_ff2 + (size_t)l * 4096 * 1024, 1024, (bf16_t*)(ws + WS_WFF2) + (size_t)l * 4096 * 1024, 4096, 1024, 0);
    }
    tr_job(tile, p.w_in_even, 2560, (bf16_t*)(ws + WS_WINE), 1024, 2560, 0);
    tr_job(tile, p.w_out_even, 1024, (bf16_t*)(ws + WS_WOUTE), 1024, 1024, 0);
    tr_job(tile, p.w_in_odd, 2336, (bf16_t*)(ws + WS_WINO), 1024, 2432, 1);
    tr_job(tile, p.w_out_odd, 1024, (bf16_t*)(ws + WS_WOUTO), 1024, 1024, 0);
}

__device__ __forceinline__ void phase_ln(const float* __restrict__ srcL, const float* __restrict__ srcC, const float* __restrict__ nw, const float* __restrict__ mod, int sh_slot, int sc_slot, bool latent_only, bf16_t* __restrict__ U) {
    const int lane = threadIdx.x & 63, gw = blockIdx.x * 4 + (threadIdx.x >> 6), nwt = gridDim.x * 4;
    const int nrows = latent_only ? NB * SEQ : NR;
    for (int idx = gw; idx < nrows; idx += nwt) {
        int b, pi; if (latent_only) { b = idx >> 13; pi = 256 + (idx & 8191); } else { b = idx / PP; pi = idx - b * PP; }
        const int R = b * PP + pi; const bool isc = pi < 256; const int ms = isc ? 2 : b;
        const float* src = isc ? srcC + (size_t)(b * 256 + pi) * 1024 : srcL + (size_t)(b * 8192 + pi - 256) * 1024;
        f32x4 v[4]; float ss = 0.f;
#pragma unroll
        for (int i = 0; i < 4; ++i) { v[i] = *(const f32x4*)(src + i * 256 + lane * 4); ss += v[i][0] * v[i][0] + v[i][1] * v[i][1] + v[i][2] * v[i][2] + v[i][3] * v[i][3]; }
        ss = wave_sum(ss);
        const float rstd = rsqrtf(ss * (1.f / 1024.f) + EPS);
        const float* sh = mod + ms * 6144 + sh_slot * 1024; const float* sc = mod + ms * 6144 + sc_slot * 1024;
#pragma unroll
        for (int i = 0; i < 4; ++i) { const int n = i * 256 + lane * 4;
            const f32x4 w4 = *(const f32x4*)(nw + n), s4 = *(const f32x4*)(sc + n), h4 = *(const f32x4*)(sh + n);
            const f32x4 y = v[i] * rstd * w4 * (s4 + 1.f) + h4;
            *(u32x2*)(U + (size_t)R * 1024 + n) = (u32x2){pack2(y[0], y[1]), pack2(y[2], y[3])}; }
    }
}

__device__ __forceinline__ void phase_final(const float* __restrict__ fw, float* __restrict__ out) {
    const int lane = threadIdx.x & 63, gw = blockIdx.x * 4 + (threadIdx.x >> 6), nwt = gridDim.x * 4;
    for (int idx = gw; idx < NB * SEQ; idx += nwt) {
        float* row = out + (size_t)idx * 1024;
        f32x4 v[4]; float ss = 0.f;
#pragma unroll
        for (int i = 0; i < 4; ++i) { v[i] = *(const f32x4*)(row + i * 256 + lane * 4); ss += v[i][0] * v[i][0] + v[i][1] * v[i][1] + v[i][2] * v[i][2] + v[i][3] * v[i][3]; }
        ss = wave_sum(ss);
        const float rstd = rsqrtf(ss * (1.f / 1024.f) + EPS);
#pragma unroll
        for (int i = 0; i < 4; ++i) { const int n = i * 256 + lane * 4; const f32x4 w4 = *(const f32x4*)(fw + n); *(f32x4*)(row + n) = v[i] * rstd * w4; }
    }
}

template <class Epi>
__device__ __forceinline__ void gemm_phase(char* smem, const bf16_t* __restrict__ A, int lda, const bf16_t* __restrict__ WT, int K, int nMt, int nNt, int rowmode, int lru, const Epi& epi) {
    bf16_t* As = (bf16_t*)smem; bf16_t* Bs = As + 128 * 72;
    const int tid = threadIdx.x, lane = tid & 63, wid = tid >> 6, wm = wid >> 1, wn = wid & 1;
    const int lr = lane & 15, lq = lane >> 4;
    const int ntiles = nMt * nNt;
    for (int tile = blockIdx.x; tile < ntiles; tile += gridDim.x) {
        const int mt = tile / nNt, nt = tile - mt * nNt;
        const int row0 = rowmode ? ((mt >> 6) * PP + 256 + (mt & 63) * 128) : mt * 128;
        const bf16_t* Ag = A + (size_t)row0 * lda + (lru ? (nt >> 1) * 64 : 0);
        const bf16_t* Bg = WT + (size_t)nt * 128 * K;
        f32x4 acc[4][4];
#pragma unroll
        for (int i = 0; i < 4; ++i)
#pragma unroll
            for (int j = 0; j < 4; ++j) acc[i][j] = (f32x4){0.f, 0.f, 0.f, 0.f};
        u32x4 ra[4], rb[4];
#pragma unroll
        for (int i = 0; i < 4; ++i) { const int c = tid + 256 * i, r = c >> 3, kc = (c & 7) * 8; ra[i] = *(const u32x4*)(Ag + (size_t)r * lda + kc); rb[i] = *(const u32x4*)(Bg + (size_t)r * K + kc); }
        for (int k0 = 0; k0 < K; k0 += 64) {
            __syncthreads();
#pragma unroll
            for (int i = 0; i < 4; ++i) { const int c = tid + 256 * i, r = c >> 3, kc = (c & 7) * 8; *(u32x4*)(As + r * 72 + kc) = ra[i]; *(u32x4*)(Bs + r * 72 + kc) = rb[i]; }
            __syncthreads();
            if (k0 + 64 < K) {
#pragma unroll
                for (int i = 0; i < 4; ++i) { const int c = tid + 256 * i, r = c >> 3, kc = (c & 7) * 8 + k0 + 64; ra[i] = *(const u32x4*)(Ag + (size_t)r * lda + kc); rb[i] = *(const u32x4*)(Bg + (size_t)r * K + kc); }
            }
#pragma unroll
            for (int ks = 0; ks < 2; ++ks) {
                bf16x8 af[4], bfr[4];
#pragma unroll
                for (int i = 0; i < 4; ++i) { af[i] = *(const bf16x8*)(As + (wm * 64 + i * 16 + lr) * 72 + ks * 32 + lq * 8); bfr[i] = *(const bf16x8*)(Bs + (wn * 64 + i * 16 + lr) * 72 + ks * 32 + lq * 8); }
#pragma unroll
                for (int mi = 0; mi < 4; ++mi)
#pragma unroll
                    for (int ni = 0; ni < 4; ++ni) acc[mi][ni] = __builtin_amdgcn_mfma_f32_16x16x32_bf16(bfr[ni], af[mi], acc[mi][ni], 0, 0, 0);
            }
        }
        epi(acc, row0 + wm * 64, nt * 128 + wn * 64, lane);
    }
}

struct EpiResid {
    const float* srcL; const float* srcC; float* dstL; float* dstC; const float* mod; int slot;
    __device__ __forceinline__ void operator()(const f32x4 (&acc)[4][4], int Rb, int nb, int lane) const {
        const int lr = lane & 15, lq = lane >> 4;
#pragma unroll
        for (int mi = 0; mi < 4; ++mi) {
            const int R = Rb + mi * 16 + lr; const int b = R / PP, pi = R - b * PP; const bool isc = pi < 256; const int ms = isc ? 2 : b;
            const size_t ro = isc ? (size_t)(b * 256 + pi) * 1024 : (size_t)(b * 8192 + pi - 256) * 1024;
            const float* s = (isc ? srcC : srcL) + ro; float* d = (isc ? dstC : dstL) + ro; const float* g = mod + ms * 6144 + slot * 1024;
#pragma unroll
            for (int ni = 0; ni < 4; ++ni) { const int n = nb + ni * 16 + lq * 4; const f32x4 h = *(const f32x4*)(s + n), gg = *(const f32x4*)(g + n); *(f32x4*)(d + n) = h + gg * acc[mi][ni]; }
        }
    }
};
struct EpiFF1 {
    bf16_t* FF;
    __device__ __forceinline__ void operator()(const f32x4 (&acc)[4][4], int Rb, int nb, int lane) const {
        const int lr = lane & 15, lq = lane >> 4;
#pragma unroll
        for (int mi = 0; mi < 4; ++mi) { const int R = Rb + mi * 16 + lr;
#pragma unroll
            for (int ni = 0; ni < 4; ++ni) { const int n = nb + ni * 16 + lq * 4; f32x4 v = acc[mi][ni];
#pragma unroll
                for (int e = 0; e < 4; ++e) { const float r = fmaxf(v[e], 0.f); v[e] = r * r; }
                *(u32x2*)(FF + (size_t)R * 4096 + n) = (u32x2){pack2(v[0], v[1]), pack2(v[2], v[3])}; } }
    }
};
__device__ __forceinline__ float gelu_tanh(float x) { const float u = 0.7978845608028654f * (x + 0.044715f * x * x * x); const float t = 1.f - 2.f / (1.f + __expf(2.f * u)); return 0.5f * x * (1.f + t); }
struct EpiInEven {
    bf16_t *Qn, *Kn, *VTn, *XL, *GG;
    __device__ __forceinline__ void operator()(const f32x4 (&acc)[4][4], int Rb, int nb, int lane) const {
        const int lr = lane & 15, lq = lane >> 4;
#pragma unroll
        for (int mi = 0; mi < 4; ++mi) { const int R = Rb + mi * 16 + lr; const int b = R / PP, pi = R - b * PP;
#pragma unroll
            for (int ni = 0; ni < 4; ++ni) { const int n = nb + ni * 16 + lq * 4; const f32x4 a = acc[mi][ni];
                if (n < 512) *(u32x2*)(Qn + (size_t)R * 512 + n) = (u32x2){pack2(a[0] * 0.125f, a[1] * 0.125f), pack2(a[2] * 0.125f, a[3] * 0.125f)};
                else if (n < 1024) *(u32x2*)(Kn + (size_t)R * 512 + (n - 512)) = (u32x2){pack2(a[0], a[1]), pack2(a[2], a[3])};
                else if (n < 1536) { const int hh = (n - 1024) >> 6, d0 = (n - 1024) & 63; bf16_t* vp = VTn + ((size_t)((b * 8 + hh) * 64 + d0)) * PP + pi;
#pragma unroll
                    for (int e = 0; e < 4; ++e) vp[(size_t)e * PP] = (bf16_t)f2bf(a[e]); }
                else if (n < 2048) *(u32x2*)(XL + (size_t)R * 512 + (n - 1536)) = (u32x2){pack2(a[0], a[1]), pack2(a[2], a[3])};
                else *(u32x2*)(GG + (size_t)R * 512 + (n - 2048)) = (u32x2){pack2(gelu_tanh(a[0]), gelu_tanh(a[1])), pack2(gelu_tanh(a[2]), gelu_tanh(a[3]))};
            } }
    }
};
struct EpiLru {
    const bf16_t* XC; __half2* AB; const float *ba, *bx, *lam;
    __device__ __forceinline__ void operator()(const f32x4 (&acc)[4][4], int Rb, int nb, int lane) const {
        const int lr = lane & 15, lq = lane >> 4;
        const int h = nb >> 8, d = (nb >> 7) & 1, colb = nb & 127;
#pragma unroll
        for (int mi = 0; mi < 4; ++mi) { const int R = Rb + mi * 16 + lr;
#pragma unroll
            for (int ni = 0; ni < 4; ++ni) { const int j0 = (colb + ni * 16 + lq * 4) >> 1; const int c = h * 64 + j0; __half2 o[2];
#pragma unroll
                for (int e2 = 0; e2 < 2; ++e2) { const int cc = c + e2;
                    const float za = acc[mi][ni][2 * e2] + ba[d * 512 + cc], zx = acc[mi][ni][2 * e2 + 1] + bx[d * 512 + cc];
                    const float r = sigmoidf_(za), ig = sigmoidf_(zx);
                    const float sp = log1pf(__expf(-lam[d * 512 + cc]));
                    const float la = -8.f * r * sp;
                    const float xv = bf2f(XC[(size_t)R * 512 + cc]);
                    const float bb = sqrtf(fmaxf(-expm1f(2.f * la), 0.f)) * ig * xv;
                    o[e2] = __floats2half2_rn(la, bb); }
                __half2* dst = AB + ((size_t)d * NR + R) * 512 + c; dst[0] = o[0]; dst[1] = o[1]; } }
    }
};
struct EpiInOdd {
    bf16_t *Gq, *Gk, *Gv, *Gg, *Qg, *Kg, *VTg; float* LR; const float *qnw, *knw; const float2* rope;
    __device__ __forceinline__ void operator()(const f32x4 (&acc)[4][4], int Rb, int nb, int lane) const {
        const int lr = lane & 15, lq = lane >> 4;
        if (nb < 1536) {
#pragma unroll
            for (int mi = 0; mi < 4; ++mi) { const int R = Rb + mi * 16 + lr;
#pragma unroll
                for (int ni = 0; ni < 4; ++ni) { const int n = nb + ni * 16 + lq * 4; const f32x4 a = acc[mi][ni];
                    if (n < 256) *(u32x2*)(Gq + (size_t)R * 256 + n) = (u32x2){pack2(a[0], a[1]), pack2(a[2], a[3])};
                    else if (n < 512) *(u32x2*)(Gk + (size_t)R * 256 + (n - 256)) = (u32x2){pack2(a[0], a[1]), pack2(a[2], a[3])};
                    else if (n < 1024) *(u32x2*)(Gv + (size_t)R * 512 + (n - 512)) = (u32x2){pack2(a[0], a[1]), pack2(a[2], a[3])};
                    else { f32x4 s;
#pragma unroll
                        for (int e = 0; e < 4; ++e) s[e] = a[e] * sigmoidf_(a[e]);
                        *(u32x2*)(Gg + (size_t)R * 512 + (n - 1024)) = (u32x2){pack2(s[0], s[1]), pack2(s[2], s[3])}; } } }
        } else if (nb < 2176) {
            const bool isq = nb < 2048; const float* nwp = isq ? qnw : knw;
#pragma unroll
            for (int mi = 0; mi < 4; ++mi) { const int R = Rb + mi * 16 + lr; const int b = R / PP, pi = R - b * PP;
                float ss = 0.f;
#pragma unroll
                for (int ni = 0; ni < 4; ++ni)
#pragma unroll
                    for (int e = 0; e < 4; ++e) ss += acc[mi][ni][e] * acc[mi][ni][e];
                ss += __shfl_xor(ss, 16); ss += __shfl_xor(ss, 32);
                const float rstd = rsqrtf(ss * (1.f / 64.f) + EPS);
                f32x4 y[4];
#pragma unroll
                for (int ni = 0; ni < 4; ++ni) { const f32x4 w4 = *(const f32x4*)(nwp + ni * 16 + lq * 4); y[ni] = acc[mi][ni] * rstd * w4; }
                if (pi >= 256) { const int t = pi - 256, prow = t >> 6, pcol = t & 63;
#pragma unroll
                    for (int e = 0; e < 4; ++e) { const int i = lq * 4 + e; const float2 cr = rope[prow * 16 + i], cc = rope[pcol * 16 + i];
                        const float a1 = y[0][e], a2 = y[1][e]; y[0][e] = a1 * cr.x - a2 * cr.y; y[1][e] = a2 * cr.x + a1 * cr.y;
                        const float b1 = y[2][e], b2 = y[3][e]; y[2][e] = b1 * cc.x - b2 * cc.y; y[3][e] = b2 * cc.x + b1 * cc.y; } }
                if (isq) {
#pragma unroll
                    for (int ni = 0; ni < 4; ++ni) { const f32x4 v = y[ni] * 0.125f; *(u32x2*)(Qg + (size_t)R * 512 + (nb - 1536) + ni * 16 + lq * 4) = (u32x2){pack2(v[0], v[1]), pack2(v[2], v[3])}; }
                } else {
#pragma unroll
                    for (int ni = 0; ni < 4; ++ni) { const f32x4 v = y[ni]; *(u32x2*)(Kg + (size_t)R * 128 + (nb - 2048) + ni * 16 + lq * 4) = (u32x2){pack2(v[0], v[1]), pack2(v[2], v[3])}; }
                } }
        } else if (nb < 2304) {
            const int kvh = (nb - 2176) >> 6;
#pragma unroll
            for (int mi = 0; mi < 4; ++mi) { const int R = Rb + mi * 16 + lr; const int b = R / PP, pi = R - b * PP;
#pragma unroll
                for (int ni = 0; ni < 4; ++ni) { bf16_t* vp = VTg + ((size_t)((b * 2 + kvh) * 64 + ni * 16 + lq * 4)) * PP + pi;
#pragma unroll
                    for (int e = 0; e < 4; ++e) vp[(size_t)e * PP] = (bf16_t)f2bf(acc[mi][ni][e]); } }
        } else if (nb == 2304) {
#pragma unroll
            for (int mi = 0; mi < 4; ++mi) { const int R = Rb + mi * 16 + lr;
#pragma unroll
                for (int ni = 0; ni < 2; ++ni) *(f32x4*)(LR + (size_t)R * 32 + ni * 16 + lq * 4) = acc[mi][ni]; }
        }
    }
};

__device__ __forceinline__ void attn_unit(char* smem, const bf16_t* __restrict__ Qp, int ldq, const bf16_t* __restrict__ Kp, int ldk, const bf16_t* __restrict__ VTp,
                                          bf16_t* __restrict__ Op, int ldo, int ntiles, int mode, int r0, int rs0, const float* __restrict__ rpb_h) {
    bf16_t* Ks = (bf16_t*)smem;
    bf16_t* Vs = Ks + 2 * 64 * 72;
    float* rp = (float*)(Vs + 2 * 64 * 72);
    const int tid = threadIdx.x, lane = tid & 63, w = tid >> 6, l31 = lane & 31, lh = lane >> 5;
    if (mode == 1) { for (int i = tid; i < 465; i += 256) rp[i] = rpb_h[i]; }
    bf16x8 qf[4];
    { const bf16_t* q = Qp + (size_t)(w * 32 + l31) * ldq + lh * 8;
#pragma unroll
        for (int ks = 0; ks < 4; ++ks) qf[ks] = *(const bf16x8*)(q + ks * 16); }
    f32x16 ot[2];
#pragma unroll
    for (int i = 0; i < 16; ++i) { ot[0][i] = 0.f; ot[1][i] = 0.f; }
    float m = -1e30f, l = 0.f;
    u32x4 rk[2], rv[2];
#define ATT_GLOAD(t_) do { const int t__ = (t_); const int pos__ = (mode == 1) ? (t__ < 4 ? t__ * 64 : 256 + (rs0 + t__ - 4) * 64) : t__ * 64; \
        _Pragma("unroll") for (int i = 0; i < 2; ++i) { const int c = tid + 256 * i, r = c >> 3, cc = (c & 7) * 8; \
            rk[i] = *(const u32x4*)(Kp + (size_t)(pos__ + r) * ldk + cc); rv[i] = *(const u32x4*)(VTp + (size_t)r * PP + pos__ + cc); } } while (0)
#define ATT_SSTORE(buf_) do { _Pragma("unroll") for (int i = 0; i < 2; ++i) { const int c = tid + 256 * i, r = c >> 3, cc = (c & 7) * 8; \
            *(u32x4*)(Ks + (buf_) * 64 * 72 + r * 72 + cc) = rk[i]; *(u32x4*)(Vs + (buf_) * 64 * 72 + r * 72 + cc) = rv[i]; } } while (0)
    ATT_GLOAD(0); ATT_SSTORE(0); __syncthreads();
    for (int t = 0; t < ntiles; ++t) {
        if (t + 1 < ntiles) ATT_GLOAD(t + 1);
        const bf16_t* ks_ = Ks + (t & 1) * 64 * 72; const bf16_t* vs_ = Vs + (t & 1) * 64 * 72;
        bool skip = false; int kr = 0, rq = 0;
        const bool local = (mode == 1) && (t >= 4);
        if (local) { kr = rs0 + t - 4; rq = r0 + (w >> 1); const int rsq = clampi(rq - 4, 0, 120); skip = (kr < rsq) || (kr >= rsq + 8); }
        if (!skip) {
            f32x16 st[2];
#pragma unroll
            for (int i = 0; i < 16; ++i) { st[0][i] = 0.f; st[1][i] = 0.f; }
#pragma unroll
            for (int kt = 0; kt < 2; ++kt)
#pragma unroll
                for (int ks = 0; ks < 4; ++ks) { const bf16x8 kf = *(const bf16x8*)(ks_ + (kt * 32 + l31) * 72 + ks * 16 + lh * 8); st[kt] = __builtin_amdgcn_mfma_f32_32x32x16_bf16(kf, qf[ks], st[kt], 0, 0, 0); }
            if (local) { const int qc = (w & 1) * 32 + l31, cs = clampi(qc - 8, 0, 48); const float* rrow = rp + (kr - rq + 7) * 31;
#pragma unroll
                for (int kt = 0; kt < 2; ++kt)
#pragma unroll
                    for (int i = 0; i < 16; ++i) { const int kc = kt * 32 + (i & 3) + 8 * (i >> 2) + 4 * lh; const bool ok = (kc >= cs) && (kc < cs + 16);
                        const float bias = rrow[clampi(kc - qc + 15, 0, 30)]; st[kt][i] = ok ? st[kt][i] + bias : -1e30f; } }
            float mx = st[0][0];
#pragma unroll
            for (int i = 1; i < 16; ++i) mx = fmaxf(mx, st[0][i]);
#pragma unroll
            for (int i = 0; i < 16; ++i) mx = fmaxf(mx, st[1][i]);
            mx = fmaxf(mx, __shfl_xor(mx, 32));
            const float mn = fmaxf(m, mx); const float alpha = exp2f((m - mn) * LOG2E); m = mn;
            const float mb = mn * LOG2E; float ps = 0.f;
#pragma unroll
            for (int kt = 0; kt < 2; ++kt)
#pragma unroll
                for (int i = 0; i < 16; ++i) { const float pe = exp2f(st[kt][i] * LOG2E - mb); st[kt][i] = pe; ps += pe; }
            l = l * alpha + ps;
#pragma unroll
            for (int i = 0; i < 16; ++i) { ot[0][i] *= alpha; ot[1][i] *= alpha; }
#pragma unroll
            for (int kt = 0; kt < 2; ++kt)
#pragma unroll
                for (int s = 0; s < 2; ++s) {
                    u32x4 pw; pw[0] = pack2(st[kt][8 * s + 0], st[kt][8 * s + 1]); pw[1] = pack2(st[kt][8 * s + 2], st[kt][8 * s + 3]); pw[2] = pack2(st[kt][8 * s + 4], st[kt][8 * s + 5]); pw[3] = pack2(st[kt][8 * s + 6], st[kt][8 * s + 7]);
                    const bf16x8 pf = __builtin_bit_cast(bf16x8, pw);
#pragma unroll
                    for (int dt = 0; dt < 2; ++dt) { const bf16_t* vp = vs_ + (dt * 32 + l31) * 72 + kt * 32 + s * 16 + lh * 4;
                        const u32x2 v0 = *(const u32x2*)vp, v1 = *(const u32x2*)(vp + 8); const u32x4 vw = (u32x4){v0[0], v0[1], v1[0], v1[1]};
                        ot[dt] = __builtin_amdgcn_mfma_f32_32x32x16_bf16(__builtin_bit_cast(bf16x8, vw), pf, ot[dt], 0, 0, 0); } }
        }
        if (t + 1 < ntiles) ATT_SSTORE((t + 1) & 1);
        __syncthreads();
    }
#undef ATT_GLOAD
#undef ATT_SSTORE
    l += __shfl_xor(l, 32);
    const float inv = 1.f / l;
    bf16_t* o = Op + (size_t)(w * 32 + l31) * ldo;
#pragma unroll
    for (int dt = 0; dt < 2; ++dt)
#pragma unroll
        for (int g = 0; g < 4; ++g) { const int d = dt * 32 + 8 * g + 4 * lh;
            *(u32x2*)(o + d) = (u32x2){pack2(ot[dt][4 * g] * inv, ot[dt][4 * g + 1] * inv), pack2(ot[dt][4 * g + 2] * inv, ot[dt][4 * g + 3] * inv)}; }
}

__device__ __forceinline__ void phase_na(const Params& p, char* smem) {
    unsigned char* ws = p.ws;
    const bf16_t* Qn = (const bf16_t*)(ws + R0_Q); const bf16_t* Kn = (const bf16_t*)(ws + R0_K); const bf16_t* VTn = (const bf16_t*)(ws + R0_VT);
    bf16_t* MO = (bf16_t*)(ws + WS_U);
    for (int u = blockIdx.x; u < 1024 + 32; u += gridDim.x) {
        if (u < 1024) { const int b = u >> 9, h = (u >> 6) & 7, qb = u & 63; const int r0 = qb * 2;
            const int rs0 = clampi(r0 - 4, 0, 120), rs1 = clampi(r0 - 3, 0, 120); const int nl = rs1 + 8 - rs0;
            const size_t Rq = (size_t)b * PP + 256 + qb * 128;
            attn_unit(smem, Qn + Rq * 512 + h * 64, 512, Kn + (size_t)b * PP * 512 + h * 64, 512, VTn + (size_t)((b * 8 + h) * 64) * PP, MO + Rq * 1024 + h * 64, 1024, 4 + nl, 1, r0, rs0, p.na_rpb + h * 465);
        } else { const int v = u - 1024; const int b = v >> 4, h = (v >> 1) & 7, qb = v & 1;
            const size_t Rq = (size_t)b * PP + qb * 128;
            attn_unit(smem, Qn + Rq * 512 + h * 64, 512, Kn + (size_t)b * PP * 512 + h * 64, 512, VTn + (size_t)((b * 8 + h) * 64) * PP, MO + Rq * 1024 + h * 64, 1024, 4, 0, 0, 0, nullptr);
        }
    }
    const bf16_t* XL = (const bf16_t*)(ws + R0_XL); bf16_t* XC = (bf16_t*)(ws + R0_XC);
    const int gt = blockIdx.x * 256 + threadIdx.x, gn = gridDim.x * 256;
    for (int idx = gt; idx < NR * 64; idx += gn) {
        const int R = idx >> 6, c8 = (idx & 63) * 8; const int b = R / PP, pi = R - b * PP; const int lo = pi < 256 ? 0 : 256, hi = pi < 256 ? 256 : PP;
        float a[8];
        { const f32x4 b0 = *(const f32x4*)(p.lru_conv_b + c8), b1 = *(const f32x4*)(p.lru_conv_b + c8 + 4); a[0] = b0[0]; a[1] = b0[1]; a[2] = b0[2]; a[3] = b0[3]; a[4] = b1[0]; a[5] = b1[1]; a[6] = b1[2]; a[7] = b1[3]; }
#pragma unroll
        for (int j = 0; j < 4; ++j) { const int pj = pi + j - 2;
            if (pj >= lo && pj < hi) { const u32x4 xv = *(const u32x4*)(XL + (size_t)(b * PP + pj) * 512 + c8);
                const f32x4 w0 = *(const f32x4*)(p.lru_conv_w + j * 512 + c8), w1 = *(const f32x4*)(p.lru_conv_w + j * 512 + c8 + 4);
                a[0] += w0[0] * bflo(xv[0]); a[1] += w0[1] * bfhi(xv[0]); a[2] += w0[2] * bflo(xv[1]); a[3] += w0[3] * bfhi(xv[1]);
                a[4] += w1[0] * bflo(xv[2]); a[5] += w1[1] * bfhi(xv[2]); a[6] += w1[2] * bflo(xv[3]); a[7] += w1[3] * bfhi(xv[3]); } }
        *(u32x4*)(XC + (size_t)R * 512 + c8) = (u32x4){pack2(a[0], a[1]), pack2(a[2], a[3]), pack2(a[4], a[5]), pack2(a[6], a[7])};
    }
}

__device__ __forceinline__ void phase_scan1(const Params& p) {
    const __half2* AB = (const __half2*)(p.ws + R0_AB); float2* SUM = (float2*)(p.ws + R0_SUM);
    for (int it = blockIdx.x; it < 1056; it += gridDim.x) {
        const int cgp = it & 1, tc = (it >> 1) % 132, db = (it >> 1) / 132, b = db & 1, d = db >> 1;
        const int c = cgp * 256 + threadIdx.x;
        const __half2* ab = AB + ((size_t)d * NR + (size_t)b * PP + tc * 64) * 512 + c;
        float h = 0.f, ap = 0.f;
#pragma unroll 8
        for (int s = 0; s < 64; ++s) { const int tt = d ? 63 - s : s; const __half2 v = ab[(size_t)tt * 512]; const float la = __low2float(v), bb = __high2float(v); h = __expf(la) * h + bb; ap += la; }
        SUM[((size_t)(d * 2 + b) * 132 + tc) * 512 + c] = make_float2(__expf(ap), h);
    }
}
__device__ __forceinline__ void phase_scan2(const Params& p) {
    const __half2* AB = (const __half2*)(p.ws + R0_AB); const float2* SUM = (const float2*)(p.ws + R0_SUM);
    const bf16_t* GG = (const bf16_t*)(p.ws + R0_GG); bf16_t* MO = (bf16_t*)(p.ws + WS_U);
    for (int it = blockIdx.x; it < 528; it += gridDim.x) {
        const int cgp = it & 1, tc = (it >> 1) % 132, b = (it >> 1) / 132;
        const int c = cgp * 256 + threadIdx.x; const size_t R0 = (size_t)b * PP + tc * 64;
        float hf[64];
        {
            float h = 0.f; const float2* sm = SUM + ((size_t)(0 * 2 + b) * 132) * 512 + c;
            for (int jj = 0; jj < tc; ++jj) { const float2 s = sm[(size_t)jj * 512]; h = s.x * h + s.y; }
            const __half2* ab = AB + ((size_t)0 * NR + R0) * 512 + c;
#pragma unroll
            for (int s = 0; s < 64; ++s) { const __half2 v = ab[(size_t)s * 512]; h = __expf(__low2float(v)) * h + __high2float(v); hf[s] = h; }
        }
        {
            const int j = tc < 4 ? 3 - tc : 135 - tc;
            float h = 0.f; const float2* sm = SUM + ((size_t)(1 * 2 + b) * 132) * 512 + c;
            for (int jj = 0; jj < j; ++jj) { const int tcj = jj < 4 ? 3 - jj : 135 - jj; const float2 s = sm[(size_t)tcj * 512]; h = s.x * h + s.y; }
            const __half2* ab = AB + ((size_t)1 * NR + R0) * 512 + c;
#pragma unroll
            for (int s = 0; s < 64; ++s) { const int tt = 63 - s; const __half2 v = ab[(size_t)tt * 512]; h = __expf(__low2float(v)) * h + __high2float(v);
                const float g = bf2f(GG[(R0 + tt) * 512 + c]);
                MO[(R0 + tt) * 1024 + 512 + c] = (bf16_t)f2bf((hf[tt] + h) * g); }
        }
    }
}

__device__ __forceinline__ void gla_gates(const Params& p, float* gs, const float* __restrict__ LR, size_t R0, int d, int h) {
    const int tid = threadIdx.x, dk = tid & 63, tg = tid >> 6;
    float wv[16];
#pragma unroll
    for (int r = 0; r < 16; ++r) wv[r] = p.gla_wa2[(d * 16 + r) * 256 + h * 64 + dk];
    const float bav = p.gla_ba[d * 256 + h * 64 + dk];
    for (int ti = 0; ti < 16; ++ti) { const int t = tg * 16 + ti; const float* lrp = LR + (R0 + t) * 32 + d * 16; float z = bav;
#pragma unroll
        for (int r = 0; r < 16; ++r) z += lrp[r] * wv[r];
        const float ls = fminf(z, 0.f) - log1pf(__expf(-fabsf(z))); gs[t * 64 + dk] = ls * (1.f / 16.f); }
    __syncthreads();
    if (tid < 64) { float s = 0.f;
        if (d == 0) { for (int t = 0; t < 64; ++t) { s += gs[t * 64 + tid]; gs[t * 64 + tid] = s; } }
        else { for (int t = 63; t >= 0; --t) { s += gs[t * 64 + tid]; gs[t * 64 + tid] = s; } } }
    __syncthreads();
}
__device__ __forceinline__ void gla_load_vt(bf16_t* VTs, const bf16_t* __restrict__ Gv, size_t R0, int h) {
    const int tid = threadIdx.x, t = tid >> 2, vq = (tid & 3) * 32; const bf16_t* src = Gv + (R0 + t) * 512 + h * 128 + vq;
#pragma unroll
    for (int q = 0; q < 4; ++q) { const u32x4 v = *(const u32x4*)(src + q * 8);
#pragma unroll
        for (int e = 0; e < 4; ++e) { VTs[(vq + q * 8 + 2 * e) * 72 + t] = (bf16_t)(v[e] & 0xffffu); VTs[(vq + q * 8 + 2 * e + 1) * 72 + t] = (bf16_t)(v[e] >> 16); } }
}
__device__ __forceinline__ void phase_gla1(const Params& p, char* smem) {
    unsigned char* ws = p.ws;
    const bf16_t* Gk = (const bf16_t*)(ws + R1_GK); const bf16_t* Gv = (const bf16_t*)(ws + R1_GV); const float* LR = (const float*)(ws + R1_LR);
    float* UC = (float*)(ws + R1_UC); float* DEC = (float*)(ws + R1_DEC);
    float* gs = (float*)smem; bf16_t* KD = (bf16_t*)(smem + 16384); bf16_t* VTs = KD + 64 * 72;
    const int tid = threadIdx.x, lane = tid & 63, w = tid >> 6, lr = lane & 15, lq = lane >> 4;
    for (int it = blockIdx.x; it < 2112; it += gridDim.x) {
        const int tc = it % 132, h = (it / 132) & 3, d = (it / 528) & 1, b = it / 1056;
        const size_t R0 = (size_t)b * PP + tc * 64;
        __syncthreads();
        gla_gates(p, gs, LR, R0, d, h);
        const int tl = d ? 0 : 63;
        { const int t = tid >> 2, dq = (tid & 3) * 16; const bf16_t* src = Gk + (R0 + t) * 256 + h * 64 + dq;
#pragma unroll
            for (int q = 0; q < 2; ++q) { const u32x4 v = *(const u32x4*)(src + q * 8);
#pragma unroll
                for (int e = 0; e < 4; ++e) { const int dk0 = dq + q * 8 + 2 * e;
                    const float k0 = bflo(v[e]) * __expf(gs[tl * 64 + dk0] - gs[t * 64 + dk0]); const float k1 = bfhi(v[e]) * __expf(gs[tl * 64 + dk0 + 1] - gs[t * 64 + dk0 + 1]);
                    KD[dk0 * 72 + t] = (bf16_t)f2bf(k0); KD[(dk0 + 1) * 72 + t] = (bf16_t)f2bf(k1); } } }
        gla_load_vt(VTs, Gv, R0, h);
        __syncthreads();
        f32x4 acc[8];
#pragma unroll
        for (int i = 0; i < 8; ++i) acc[i] = (f32x4){0.f, 0.f, 0.f, 0.f};
#pragma unroll
        for (int ks = 0; ks < 2; ++ks) { const bf16x8 a = *(const bf16x8*)(KD + (16 * w + lr) * 72 + ks * 32 + lq * 8);
#pragma unroll
            for (int nt = 0; nt < 8; ++nt) { const bf16x8 bb = *(const bf16x8*)(VTs + (16 * nt + lr) * 72 + ks * 32 + lq * 8); acc[nt] = __builtin_amdgcn_mfma_f32_16x16x32_bf16(a, bb, acc[nt], 0, 0, 0); } }
        const int j = d == 0 ? tc : (tc < 4 ? 3 - tc : 135 - tc);
        const size_t chain = (size_t)((b * 2 + d) * 4 + h);
        float* up = UC + (chain * 132 + j) * 8192;
#pragma unroll
        for (int nt = 0; nt < 8; ++nt)
#pragma unroll
            for (int e = 0; e < 4; ++e) up[(16 * w + 4 * lq + e) * 128 + 16 * nt + lr] = acc[nt][e];
        if (tid < 64) DEC[(chain * 132 + j) * 64 + tid] = __expf(gs[tl * 64 + tid]);
    }
}
__device__ __forceinline__ void phase_gla2(const Params& p) {
    float* UC = (float*)(p.ws + R1_UC); const float* DEC = (const float*)(p.ws + R1_DEC);
    const int gt = blockIdx.x * 256 + threadIdx.x, gn = gridDim.x * 256;
    for (int e = gt; e < 16 * 8192; e += gn) { const int chain = e >> 13, el = e & 8191, dk = el >> 7;
        float* u = UC + (size_t)chain * 132 * 8192 + el; const float* dec = DEC + (size_t)chain * 132 * 64 + dk; float S = 0.f;
#pragma unroll 4
        for (int j = 0; j < 132; ++j) { const float uv = u[(size_t)j * 8192]; const float dv = dec[j * 64]; u[(size_t)j * 8192] = S; S = dv * S + uv; } }
}
__device__ __forceinline__ void phase_gla3(const Params& p, char* smem) {
    unsigned char* ws = p.ws;
    const bf16_t* Gq = (const bf16_t*)(ws + R1_GQ); const bf16_t* Gk = (const bf16_t*)(ws + R1_GK); const bf16_t* Gv = (const bf16_t*)(ws + R1_GV); const bf16_t* Gg = (const bf16_t*)(ws + R1_GG);
    const float* LR = (const float*)(ws + R1_LR); const float* UC = (const float*)(ws + R1_UC); bf16_t* MO = (bf16_t*)(ws + WS_U);
    float* gs = (float*)smem; bf16_t* ATT = (bf16_t*)smem; bf16_t* QI = (bf16_t*)(smem + 16384); bf16_t* KI = QI + 64 * 72; bf16_t* VTs = KI + 64 * 72; bf16_t* SPT = VTs + 128 * 72;
    const int tid = threadIdx.x, lane = tid & 63, w = tid >> 6, lr = lane & 15, lq = lane >> 4;
    for (int it = blockIdx.x; it < 1024; it += gridDim.x) {
        const int tcl = it & 127, h = (it >> 7) & 3, b = it >> 9; const int tc = 4 + tcl;
        const size_t R0 = (size_t)b * PP + tc * 64;
        __syncthreads();
        gla_load_vt(VTs, Gv, R0, h);
        f32x4 acc[8];
#pragma unroll
        for (int i = 0; i < 8; ++i) acc[i] = (f32x4){0.f, 0.f, 0.f, 0.f};
        for (int d = 0; d < 2; ++d) {
            const int j = d == 0 ? tc : 135 - tc; const size_t chain = (size_t)((b * 2 + d) * 4 + h);
            __syncthreads();
            gla_gates(p, gs, LR, R0, d, h);
            { const int t = tid >> 2, dq = (tid & 3) * 16; const bf16_t* qs = Gq + (R0 + t) * 256 + h * 64 + dq; const bf16_t* ksrc = Gk + (R0 + t) * 256 + h * 64 + dq;
#pragma unroll
                for (int q = 0; q < 2; ++q) { const u32x4 qv = *(const u32x4*)(qs + q * 8), kv = *(const u32x4*)(ksrc + q * 8); u32x4 qo, ko;
#pragma unroll
                    for (int e = 0; e < 4; ++e) { const int dk0 = dq + q * 8 + 2 * e; const float g0 = gs[t * 64 + dk0], g1 = gs[t * 64 + dk0 + 1];
                        const float e0 = __expf(g0), e1 = __expf(g1);
                        qo[e] = pack2(bflo(qv[e]) * 0.125f * e0, bfhi(qv[e]) * 0.125f * e1); ko[e] = pack2(bflo(kv[e]) / e0, bfhi(kv[e]) / e1); }
                    *(u32x4*)(QI + t * 72 + dq + q * 8) = qo; *(u32x4*)(KI + t * 72 + dq + q * 8) = ko; } }
            { const int dk = tid >> 2, vq = (tid & 3) * 32; const float* sp = UC + (chain * 132 + j) * 8192 + dk * 128 + vq;
#pragma unroll
                for (int q = 0; q < 8; ++q) { const f32x4 v = *(const f32x4*)(sp + q * 4);
#pragma unroll
                    for (int e = 0; e < 4; ++e) SPT[(vq + q * 4 + e) * 72 + dk] = (bf16_t)f2bf(v[e]); } }
            __syncthreads();
            f32x4 at[4];
#pragma unroll
            for (int i = 0; i < 4; ++i) at[i] = (f32x4){0.f, 0.f, 0.f, 0.f};
#pragma unroll
            for (int ks = 0; ks < 2; ++ks) { const bf16x8 a = *(const bf16x8*)(QI + (16 * w + lr) * 72 + ks * 32 + lq * 8);
#pragma unroll
                for (int nt = 0; nt < 4; ++nt) { const bf16x8 bb = *(const bf16x8*)(KI + (16 * nt + lr) * 72 + ks * 32 + lq * 8); at[nt] = __builtin_amdgcn_mfma_f32_16x16x32_bf16(a, bb, at[nt], 0, 0, 0); } }
#pragma unroll
            for (int nt = 0; nt < 4; ++nt)
#pragma unroll
                for (int e = 0; e < 4; ++e) { const int t = 16 * w + 4 * lq + e, s = 16 * nt + lr; const bool keep = d == 0 ? (s <= t) : (s >= t); ATT[t * 72 + s] = (bf16_t)f2bf(keep ? at[nt][e] : 0.f); }
            __syncthreads();
#pragma unroll
            for (int ks = 0; ks < 2; ++ks) { const bf16x8 a1 = *(const bf16x8*)(ATT + (16 * w + lr) * 72 + ks * 32 + lq * 8); const bf16x8 a2 = *(const bf16x8*)(QI + (16 * w + lr) * 72 + ks * 32 + lq * 8);
#pragma unroll
                for (int nt = 0; nt < 8; ++nt) { const bf16x8 b1 = *(const bf16x8*)(VTs + (16 * nt + lr) * 72 + ks * 32 + lq * 8); const bf16x8 b2 = *(const bf16x8*)(SPT + (16 * nt + lr) * 72 + ks * 32 + lq * 8);
                    acc[nt] = __builtin_amdgcn_mfma_f32_16x16x32_bf16(a1, b1, acc[nt], 0, 0, 0); acc[nt] = __builtin_amdgcn_mfma_f32_16x16x32_bf16(a2, b2, acc[nt], 0, 0, 0); } }
        }
#pragma unroll
        for (int e = 0; e < 4; ++e) { float ss = 0.f;
#pragma unroll
            for (int nt = 0; nt < 8; ++nt) ss += acc[nt][e] * acc[nt][e];
            ss += __shfl_xor(ss, 1); ss += __shfl_xor(ss, 2); ss += __shfl_xor(ss, 4); ss += __shfl_xor(ss, 8);
            const float rstd = rsqrtf(ss * (1.f / 128.f) + EPS); const size_t R = R0 + 16 * w + 4 * lq + e;
#pragma unroll
            for (int nt = 0; nt < 8; ++nt) { const int v = 16 * nt + lr; const float y = acc[nt][e] * rstd * p.gla_norm_w[v] * bf2f(Gg[R * 512 + h * 128 + v]); MO[R * 1024 + h * 128 + v] = (bf16_t)f2bf(y); } }
    }
}
__device__ __forceinline__ void phase_gqa(const Params& p, char* smem) {
    unsigned char* ws = p.ws;
    const bf16_t* Qg = (const bf16_t*)(ws + R1_QG); const bf16_t* Kg = (const bf16_t*)(ws + R1_KG); const bf16_t* VTg = (const bf16_t*)(ws + R1_VTG); bf16_t* MO = (bf16_t*)(ws + WS_U);
    for (int u = blockIdx.x; u < 1024; u += gridDim.x) { const int b = u >> 9, hq = (u >> 6) & 7, qb = u & 63, kvh = hq >> 2;
        const size_t Rq = (size_t)b * PP + 256 + qb * 128;
        attn_unit(smem, Qg + Rq * 512 + hq * 64, 512, Kg + (size_t)b * PP * 128 + kvh * 64, 128, VTg + (size_t)((b * 2 + kvh) * 64) * PP, MO + Rq * 1024 + 512 + hq * 64, 1024, 132, 0, 0, 0, nullptr); }
}

template <int ph> __device__ __forceinline__ void run_phase(const Params& p, char* smem) {
    unsigned char* ws = p.ws;
    float* MOD = (float*)(ws + WS_MOD); float* Hc = (float*)(ws + WS_HC); float* Hl = p.out; bf16_t* U = (bf16_t*)(ws + WS_U);
    if constexpr (ph == 0) { phase_prologue(p, smem); }
    if constexpr (ph == 1) { phase_ln(p.x, p.ctx, p.norm1_w, MOD, 0, 1, false, U); }
    if constexpr (ph == 2) { { EpiInEven e{(bf16_t*)(ws + R0_Q), (bf16_t*)(ws + R0_K), (bf16_t*)(ws + R0_VT), (bf16_t*)(ws + R0_XL), (bf16_t*)(ws + R0_GG)};
        gemm_phase(smem, U, 1024, (const bf16_t*)(ws + WS_WINE), 1024, 132, 20, 0, 0, e); } }
    if constexpr (ph == 3) { phase_na(p, smem); }
    if constexpr (ph == 4) { { EpiLru e{(const bf16_t*)(ws + R0_XC), (__half2*)(ws + R0_AB), p.lru_ba, p.lru_bx, p.lru_lambda};
        gemm_phase(smem, (const bf16_t*)(ws + R0_XC), 512, (const bf16_t*)(ws + WS_WLRU), 64, 132, 16, 0, 1, e); } }
    if constexpr (ph == 5) { phase_scan1(p); }
    if constexpr (ph == 6) { phase_scan2(p); }
    if constexpr (ph == 7) { { EpiResid e{p.x, p.ctx, Hl, Hc, MOD, 2}; gemm_phase(smem, U, 1024, (const bf16_t*)(ws + WS_WOUTE), 1024, 132, 8, 0, 0, e); } }
    if constexpr (ph == 8) { phase_ln(Hl, Hc, p.norm2_w, MOD, 3, 4, false, U); }
    if constexpr (ph == 9) { { EpiFF1 e{(bf16_t*)(ws + R_FF)}; gemm_phase(smem, U, 1024, (const bf16_t*)(ws + WS_WFF1), 1024, 132, 32, 0, 0, e); } }
    if constexpr (ph == 10) { { EpiResid e{Hl, Hc, Hl, Hc, MOD, 5}; gemm_phase(smem, (const bf16_t*)(ws + R_FF), 4096, (const bf16_t*)(ws + WS_WFF2), 4096, 132, 8, 0, 0, e); } }
    if constexpr (ph == 11) { phase_ln(Hl, Hc, p.norm1_w + 1024, MOD + 3 * 6144, 0, 1, false, U); }
    if constexpr (ph == 12) { { EpiInOdd e{(bf16_t*)(ws + R1_GQ), (bf16_t*)(ws + R1_GK), (bf16_t*)(ws + R1_GV), (bf16_t*)(ws + R1_GG), (bf16_t*)(ws + R1_QG), (bf16_t*)(ws + R1_KG), (bf16_t*)(ws + R1_VTG),
                          (float*)(ws + R1_LR), p.gqa_q_norm_w, p.gqa_k_norm_w, (const float2*)(ws + WS_ROPE)};
        gemm_phase(smem, U, 1024, (const bf16_t*)(ws + WS_WINO), 1024, 132, 19, 0, 0, e); } }
    if constexpr (ph == 13) { phase_gla1(p, smem); }
    if constexpr (ph == 14) { phase_gla2(p); phase_gqa(p, smem); }
    if constexpr (ph == 15) { phase_gla3(p, smem); }
    if constexpr (ph == 16) { { EpiResid e{Hl, Hc, Hl, Hc, MOD + 3 * 6144, 2}; gemm_phase(smem, U, 1024, (const bf16_t*)(ws + WS_WOUTO), 1024, 128, 8, 1, 0, e); } }
    if constexpr (ph == 17) { phase_ln(Hl, Hc, p.norm2_w + 1024, MOD + 3 * 6144, 3, 4, true, U); }
    if constexpr (ph == 18) { { EpiFF1 e{(bf16_t*)(ws + R_FF)}; gemm_phase(smem, U, 1024, (const bf16_t*)(ws + WS_WFF1) + (size_t)4096 * 1024, 1024, 128, 32, 1, 0, e); } }
    if constexpr (ph == 19) { { EpiResid e{Hl, Hc, Hl, Hc, MOD + 3 * 6144, 5}; gemm_phase(smem, (const bf16_t*)(ws + R_FF), 4096, (const bf16_t*)(ws + WS_WFF2) + (size_t)4096 * 1024, 4096, 128, 8, 1, 0, e); } }
    if constexpr (ph == 20) { phase_final(p.final_norm_w, Hl); }
}

#if MEGA
template <int PH> __device__ __forceinline__ void run_all(const Params& p, char* smem, cg::grid_group& grid) {
    if constexpr (PH < NPHASE) { run_phase<PH>(p, smem); if constexpr (PH + 1 < NPHASE) grid.sync(); run_all<PH + 1>(p, smem, grid); }
}
__global__ void __launch_bounds__(256, 2) hybrid_fwd(Params p) {
    extern __shared__ __attribute__((aligned(16))) char smem[];
    cg::grid_group grid = cg::this_grid();
    run_all<0>(p, smem, grid);
}
#else
template <int PH> __global__ void __launch_bounds__(256, 2) phase_k(Params p) {
    extern __shared__ __attribute__((aligned(16))) char smem[];
    run_phase<PH>(p, smem);
}
template <int PH> static bool setup_all() {
    if constexpr (PH < NPHASE) { if (hipFuncSetAttribute((const void*)phase_k<PH>, hipFuncAttributeMaxDynamicSharedMemorySize, LDS_BYTES) != hipSuccess) return false; return setup_all<PH + 1>(); }
    else return true;
}
template <int PH> static void launch_all(const Params& p, int grid, hipStream_t stream) {
    if constexpr (PH < NPHASE) { hipLaunchKernelGGL(phase_k<PH>, dim3(grid), dim3(256), LDS_BYTES, stream, p); launch_all<PH + 1>(p, grid, stream); }
}
#endif

extern "C" void kernel_launch(void* const* d_in, const int* in_sizes, int n_in, void* d_out, int out_size, void* d_ws, size_t ws_size, hipStream_t stream) {
    static int grid_blocks = 0;
    if (grid_blocks == 0) {
        if (n_in != 28 || out_size != NB * SEQ * DM || ws_size < WS_NEED) { fprintf(stderr, "kernel_launch: unexpected shapes (n_in %d out %d ws %zu need %zu)\n", n_in, out_size, ws_size, (size_t)WS_NEED); grid_blocks = -1; return; }
        int dev = 0, cus = 0, per_cu = 0;
        if (hipGetDevice(&dev) != hipSuccess || hipDeviceGetAttribute(&cus, hipDeviceAttributeMultiprocessorCount, dev) != hipSuccess) { grid_blocks = -1; return; }
#if MEGA
        if (hipFuncSetAttribute((const void*)hybrid_fwd, hipFuncAttributeMaxDynamicSharedMemorySize, LDS_BYTES) != hipSuccess) { fprintf(stderr, "kernel_launch: hipFuncSetAttribute failed\n"); grid_blocks = -1; return; }
        if (hipOccupancyMaxActiveBlocksPerMultiprocessor(&per_cu, (const void*)hybrid_fwd, 256, LDS_BYTES) != hipSuccess || per_cu < 1) { fprintf(stderr, "kernel_launch: occupancy query failed (%d)\n", per_cu); grid_blocks = -1; return; }
        if (per_cu > 2) per_cu = 2;
#else
        if (!setup_all<0>()) { fprintf(stderr, "kernel_launch: hipFuncSetAttribute failed\n"); grid_blocks = -1; return; }
        per_cu = 2;
#endif
        grid_blocks = cus * per_cu;
    }
    if (grid_blocks < 0) return;
    Params p{};
    const float** pp = (const float**)&p;
    for (int i = 0; i < 28; ++i) pp[i] = (const float*)d_in[i];
    p.out = (float*)d_out; p.ws = (unsigned char*)d_ws;
    p.ph_lo = 0; p.ph_hi = NPHASE;
#if MEGA
    void* args[] = {&p};
    hipError_t e = hipLaunchCooperativeKernel((const void*)hybrid_fwd, dim3(grid_blocks), dim3(256), args, LDS_BYTES, stream);
    if (e != hipSuccess) fprintf(stderr, "cooperative launch failed: %s (grid %d)\n", hipGetErrorString(e), grid_blocks);
#else
    launch_all<0>(p, grid_blocks, stream);
#endif
}
```

```cpp
#include <hip/hip_runtime.h>
#include <hip/hip_cooperative_groups.h>
#include <hip/hip_fp16.h>
#include <cstdio>
#include <cstdint>
namespace cg = cooperative_groups;

#ifndef MEGA
#define MEGA 1
#endif

typedef unsigned short bf16_t;
typedef short bf16x8 __attribute__((ext_vector_type(8)));
typedef short s16x4 __attribute__((ext_vector_type(4)));
typedef float f32x4 __attribute__((ext_vector_type(4)));
typedef float f32x16 __attribute__((ext_vector_type(16)));
typedef unsigned u32x4 __attribute__((ext_vector_type(4)));
typedef unsigned u32x2 __attribute__((ext_vector_type(2)));

constexpr int DM = 1024, NB = 2, SEQ = 8192, CTX = 256, PP = SEQ + CTX, NR = NB * PP;
constexpr float EPS = 1e-6f;
constexpr float LOG2E = 1.4426950408889634f;
constexpr int LDS_BYTES = 71680;
constexpr int NPHASE = 21;

constexpr size_t WS_WFF1 = 0;
constexpr size_t WS_WFF2 = WS_WFF1 + 2ull * 4096 * 1024 * 2;
constexpr size_t WS_WINE = WS_WFF2 + 2ull * 4096 * 1024 * 2;
constexpr size_t WS_WOUTE = WS_WINE + 2560ull * 1024 * 2;
constexpr size_t WS_WINO = WS_WOUTE + 1024ull * 1024 * 2;
constexpr size_t WS_WOUTO = WS_WINO + 2432ull * 1024 * 2;
constexpr size_t WS_WLRU = WS_WOUTO + 1024ull * 1024 * 2;
constexpr size_t WS_MOD = WS_WLRU + 2048ull * 64 * 2;
constexpr size_t WS_ROPE = WS_MOD + 2ull * 3 * 6144 * 4;
constexpr size_t WS_HC = WS_ROPE + 128ull * 16 * 8;
constexpr size_t WS_U = WS_HC + 512ull * 1024 * 4;
constexpr size_t WS_REG = WS_U + (size_t)NR * 1024 * 2;
constexpr size_t R0_Q = WS_REG;
constexpr size_t R0_K = R0_Q + (size_t)NR * 512 * 2;
constexpr size_t R0_VT = R0_K + (size_t)NR * 512 * 2;
constexpr size_t R0_XL = R0_VT + (size_t)NR * 512 * 2;
constexpr size_t R0_GG = R0_XL + (size_t)NR * 512 * 2;
constexpr size_t R0_XC = R0_GG + (size_t)NR * 512 * 2;
constexpr size_t R0_AB = R0_XC + (size_t)NR * 512 * 2;
constexpr size_t R0_SUM = R0_AB + 2ull * NR * 512 * 4;
constexpr size_t R0_END = R0_SUM + 2ull * 2 * 132 * 512 * 8;
constexpr size_t R_FF = WS_REG;
constexpr size_t RFF_END = R_FF + (size_t)NR * 4096 * 2;
constexpr size_t R1_GQ = WS_REG;
constexpr size_t R1_GK = R1_GQ + (size_t)NR * 256 * 2;
constexpr size_t R1_GV = R1_GK + (size_t)NR * 256 * 2;
constexpr size_t R1_GG = R1_GV + (size_t)NR * 512 * 2;
constexpr size_t R1_LR = R1_GG + (size_t)NR * 512 * 2;
constexpr size_t R1_QG = R1_LR + (size_t)NR * 32 * 4;
constexpr size_t R1_KG = R1_QG + (size_t)NR * 512 * 2;
constexpr size_t R1_VTG = R1_KG + (size_t)NR * 128 * 2;
constexpr size_t R1_UC = R1_VTG + (size_t)NR * 128 * 2;
constexpr size_t R1_DEC = R1_UC + 16ull * 132 * 8192 * 4;
constexpr size_t R1_END = R1_DEC + 16ull * 132 * 64 * 4;
constexpr size_t WS_BAR = 268435456ull - 16384ull;
constexpr size_t WS_NEED0 = (R0_END > RFF_END ? (R0_END > R1_END ? R0_END : R1_END) : (RFF_END > R1_END ? RFF_END : R1_END));
static_assert(WS_NEED0 <= WS_BAR, "workspace overlay runs into the barrier words");
constexpr size_t WS_NEED = 268435456ull;

struct Params {
    const float *x, *c, *ctx, *c_ctx, *norm1_w, *norm2_w, *w_mod, *b_mod, *w_ff1, *w_ff2;
    const float *w_in_even, *na_rpb, *lru_conv_w, *lru_conv_b, *lru_wa, *lru_ba, *lru_wx, *lru_bx, *lru_lambda, *w_out_even;
    const float *w_in_odd, *gla_wa2, *gla_ba, *gla_norm_w, *gqa_q_norm_w, *gqa_k_norm_w, *w_out_odd, *final_norm_w;
    float* out;
    unsigned char* ws;
    int ph_lo, ph_hi;
};

__device__ __forceinline__ unsigned f2bf(float f) { unsigned u = __float_as_uint(f); u += 0x7fffu + ((u >> 16) & 1u); return u >> 16; }
__device__ __forceinline__ unsigned pack2(float a, float b) { return f2bf(a) | (f2bf(b) << 16); }
__device__ __forceinline__ float bf2f(unsigned h) { return __uint_as_float(h << 16); }
__device__ __forceinline__ float bflo(unsigned w) { return __uint_as_float(w << 16); }
__device__ __forceinline__ float bfhi(unsigned w) { return __uint_as_float(w & 0xffff0000u); }
__device__ __forceinline__ float sigmoidf_(float z) { return 1.f / (1.f + __expf(-z)); }
__device__ __forceinline__ float wave_sum(float v) {
#pragma unroll
    for (int o = 32; o > 0; o >>= 1) v += __shfl_xor(v, o);
    return v;
}
__device__ __forceinline__ int clampi(int v, int lo, int hi) { return v < lo ? lo : (v > hi ? hi : v); }

__device__ __forceinline__ void tr_job(float* tile, const float* __restrict__ src, int Nsrc, bf16_t* __restrict__ dst, int K, int Ndst, int mode) {
    const int tid = threadIdx.x;
    const int nkt = K >> 6, ntiles = (Ndst >> 6) * nkt;
    for (int t = blockIdx.x; t < ntiles; t += gridDim.x) {
        const int n0 = (t / nkt) << 6, k0 = (t % nkt) << 6;
        __syncthreads();
        {
            const int n = tid & 63; const int nn = n0 + n; bool valid = true; int on = nn;
            if (mode == 1) { if (nn >= 2336) valid = false; else if (nn >= 2304) on = nn - 2304 + 1536; else if (nn >= 1536) on = nn + 32; }
#pragma unroll
            for (int i = 0; i < 16; ++i) { const int k = i * 4 + (tid >> 6); tile[k * 65 + n] = valid ? src[(size_t)(k0 + k) * Nsrc + on] : 0.f; }
        }
        __syncthreads();
        {
            const int n = tid >> 2, kq = (tid & 3) * 16; unsigned w[8];
#pragma unroll
            for (int j = 0; j < 8; ++j) w[j] = pack2(tile[(kq + 2 * j) * 65 + n], tile[(kq + 2 * j + 1) * 65 + n]);
            u32x4* d = (u32x4*)(dst + (size_t)(n0 + n) * K + k0 + kq);
            d[0] = (u32x4){w[0], w[1], w[2], w[3]}; d[1] = (u32x4){w[4], w[5], w[6], w[7]};
        }
    }
}

__device__ __forceinline__ void phase_prologue(const Params& p, char* smem) {
    const int tid = threadIdx.x, bid = blockIdx.x, nblk = gridDim.x;
    unsigned char* ws = p.ws;
    {
        float* sv = (float*)smem; float* red = sv + 3072; float* MOD = (float*)(ws + WS_MOD);
        for (int i = tid; i < 3072; i += 256) { const int j = i >> 10, k = i & 1023; const float v = j < 2 ? p.c[j * 1024 + k] : p.c_ctx[k]; sv[i] = v / (1.f + __expf(-v)); }
        __syncthreads();
        for (int it = bid; it < 192; it += nblk) {
            const int l = it / 96, n0 = (it % 96) * 64, col = tid & 63, kg = tid >> 6;
            const float* w = p.w_mod + (size_t)l * 1024 * 6144 + n0 + col;
            float a0 = 0.f, a1 = 0.f, a2 = 0.f;
#pragma unroll 8
            for (int k = kg * 256; k < kg * 256 + 256; ++k) { const float wv = w[(size_t)k * 6144]; a0 += sv[k] * wv; a1 += sv[1024 + k] * wv; a2 += sv[2048 + k] * wv; }
            red[(kg * 3 + 0) * 64 + col] = a0; red[(kg * 3 + 1) * 64 + col] = a1; red[(kg * 3 + 2) * 64 + col] = a2;
            __syncthreads();
            if (tid < 192) { const int j = tid >> 6, cc = tid & 63;
                const float s = red[(0 * 3 + j) * 64 + cc] + red[(1 * 3 + j) * 64 + cc] + red[(2 * 3 + j) * 64 + cc] + red[(3 * 3 + j) * 64 + cc];
                MOD[(l * 3 + j) * 6144 + n0 + cc] = s + p.b_mod[l * 6144 + n0 + cc]; }
            __syncthreads();
        }
    }
    {
        const int gt = bid * 256 + tid, gn = nblk * 256;
        float2* rope = (float2*)(ws + WS_ROPE);
        for (int i = gt; i < 2048; i += gn) { const int pos = i >> 4, f = i & 15; const float inv = powf(10000.f, -(float)f / 16.f); const float ang = (float)pos * inv; float s, c; sincosf(ang, &s, &c); rope[i] = make_float2(c, s); }
        bf16_t* wl = (bf16_t*)(ws + WS_WLRU);
        for (int i = gt; i < 2048 * 64; i += gn) { const int n = i >> 6, k = i & 63; const int h = n >> 8, d = (n >> 7) & 1, j = (n & 127) >> 1, g = n & 1;
            const float* W = g ? p.lru_wx : p.lru_wa; wl[i] = (bf16_t)f2bf(W[(((size_t)(d * 8 + h) * 64 + k) * 64) + j]); }
    }
    float* tile = (float*)smem;
    for (int l = 0; l < 2; ++l) {
        tr_job(tile, p.w_ff1 + (size_t)l * 1024 * 4096, 4096, (bf16_t*)(ws + WS_WFF1) + (size_t)l * 4096 * 1024, 1024, 4096, 0);
        tr_job(tile, p.w_ff2 + (size_t)l * 4096 * 1024, 1024, (bf16_t*)(ws + WS_WFF2) + (size_t)l * 4096 * 1024, 4096, 1024, 0);
    }
    tr_job(tile, p.w_in_even, 2560, (bf16_t*)(ws + WS_WINE), 1024, 2560, 0);
    tr_job(tile, p.w_out_even, 1024, (bf16_t*)(ws + WS_WOUTE), 1024, 1024, 0);
    tr_job(tile, p.w_in_odd, 2336, (bf16_t*)(ws + WS_WINO), 1024, 2432, 1);
    tr_job(tile, p.w_out_odd, 1024, (bf16_t*)(ws + WS_WOUTO), 1024, 1024, 0);
}

__device__ __forceinline__ void phase_ln(const float* __restrict__ srcL, const float* __restrict__ srcC, const float* __restrict__ nw, const float* __restrict__ mod, int sh_slot, int sc_slot, bool latent_only, bf16_t* __restrict__ U) {
    const int lane = threadIdx.x & 63, gw = blockIdx.x * 4 + (threadIdx.x >> 6), nwt = gridDim.x * 4;
    const int nrows = latent_only ? NB * SEQ : NR;
    for (int idx = gw; idx < nrows; idx += nwt) {
        int b, pi; if (latent_only) { b = idx >> 13; pi = 256 + (idx & 8191); } else { b = idx / PP; pi = idx - b * PP; }
        const int R = b * PP + pi; const bool isc = pi < 256; const int ms = isc ? 2 : b;
        const float* src = isc ? srcC + (size_t)(b * 256 + pi) * 1024 : srcL + (size_t)(b * 8192 + pi - 256) * 1024;
        f32x4 v[4]; float ss = 0.f;
#pragma unroll
        for (int i = 0; i < 4; ++i) { v[i] = *(const f32x4*)(src + i * 256 + lane * 4); ss += v[i][0] * v[i][0] + v[i][1] * v[i][1] + v[i][2] * v[i][2] + v[i][3] * v[i][3]; }
        ss = wave_sum(ss);
        const float rstd = rsqrtf(ss * (1.f / 1024.f) + EPS);
        const float* sh = mod + ms * 6144 + sh_slot * 1024; const float* sc = mod + ms * 6144 + sc_slot * 1024;
#pragma unroll
        for (int i = 0; i < 4; ++i) { const int n = i * 256 + lane * 4;
            const f32x4 w4 = *(const f32x4*)(nw + n), s4 = *(const f32x4*)(sc + n), h4 = *(const f32x4*)(sh + n);
            const f32x4 y = v[i] * rstd * w4 * (s4 + 1.f) + h4;
            *(u32x2*)(U + (size_t)R * 1024 + n) = (u32x2){pack2(y[0], y[1]), pack2(y[2], y[3])}; }
    }
}

__device__ __forceinline__ void phase_final(const float* __restrict__ fw, float* __restrict__ out) {
    const int lane = threadIdx.x & 63, gw = blockIdx.x * 4 + (threadIdx.x >> 6), nwt = gridDim.x * 4;
    for (int idx = gw; idx < NB * SEQ; idx += nwt) {
        float* row = out + (size_t)idx * 1024;
        f32x4 v[4]; float ss = 0.f;
#pragma unroll
        for (int i = 0; i < 4; ++i) { v[i] = *(const f32x4*)(row + i * 256 + lane * 4); ss += v[i][0] * v[i][0] + v[i][1] * v[i][1] + v[i][2] * v[i][2] + v[i][3] * v[i][3]; }
        ss = wave_sum(ss);
        const float rstd = rsqrtf(ss * (1.f / 1024.f) + EPS);
#pragma unroll
        for (int i = 0; i < 4; ++i) { const int n = i * 256 + lane * 4; const f32x4 w4 = *(const f32x4*)(fw + n); *(f32x4*)(row + n) = v[i] * rstd * w4; }
    }
}

template <class Epi>
__device__ __forceinline__ void gemm_phase(char* smem, const bf16_t* __restrict__ A, int lda, const bf16_t* __restrict__ WT, int K, int nMt, int nNt, int rowmode, int lru, const Epi& epi) {
    bf16_t* As = (bf16_t*)smem; bf16_t* Bs = As + 128 * 72;
    const int tid = threadIdx.x, lane = tid & 63, wid = tid >> 6, wm = wid >> 1, wn = wid & 1;
    const int lr = lane & 15, lq = lane >> 4;
    const int ntiles = nMt * nNt;
    for (int tile = blockIdx.x; tile < ntiles; tile += gridDim.x) {
        const int mt = tile / nNt, nt = tile - mt * nNt;
        const int row0 = rowmode ? ((mt >> 6) * PP + 256 + (mt & 63) * 128) : mt * 128;
        const bf16_t* Ag = A + (size_t)row0 * lda + (lru ? (nt >> 1) * 64 : 0);
        const bf16_t* Bg = WT + (size_t)nt * 128 * K;
        f32x4 acc[4][4];
#pragma unroll
        for (int i = 0; i < 4; ++i)
#pragma unroll
            for (int j = 0; j < 4; ++j) acc[i][j] = (f32x4){0.f, 0.f, 0.f, 0.f};
        u32x4 ra[4], rb[4];
#pragma unroll
        for (int i = 0; i < 4; ++i) { const int c = tid + 256 * i, r = c >> 3, kc = (c & 7) * 8; ra[i] = *(const u32x4*)(Ag + (size_t)r * lda + kc); rb[i] = *(const u32x4*)(Bg + (size_t)r * K + kc); }
        for (int k0 = 0; k0 < K; k0 += 64) {
            __syncthreads();
#pragma unroll
            for (int i = 0; i < 4; ++i) { const int c = tid + 256 * i, r = c >> 3, kc = (c & 7) * 8; *(u32x4*)(As + r * 72 + kc) = ra[i]; *(u32x4*)(Bs + r * 72 + kc) = rb[i]; }
            __syncthreads();
            if (k0 + 64 < K) {
#pragma unroll
                for (int i = 0; i < 4; ++i) { const int c = tid + 256 * i, r = c >> 3, kc = (c & 7) * 8 + k0 + 64; ra[i] = *(const u32x4*)(Ag + (size_t)r * lda + kc); rb[i] = *(const u32x4*)(Bg + (size_t)r * K + kc); }
            }
#pragma unroll
            for (int ks = 0; ks < 2; ++ks) {
                bf16x8 af[4], bfr[4];
#pragma unroll
                for (int i = 0; i < 4; ++i) { af[i] = *(const bf16x8*)(As + (wm * 64 + i * 16 + lr) * 72 + ks * 32 + lq * 8); bfr[i] = *(const bf16x8*)(Bs + (wn * 64 + i * 16 + lr) * 72 + ks * 32 + lq * 8); }
#pragma unroll
                for (int mi = 0; mi < 4; ++mi)
#pragma unroll
                    for (int ni = 0; ni < 4; ++ni) acc[mi][ni] = __builtin_amdgcn_mfma_f32_16x16x32_bf16(bfr[ni], af[mi], acc[mi][ni], 0, 0, 0);
            }
        }
        epi(acc, row0 + wm * 64, nt * 128 + wn * 64, lane);
    }
}

struct EpiResid {
    const float* srcL; const float* srcC; float* dstL; float* dstC; const float* mod; int slot;
    __device__ __forceinline__ void operator()(const f32x4 (&acc)[4][4], int Rb, int nb, int lane) const {
        const int lr = lane & 15, lq = lane >> 4;
#pragma unroll
        for (int mi = 0; mi < 4; ++mi) {
            const int R = Rb + mi * 16 + lr; const int b = R / PP, pi = R - b * PP; const bool isc = pi < 256; const int ms = isc ? 2 : b;
            const size_t ro = isc ? (size_t)(b * 256 + pi) * 1024 : (size_t)(b * 8192 + pi - 256) * 1024;
            const float* s = (isc ? srcC : srcL) + ro; float* d = (isc ? dstC : dstL) + ro; const float* g = mod + ms * 6144 + slot * 1024;
#pragma unroll
            for (int ni = 0; ni < 4; ++ni) { const int n = nb + ni * 16 + lq * 4; const f32x4 h = *(const f32x4*)(s + n), gg = *(const f32x4*)(g + n); *(f32x4*)(d + n) = h + gg * acc[mi][ni]; }
        }
    }
};
struct EpiFF1 {
    bf16_t* FF;
    __device__ __forceinline__ void operator()(const f32x4 (&acc)[4][4], int Rb, int nb, int lane) const {
        const int lr = lane & 15, lq = lane >> 4;
#pragma unroll
        for (int mi = 0; mi < 4; ++mi) { const int R = Rb + mi * 16 + lr;
#pragma unroll
            for (int ni = 0; ni < 4; ++ni) { const int n = nb + ni * 16 + lq * 4; f32x4 v = acc[mi][ni];
#pragma unroll
                for (int e = 0; e < 4; ++e) { const float r = fmaxf(v[e], 0.f); v[e] = r * r; }
                *(u32x2*)(FF + (size_t)R * 4096 + n) = (u32x2){pack2(v[0], v[1]), pack2(v[2], v[3])}; } }
    }
};
__device__ __forceinline__ float gelu_tanh(float x) { const float u = 0.7978845608028654f * (x + 0.044715f * x * x * x); const float t = 1.f - 2.f / (1.f + __expf(2.f * u)); return 0.5f * x * (1.f + t); }
struct EpiInEven {
    bf16_t *Qn, *Kn, *VTn, *XL, *GG;
    __device__ __forceinline__ void operator()(const f32x4 (&acc)[4][4], int Rb, int nb, int lane) const {
        const int lr = lane & 15, lq = lane >> 4;
#pragma unroll
        for (int mi = 0; mi < 4; ++mi) { const int R = Rb + mi * 16 + lr; const int b = R / PP, pi = R - b * PP;
#pragma unroll
            for (int ni = 0; ni < 4; ++ni) { const int n = nb + ni * 16 + lq * 4; const f32x4 a = acc[mi][ni];
                if (n < 512) *(u32x2*)(Qn + (size_t)R * 512 + n) = (u32x2){pack2(a[0] * 0.125f, a[1] * 0.125f), pack2(a[2] * 0.125f, a[3] * 0.125f)};
                else if (n < 1024) *(u32x2*)(Kn + (size_t)R * 512 + (n - 512)) = (u32x2){pack2(a[0], a[1]), pack2(a[2], a[3])};
                else if (n < 1536) { const int hh = (n - 1024) >> 6, d0 = (n - 1024) & 63; bf16_t* vp = VTn + ((size_t)((b * 8 + hh) * 64 + d0)) * PP + pi;
#pragma unroll
                    for (int e = 0; e < 4; ++e) vp[(size_t)e * PP] = (bf16_t)f2bf(a[e]); }
                else if (n < 2048) *(u32x2*)(XL + (size_t)R * 512 + (n - 1536)) = (u32x2){pack2(a[0], a[1]), pack2(a[2], a[3])};
                else *(u32x2*)(GG + (size_t)R * 512 + (n - 2048)) = (u32x2){pack2(gelu_tanh(a[0]), gelu_tanh(a[1])), pack2(gelu_tanh(a[2]), gelu_tanh(a[3]))};
            } }
    }
};
struct EpiLru {
    const bf16_t* XC; __half2* AB; const float *ba, *bx, *lam;
    __device__ __forceinline__ void operator()(const f32x4 (&acc)[4][4], int Rb, int nb, int lane) const {
        const int lr = lane & 15, lq = lane >> 4;
        const int h = nb >> 8, d = (nb >> 7) & 1, colb = nb & 127;
#pragma unroll
        for (int mi = 0; mi < 4; ++mi) { const int R = Rb + mi * 16 + lr;
#pragma unroll
            for (int ni = 0; ni < 4; ++ni) { const int j0 = (colb + ni * 16 + lq * 4) >> 1; const int c = h * 64 + j0; __half2 o[2];
#pragma unroll
                for (int e2 = 0; e2 < 2; ++e2) { const int cc = c + e2;
                    const float za = acc[mi][ni][2 * e2] + ba[d * 512 + cc], zx = acc[mi][ni][2 * e2 + 1] + bx[d * 512 + cc];
                    const float r = sigmoidf_(za), ig = sigmoidf_(zx);
                    const float sp = log1pf(__expf(-lam[d * 512 + cc]));
                    const float la = -8.f * r * sp;
                    const float xv = bf2f(XC[(size_t)R * 512 + cc]);
                    const float bb = sqrtf(fmaxf(-expm1f(2.f * la), 0.f)) * ig * xv;
                    o[e2] = __floats2half2_rn(la, bb); }
                __half2* dst = AB + ((size_t)d * NR + R) * 512 + c; dst[0] = o[0]; dst[1] = o[1]; } }
    }
};
struct EpiInOdd {
    bf16_t *Gq, *Gk, *Gv, *Gg, *Qg, *Kg, *VTg; float* LR; const float *qnw, *knw; const float2* rope;
    __device__ __forceinline__ void operator()(const f32x4 (&acc)[4][4], int Rb, int nb, int lane) const {
        const int lr = lane & 15, lq = lane >> 4;
        if (nb < 1536) {
#pragma unroll
            for (int mi = 0; mi < 4; ++mi) { const int R = Rb + mi * 16 + lr;
#pragma unroll
                for (int ni = 0; ni < 4; ++ni) { const int n = nb + ni * 16 + lq * 4; const f32x4 a = acc[mi][ni];
                    if (n < 256) *(u32x2*)(Gq + (size_t)R * 256 + n) = (u32x2){pack2(a[0], a[1]), pack2(a[2], a[3])};
                    else if (n < 512) *(u32x2*)(Gk + (size_t)R * 256 + (n - 256)) = (u32x2){pack2(a[0], a[1]), pack2(a[2], a[3])};
                    else if (n < 1024) *(u32x2*)(Gv + (size_t)R * 512 + (n - 512)) = (u32x2){pack2(a[0], a[1]), pack2(a[2], a[3])};
                    else { f32x4 s;
#pragma unroll
                        for (int e = 0; e < 4; ++e) s[e] = a[e] * sigmoidf_(a[e]);
                        *(u32x2*)(Gg + (size_t)R * 512 + (n - 1024)) = (u32x2){pack2(s[0], s[1]), pack2(s[2], s[3])}; } } }
        } else if (nb < 2176) {
            const bool isq = nb < 2048; const float* nwp = isq ? qnw : knw;
#pragma unroll
            for (int mi = 0; mi < 4; ++mi) { const int R = Rb + mi * 16 + lr; const int b = R / PP, pi = R - b * PP;
                float ss = 0.f;
#pragma unroll
                for (int ni = 0; ni < 4; ++ni)
#pragma unroll
                    for (int e = 0; e < 4; ++e) ss += acc[mi][ni][e] * acc[mi][ni][e];
                ss += __shfl_xor(ss, 16); ss += __shfl_xor(ss, 32);
                const float rstd = rsqrtf(ss * (1.f / 64.f) + EPS);
                f32x4 y[4];
#pragma unroll
                for (int ni = 0; ni < 4; ++ni) { const f32x4 w4 = *(const f32x4*)(nwp + ni * 16 + lq * 4); y[ni] = acc[mi][ni] * rstd * w4; }
                if (pi >= 256) { const int t = pi - 256, prow = t >> 6, pcol = t & 63;
#pragma unroll
                    for (int e = 0; e < 4; ++e) { const int i = lq * 4 + e; const float2 cr = rope[prow * 16 + i], cc = rope[pcol * 16 + i];
                        const float a1 = y[0][e], a2 = y[1][e]; y[0][e] = a1 * cr.x - a2 * cr.y; y[1][e] = a2 * cr.x + a1 * cr.y;
                        const float b1 = y[2][e], b2 = y[3][e]; y[2][e] = b1 * cc.x - b2 * cc.y; y[3][e] = b2 * cc.x + b1 * cc.y; } }
                if (isq) {
#pragma unroll
                    for (int ni = 0; ni < 4; ++ni) { const f32x4 v = y[ni] * 0.125f; *(u32x2*)(Qg + (size_t)R * 512 + (nb - 1536) + ni * 16 + lq * 4) = (u32x2){pack2(v[0], v[1]), pack2(v[2], v[3])}; }
                } else {
#pragma unroll
                    for (int ni = 0; ni < 4; ++ni) { const f32x4 v = y[ni]; *(u32x2*)(Kg + (size_t)R * 128 + (nb - 2048) + ni * 16 + lq * 4) = (u32x2){pack2(v[0], v[1]), pack2(v[2], v[3])}; }
                } }
        } else if (nb < 2304) {
            const int kvh = (nb - 2176) >> 6;
#pragma unroll
            for (int mi = 0; mi < 4; ++mi) { const int R = Rb + mi * 16 + lr; const int b = R / PP, pi = R - b * PP;
#pragma unroll
                for (int ni = 0; ni < 4; ++ni) { bf16_t* vp = VTg + ((size_t)((b * 2 + kvh) * 64 + ni * 16 + lq * 4)) * PP + pi;
#pragma unroll
                    for (int e = 0; e < 4; ++e) vp[(size_t)e * PP] = (bf16_t)f2bf(acc[mi][ni][e]); } }
        } else if (nb == 2304) {
#pragma unroll
            for (int mi = 0; mi < 4; ++mi) { const int R = Rb + mi * 16 + lr;
#pragma unroll
                for (int ni = 0; ni < 2; ++ni) *(f32x4*)(LR + (size_t)R * 32 + ni * 16 + lq * 4) = acc[mi][ni]; }
        }
    }
};

__device__ __forceinline__ void attn_unit(char* smem, const bf16_t* __restrict__ Qp, int ldq, const bf16_t* __restrict__ Kp, int ldk, const bf16_t* __restrict__ VTp,
                                          bf16_t* __restrict__ Op, int ldo, int ntiles, int mode, int r0, int rs0, const float* __restrict__ rpb_h) {
    bf16_t* Ks = (bf16_t*)smem;
    bf16_t* Vs = Ks + 2 * 64 * 72;
    float* rp = (float*)(Vs + 2 * 64 * 72);
    const int tid = threadIdx.x, lane = tid & 63, w = tid >> 6, l31 = lane & 31, lh = lane >> 5;
    if (mode == 1) { for (int i = tid; i < 465; i += 256) rp[i] = rpb_h[i]; }
    bf16x8 qf[4];
    { const bf16_t* q = Qp + (size_t)(w * 32 + l31) * ldq + lh * 8;
#pragma unroll
        for (int ks = 0; ks < 4; ++ks) qf[ks] = *(const bf16x8*)(q + ks * 16); }
    f32x16 ot[2];
#pragma unroll
    for (int i = 0; i < 16; ++i) { ot[0][i] = 0.f; ot[1][i] = 0.f; }
    float m = -1e30f, l = 0.f;
    u32x4 rk[2], rv[2];
#define ATT_GLOAD(t_) do { const int t__ = (t_); const int pos__ = (mode == 1) ? (t__ < 4 ? t__ * 64 : 256 + (rs0 + t__ - 4) * 64) : t__ * 64; \
        _Pragma("unroll") for (int i = 0; i < 2; ++i) { const int c = tid + 256 * i, r = c >> 3, cc = (c & 7) * 8; \
            rk[i] = *(const u32x4*)(Kp + (size_t)(pos__ + r) * ldk + cc); rv[i] = *(const u32x4*)(VTp + (size_t)r * PP + pos__ + cc); } } while (0)
#define ATT_SSTORE(buf_) do { _Pragma("unroll") for (int i = 0; i < 2; ++i) { const int c = tid + 256 * i, r = c >> 3, cc = (c & 7) * 8; \
            *(u32x4*)(Ks + (buf_) * 64 * 72 + r * 72 + cc) = rk[i]; *(u32x4*)(Vs + (buf_) * 64 * 72 + r * 72 + cc) = rv[i]; } } while (0)
    ATT_GLOAD(0); ATT_SSTORE(0); __syncthreads();
    for (int t = 0; t < ntiles; ++t) {
        if (t + 1 < ntiles) ATT_GLOAD(t + 1);
        const bf16_t* ks_ = Ks + (t & 1) * 64 * 72; const bf16_t* vs_ = Vs + (t & 1) * 64 * 72;
        bool skip = false; int kr = 0, rq = 0;
        const bool local = (mode == 1) && (t >= 4);
        if (local) { kr = rs0 + t - 4; rq = r0 + (w >> 1); const int rsq = clampi(rq - 4, 0, 120); skip = (kr < rsq) || (kr >= rsq + 8); }
        if (!skip) {
            f32x16 st[2];
#pragma unroll
            for (int i = 0; i < 16; ++i) { st[0][i] = 0.f; st[1][i] = 0.f; }
#pragma unroll
            for (int kt = 0; kt < 2; ++kt)
#pragma unroll
                for (int ks = 0; ks < 4; ++ks) { const bf16x8 kf = *(const bf16x8*)(ks_ + (kt * 32 + l31) * 72 + ks * 16 + lh * 8); st[kt] = __builtin_amdgcn_mfma_f32_32x32x16_bf16(kf, qf[ks], st[kt], 0, 0, 0); }
            if (local) { const int qc = (w & 1) * 32 + l31, cs = clampi(qc - 8, 0, 48); const float* rrow = rp + (kr - rq + 7) * 31;
#pragma unroll
                for (int kt = 0; kt < 2; ++kt)
#pragma unroll
                    for (int i = 0; i < 16; ++i) { const int kc = kt * 32 + (i & 3) + 8 * (i >> 2) + 4 * lh; const bool ok = (kc >= cs) && (kc < cs + 16);
                        const float bias = rrow[clampi(kc - qc + 15, 0, 30)]; st[kt][i] = ok ? st[kt][i] + bias : -1e30f; } }
            float mx = st[0][0];
#pragma unroll
            for (int i = 1; i < 16; ++i) mx = fmaxf(mx, st[0][i]);
#pragma unroll
            for (int i = 0; i < 16; ++i) mx = fmaxf(mx, st[1][i]);
            mx = fmaxf(mx, __shfl_xor(mx, 32));
            const float mn = fmaxf(m, mx); const float alpha = exp2f((m - mn) * LOG2E); m = mn;
            const float mb = mn * LOG2E; float ps = 0.f;
#pragma unroll
            for (int kt = 0; kt < 2; ++kt)
#pragma unroll
                for (int i = 0; i < 16; ++i) { const float pe = exp2f(st[kt][i] * LOG2E - mb); st[kt][i] = pe; ps += pe; }
            l = l * alpha + ps;
#pragma unroll
            for (int i = 0; i < 16; ++i) { ot[0][i] *= alpha; ot[1][i] *= alpha; }
#pragma unroll
            for (int kt = 0; kt < 2; ++kt)
#pragma unroll
                for (int s = 0; s < 2; ++s) {
                    u32x4 pw; pw[0] = pack2(st[kt][8 * s + 0], st[kt][8 * s + 1]); pw[1] = pack2(st[kt][8 * s + 2], st[kt][8 * s + 3]); pw[2] = pack2(st[kt][8 * s + 4], st[kt][8 * s + 5]); pw[3] = pack2(st[kt][8 * s + 6], st[kt][8 * s + 7]);
                    const bf16x8 pf = __builtin_bit_cast(bf16x8, pw);
#pragma unroll
                    for (int dt = 0; dt < 2; ++dt) { const bf16_t* vp = vs_ + (dt * 32 + l31) * 72 + kt * 32 + s * 16 + lh * 4;
                        const u32x2 v0 = *(const u32x2*)vp, v1 = *(const u32x2*)(vp + 8); const u32x4 vw = (u32x4){v0[0], v0[1], v1[0], v1[1]};
                        ot[dt] = __builtin_amdgcn_mfma_f32_32x32x16_bf16(__builtin_bit_cast(bf16x8, vw), pf, ot[dt], 0, 0, 0); } }
        }
        if (t + 1 < ntiles) ATT_SSTORE((t + 1) & 1);
        __syncthreads();
    }
#undef ATT_GLOAD
#undef ATT_SSTORE
    l += __shfl_xor(l, 32);
    const float inv = 1.f / l;
    bf16_t* o = Op + (size_t)(w * 32 + l31) * ldo;
#pragma unroll
    for (int dt = 0; dt < 2; ++dt)
#pragma unroll
        for (int g = 0; g < 4; ++g) { const int d = dt * 32 + 8 * g + 4 * lh;
            *(u32x2*)(o + d) = (u32x2){pack2(ot[dt][4 * g] * inv, ot[dt][4 * g + 1] * inv), pack2(ot[dt][4 * g + 2] * inv, ot[dt][4 * g + 3] * inv)}; }
}

__device__ __forceinline__ void phase_na(const Params& p, char* smem) {
    unsigned char* ws = p.ws;
    const bf16_t* Qn = (const bf16_t*)(ws + R0_Q); const bf16_t* Kn = (const bf16_t*)(ws + R0_K); const bf16_t* VTn = (const bf16_t*)(ws + R0_VT);
    bf16_t* MO = (bf16_t*)(ws + WS_U);
    for (int u = blockIdx.x; u < 1024 + 32; u += gridDim.x) {
        if (u < 1024) { const int b = u >> 9, h = (u >> 6) & 7, qb = u & 63; const int r0 = qb * 2;
            const int rs0 = clampi(r0 - 4, 0, 120), rs1 = clampi(r0 - 3, 0, 120); const int nl = rs1 + 8 - rs0;
            const size_t Rq = (size_t)b * PP + 256 + qb * 128;
            attn_unit(smem, Qn + Rq * 512 + h * 64, 512, Kn + (size_t)b * PP * 512 + h * 64, 512, VTn + (size_t)((b * 8 + h) * 64) * PP, MO + Rq * 1024 + h * 64, 1024, 4 + nl, 1, r0, rs0, p.na_rpb + h * 465);
        } else { const int v = u - 1024; const int b = v >> 4, h = (v >> 1) & 7, qb = v & 1;
            const size_t Rq = (size_t)b * PP + qb * 128;
            attn_unit(smem, Qn + Rq * 512 + h * 64, 512, Kn + (size_t)b * PP * 512 + h * 64, 512, VTn + (size_t)((b * 8 + h) * 64) * PP, MO + Rq * 1024 + h * 64, 1024, 4, 0, 0, 0, nullptr);
        }
    }
    const bf16_t* XL = (const bf16_t*)(ws + R0_XL); bf16_t* XC = (bf16_t*)(ws + R0_XC);
    const int gt = blockIdx.x * 256 + threadIdx.x, gn = gridDim.x * 256;
    for (int idx = gt; idx < NR * 64; idx += gn) {
        const int R = idx >> 6, c8 = (idx & 63) * 8; const int b = R / PP, pi = R - b * PP; const int lo = pi < 256 ? 0 : 256, hi = pi < 256 ? 256 : PP;
        float a[8];
        { const f32x4 b0 = *(const f32x4*)(p.lru_conv_b + c8), b1 = *(const f32x4*)(p.lru_conv_b + c8 + 4); a[0] = b0[0]; a[1] = b0[1]; a[2] = b0[2]; a[3] = b0[3]; a[4] = b1[0]; a[5] = b1[1]; a[6] = b1[2]; a[7] = b1[3]; }
#pragma unroll
        for (int j = 0; j < 4; ++j) { const int pj = pi + j - 2;
            if (pj >= lo && pj < hi) { const u32x4 xv = *(const u32x4*)(XL + (size_t)(b * PP + pj) * 512 + c8);
                const f32x4 w0 = *(const f32x4*)(p.lru_conv_w + j * 512 + c8), w1 = *(const f32x4*)(p.lru_conv_w + j * 512 + c8 + 4);
                a[0] += w0[0] * bflo(xv[0]); a[1] += w0[1] * bfhi(xv[0]); a[2] += w0[2] * bflo(xv[1]); a[3] += w0[3] * bfhi(xv[1]);
                a[4] += w1[0] * bflo(xv[2]); a[5] += w1[1] * bfhi(xv[2]); a[6] += w1[2] * bflo(xv[3]); a[7] += w1[3] * bfhi(xv[3]); } }
        *(u32x4*)(XC + (size_t)R * 512 + c8) = (u32x4){pack2(a[0], a[1]), pack2(a[2], a[3]), pack2(a[4], a[5]), pack2(a[6], a[7])};
    }
}

__device__ __forceinline__ void phase_scan1(const Params& p) {
    const __half2* AB = (const __half2*)(p.ws + R0_AB); float2* SUM = (float2*)(p.ws + R0_SUM);
    for (int it = blockIdx.x; it < 1056; it += gridDim.x) {
        const int cgp = it & 1, tc = (it >> 1) % 132, db = (it >> 1) / 132, b = db & 1, d = db >> 1;
        const int c = cgp * 256 + threadIdx.x;
        const __half2* ab = AB + ((size_t)d * NR + (size_t)b * PP + tc * 64) * 512 + c;
        float h = 0.f, ap = 0.f;
#pragma unroll 8
        for (int s = 0; s < 64; ++s) { const int tt = d ? 63 - s : s; const __half2 v = ab[(size_t)tt * 512]; const float la = __low2float(v), bb = __high2float(v); h = __expf(la) * h + bb; ap += la; }
        SUM[((size_t)(d * 2 + b) * 132 + tc) * 512 + c] = make_float2(__expf(ap), h);
    }
}
__device__ __forceinline__ void phase_scan2(const Params& p) {
    const __half2* AB = (const __half2*)(p.ws + R0_AB); const float2* SUM = (const float2*)(p.ws + R0_SUM);
    const bf16_t* GG = (const bf16_t*)(p.ws + R0_GG); bf16_t* MO = (bf16_t*)(p.ws + WS_U);
    for (int it = blockIdx.x; it < 528; it += gridDim.x) {
        const int cgp = it & 1, tc = (it >> 1) % 132, b = (it >> 1) / 132;
        const int c = cgp * 256 + threadIdx.x; const size_t R0 = (size_t)b * PP + tc * 64;
        float hf[64];
        {
            float h = 0.f; const float2* sm = SUM + ((size_t)(0 * 2 + b) * 132) * 512 + c;
            for (int jj = 0; jj < tc; ++jj) { const float2 s = sm[(size_t)jj * 512]; h = s.x * h + s.y; }
            const __half2* ab = AB + ((size_t)0 * NR + R0) * 512 + c;
#pragma unroll
            for (int s = 0; s < 64; ++s) { const __half2 v = ab[(size_t)s * 512]; h = __expf(__low2float(v)) * h + __high2float(v); hf[s] = h; }
        }
        {
            const int j = tc < 4 ? 3 - tc : 135 - tc;
            float h = 0.f; const float2* sm = SUM + ((size_t)(1 * 2 + b) * 132) * 512 + c;
            for (int jj = 0; jj < j; ++jj) { const int tcj = jj < 4 ? 3 - jj : 135 - jj; const float2 s = sm[(size_t)tcj * 512]; h = s.x * h + s.y; }
            const __half2* ab = AB + ((size_t)1 * NR + R0) * 512 + c;
#pragma unroll
            for (int s = 0; s < 64; ++s) { const int tt = 63 - s; const __half2 v = ab[(size_t)tt * 512]; h = __expf(__low2float(v)) * h + __high2float(v);
                const float g = bf2f(GG[(R0 + tt) * 512 + c]);
                MO[(R0 + tt) * 1024 + 512 + c] = (bf16_t)f2bf((hf[tt] + h) * g); }
        }
    }
}

__device__ __forceinline__ void gla_gates(const Params& p, float* gs, const float* __restrict__ LR, size_t R0, int d, int h) {
    const int tid = threadIdx.x, dk = tid & 63, tg = tid >> 6;
    float wv[16];
#pragma unroll
    for (int r = 0; r < 16; ++r) wv[r] = p.gla_wa2[(d * 16 + r) * 256 + h * 64 + dk];
    const float bav = p.gla_ba[d * 256 + h * 64 + dk];
    for (int ti = 0; ti < 16; ++ti) { const int t = tg * 16 + ti; const float* lrp = LR + (R0 + t) * 32 + d * 16; float z = bav;
#pragma unroll
        for (int r = 0; r < 16; ++r) z += lrp[r] * wv[r];
        const float ls = fminf(z, 0.f) - log1pf(__expf(-fabsf(z))); gs[t * 64 + dk] = ls * (1.f / 16.f); }
    __syncthreads();
    if (tid < 64) { float s = 0.f;
        if (d == 0) { for (int t = 0; t < 64; ++t) { s += gs[t * 64 + tid]; gs[t * 64 + tid] = s; } }
        else { for (int t = 63; t >= 0; --t) { s += gs[t * 64 + tid]; gs[t * 64 + tid] = s; } } }
    __syncthreads();
}
__device__ __forceinline__ void gla_load_vt(bf16_t* VTs, const bf16_t* __restrict__ Gv, size_t R0, int h) {
    const int tid = threadIdx.x, t = tid >> 2, vq = (tid & 3) * 32; const bf16_t* src = Gv + (R0 + t) * 512 + h * 128 + vq;
#pragma unroll
    for (int q = 0; q < 4; ++q) { const u32x4 v = *(const u32x4*)(src + q * 8);
#pragma unroll
        for (int e = 0; e < 4; ++e) { VTs[(vq + q * 8 + 2 * e) * 72 + t] = (bf16_t)(v[e] & 0xffffu); VTs[(vq + q * 8 + 2 * e + 1) * 72 + t] = (bf16_t)(v[e] >> 16); } }
}
__device__ __forceinline__ void phase_gla1(const Params& p, char* smem) {
    unsigned char* ws = p.ws;
    const bf16_t* Gk = (const bf16_t*)(ws + R1_GK); const bf16_t* Gv = (const bf16_t*)(ws + R1_GV); const float* LR = (const float*)(ws + R1_LR);
    float* UC = (float*)(ws + R1_UC); float* DEC = (float*)(ws + R1_DEC);
    float* gs = (float*)smem; bf16_t* KD = (bf16_t*)(smem + 16384); bf16_t* VTs = KD + 64 * 72;
    const int tid = threadIdx.x, lane = tid & 63, w = tid >> 6, lr = lane & 15, lq = lane >> 4;
    for (int it = blockIdx.x; it < 2112; it += gridDim.x) {
        const int tc = it % 132, h = (it / 132) & 3, d = (it / 528) & 1, b = it / 1056;
        const size_t R0 = (size_t)b * PP + tc * 64;
        __syncthreads();
        gla_gates(p, gs, LR, R0, d, h);
        const int tl = d ? 0 : 63;
        { const int t = tid >> 2, dq = (tid & 3) * 16; const bf16_t* src = Gk + (R0 + t) * 256 + h * 64 + dq;
#pragma unroll
            for (int q = 0; q < 2; ++q) { const u32x4 v = *(const u32x4*)(src + q * 8);
#pragma unroll
                for (int e = 0; e < 4; ++e) { const int dk0 = dq + q * 8 + 2 * e;
                    const float k0 = bflo(v[e]) * __expf(gs[tl * 64 + dk0] - gs[t * 64 + dk0]); const float k1 = bfhi(v[e]) * __expf(gs[tl * 64 + dk0 + 1] - gs[t * 64 + dk0 + 1]);
                    KD[dk0 * 72 + t] = (bf16_t)f2bf(k0); KD[(dk0 + 1) * 72 + t] = (bf16_t)f2bf(k1); } } }
        gla_load_vt(VTs, Gv, R0, h);
        __syncthreads();
        f32x4 acc[8];
#pragma unroll
        for (int i = 0; i < 8; ++i) acc[i] = (f32x4){0.f, 0.f, 0.f, 0.f};
#pragma unroll
        for (int ks = 0; ks < 2; ++ks) { const bf16x8 a = *(const bf16x8*)(KD + (16 * w + lr) * 72 + ks * 32 + lq * 8);
#pragma unroll
            for (int nt = 0; nt < 8; ++nt) { const bf16x8 bb = *(const bf16x8*)(VTs + (16 * nt + lr) * 72 + ks * 32 + lq * 8); acc[nt] = __builtin_amdgcn_mfma_f32_16x16x32_bf16(a, bb, acc[nt], 0, 0, 0); } }
        const int j = d == 0 ? tc : (tc < 4 ? 3 - tc : 135 - tc);
        const size_t chain = (size_t)((b * 2 + d) * 4 + h);
        float* up = UC + (chain * 132 + j) * 8192;
#pragma unroll
        for (int nt = 0; nt < 8; ++nt)
#pragma unroll
            for (int e = 0; e < 4; ++e) up[(16 * w + 4 * lq + e) * 128 + 16 * nt + lr] = acc[nt][e];
        if (tid < 64) DEC[(chain * 132 + j) * 64 + tid] = __expf(gs[tl * 64 + tid]);
    }
}
__device__ __forceinline__ void phase_gla2(const Params& p) {
    float* UC = (float*)(p.ws + R1_UC); const float* DEC = (const float*)(p.ws + R1_DEC);
    const int gt = blockIdx.x * 256 + threadIdx.x, gn = gridDim.x * 256;
    for (int e = gt; e < 16 * 8192; e += gn) { const int chain = e >> 13, el = e & 8191, dk = el >> 7;
        float* u = UC + (size_t)chain * 132 * 8192 + el; const float* dec = DEC + (size_t)chain * 132 * 64 + dk; float S = 0.f;
#pragma unroll 4
        for (int j = 0; j < 132; ++j) { const float uv = u[(size_t)j * 8192]; const float dv = dec[j * 64]; u[(size_t)j * 8192] = S; S = dv * S + uv; } }
}
__device__ __forceinline__ void phase_gla3(const Params& p, char* smem) {
    unsigned char* ws = p.ws;
    const bf16_t* Gq = (const bf16_t*)(ws + R1_GQ); const bf16_t* Gk = (const bf16_t*)(ws + R1_GK); const bf16_t* Gv = (const bf16_t*)(ws + R1_GV); const bf16_t* Gg = (const bf16_t*)(ws + R1_GG);
    const float* LR = (const float*)(ws + R1_LR); const float* UC = (const float*)(ws + R1_UC); bf16_t* MO = (bf16_t*)(ws + WS_U);
    float* gs = (float*)smem; bf16_t* ATT = (bf16_t*)smem; bf16_t* QI = (bf16_t*)(smem + 16384); bf16_t* KI = QI + 64 * 72; bf16_t* VTs = KI + 64 * 72; bf16_t* SPT = VTs + 128 * 72;
    const int tid = threadIdx.x, lane = tid & 63, w = tid >> 6, lr = lane & 15, lq = lane >> 4;
    for (int it = blockIdx.x; it < 1024; it += gridDim.x) {
        const int tcl = it & 127, h = (it >> 7) & 3, b = it >> 9; const int tc = 4 + tcl;
        const size_t R0 = (size_t)b * PP + tc * 64;
        __syncthreads();
        gla_load_vt(VTs, Gv, R0, h);
        f32x4 acc[8];
#pragma unroll
        for (int i = 0; i < 8; ++i) acc[i] = (f32x4){0.f, 0.f, 0.f, 0.f};
        for (int d = 0; d < 2; ++d) {
            const int j = d == 0 ? tc : 135 - tc; const size_t chain = (size_t)((b * 2 + d) * 4 + h);
            __syncthreads();
            gla_gates(p, gs, LR, R0, d, h);
            { const int t = tid >> 2, dq = (tid & 3) * 16; const bf16_t* qs = Gq + (R0 + t) * 256 + h * 64 + dq; const bf16_t* ksrc = Gk + (R0 + t) * 256 + h * 64 + dq;
#pragma unroll
                for (int q = 0; q < 2; ++q) { const u32x4 qv = *(const u32x4*)(qs + q * 8), kv = *(const u32x4*)(ksrc + q * 8); u32x4 qo, ko;
#pragma unroll
                    for (int e = 0; e < 4; ++e) { const int dk0 = dq + q * 8 + 2 * e; const float g0 = gs[t * 64 + dk0], g1 = gs[t * 64 + dk0 + 1];
                        const float e0 = __expf(g0), e1 = __expf(g1);
                        qo[e] = pack2(bflo(qv[e]) * 0.125f * e0, bfhi(qv[e]) * 0.125f * e1); ko[e] = pack2(bflo(kv[e]) / e0, bfhi(kv[e]) / e1); }
                    *(u32x4*)(QI + t * 72 + dq + q * 8) = qo; *(u32x4*)(KI + t * 72 + dq + q * 8) = ko; } }
            { const int dk = tid >> 2, vq = (tid & 3) * 32; const float* sp = UC + (chain * 132 + j) * 8192 + dk * 128 + vq;
#pragma unroll
                for (int q = 0; q < 8; ++q) { const f32x4 v = *(const f32x4*)(sp + q * 4);
#pragma unroll
                    for (int e = 0; e < 4; ++e) SPT[(vq + q * 4 + e) * 72 + dk] = (bf16_t)f2bf(v[e]); } }
            __syncthreads();
            f32x4 at[4];
#pragma unroll
            for (int i = 0; i < 4; ++i) at[i] = (f32x4){0.f, 0.f, 0.f, 0.f};
#pragma unroll
            for (int ks = 0; ks < 2; ++ks) { const bf16x8 a = *(const bf16x8*)(QI + (16 * w + lr) * 72 + ks * 32 + lq * 8);
#pragma unroll
                for (int nt = 0; nt < 4; ++nt) { const bf16x8 bb = *(const bf16x8*)(KI + (16 * nt + lr) * 72 + ks * 32 + lq * 8); at[nt] = __builtin_amdgcn_mfma_f32_16x16x32_bf16(a, bb, at[nt], 0, 0, 0); } }
#pragma unroll
            for (int nt = 0; nt < 4; ++nt)
#pragma unroll
                for (int e = 0; e < 4; ++e) { const int t = 16 * w + 4 * lq + e, s = 16 * nt + lr; const bool keep = d == 0 ? (s <= t) : (s >= t); ATT[t * 72 + s] = (bf16_t)f2bf(keep ? at[nt][e] : 0.f); }
            __syncthreads();
#pragma unroll
            for (int ks = 0; ks < 2; ++ks) { const bf16x8 a1 = *(const bf16x8*)(ATT + (16 * w + lr) * 72 + ks * 32 + lq * 8); const bf16x8 a2 = *(const bf16x8*)(QI + (16 * w + lr) * 72 + ks * 32 + lq * 8);
#pragma unroll
                for (int nt = 0; nt < 8; ++nt) { const bf16x8 b1 = *(const bf16x8*)(VTs + (16 * nt + lr) * 72 + ks * 32 + lq * 8); const bf16x8 b2 = *(const bf16x8*)(SPT + (16 * nt + lr) * 72 + ks * 32 + lq * 8);
                    acc[nt] = __builtin_amdgcn_mfma_f32_16x16x32_bf16(a1, b1, acc[nt], 0, 0, 0); acc[nt] = __builtin_amdgcn_mfma_f32_16x16x32_bf16(a2, b2, acc[nt], 0, 0, 0); } }
        }
#pragma unroll
        for (int e = 0; e < 4; ++e) { float ss = 0.f;
#pragma unroll
            for (int nt = 0; nt < 8; ++nt) ss += acc[nt][e] * acc[nt][e];
            ss += __shfl_xor(ss, 1); ss += __shfl_xor(ss, 2); ss += __shfl_xor(ss, 4); ss += __shfl_xor(ss, 8);
            const float rstd = rsqrtf(ss * (1.f / 128.f) + EPS); const size_t R = R0 + 16 * w + 4 * lq + e;
#pragma unroll
            for (int nt = 0; nt < 8; ++nt) { const int v = 16 * nt + lr; const float y = acc[nt][e] * rstd * p.gla_norm_w[v] * bf2f(Gg[R * 512 + h * 128 + v]); MO[R * 1024 + h * 128 + v] = (bf16_t)f2bf(y); } }
    }
}
__device__ __forceinline__ void phase_gqa(const Params& p, char* smem) {
    unsigned char* ws = p.ws;
    const bf16_t* Qg = (const bf16_t*)(ws + R1_QG); const bf16_t* Kg = (const bf16_t*)(ws + R1_KG); const bf16_t* VTg = (const bf16_t*)(ws + R1_VTG); bf16_t* MO = (bf16_t*)(ws + WS_U);
    for (int u = blockIdx.x; u < 1024; u += gridDim.x) { const int b = u >> 9, hq = (u >> 6) & 7, qb = u & 63, kvh = hq >> 2;
        const size_t Rq = (size_t)b * PP + 256 + qb * 128;
        attn_unit(smem, Qg + Rq * 512 + hq * 64, 512, Kg + (size_t)b * PP * 128 + kvh * 64, 128, VTg + (size_t)((b * 2 + kvh) * 64) * PP, MO + Rq * 1024 + 512 + hq * 64, 1024, 132, 0, 0, 0, nullptr); }
}


#define XB_TMO      128
#define XB_XCNT(j)  (256  + 64 * (j))
#define XB_XSUB(j)  (1280 + 64 * (j))
#define XB_XGEN(j)  (2304 + 64 * (j))
#define XB_TOP      3328
#define XB_TOPGEN   3392
#define XCD_BAR_WORDS 3456
#define XB_SPIN_CAP (1u << 20)
#define LAS __attribute__((address_space(3)))
__device__ __forceinline__ unsigned xb_ld(unsigned* p)              { return __hip_atomic_load(p, __ATOMIC_RELAXED, __HIP_MEMORY_SCOPE_AGENT); }
__device__ __forceinline__ unsigned xb_add(unsigned* p, unsigned v) { return __hip_atomic_fetch_add(p, v, __ATOMIC_RELAXED, __HIP_MEMORY_SCOPE_AGENT); }
__device__ __forceinline__ unsigned xb_xcc_id() { return (unsigned)__builtin_amdgcn_s_getreg((3 << 11) | 20) & 0xFu; }
#define XB_SPIN(cond, bar) do { unsigned _sp = 0; while (cond) { __builtin_amdgcn_s_sleep(1); \
    if ((++_sp & 255u) == 0u) { if (xb_ld(&(bar)[XB_TMO])) break; if (_sp > XB_SPIN_CAP) { atomicAdd(&(bar)[XB_TMO], 1u); break; } } } } while (0)
struct XcdBarrier { unsigned* bar; unsigned x; volatile LAS unsigned* st; };
__device__ __forceinline__ XcdBarrier xcd_barrier_post(unsigned* bar, volatile LAS unsigned* st) {
    XcdBarrier b; b.bar = bar; b.x = xb_xcc_id(); b.st = st;
    if (threadIdx.x == 0) (void)xb_add(&bar[XB_XCNT(b.x)], 1u);
    return b;
}
__device__ __forceinline__ void xcd_barrier_complete(unsigned* bar, unsigned x, unsigned& nloc, unsigned& nx) {
    const unsigned G = gridDim.x * gridDim.y * gridDim.z;
    unsigned sum, cnt, mine, sp = 0u;
    for (;;) {
        sum = 0u; cnt = 0u; mine = 0u;
#pragma unroll
        for (unsigned j = 0; j < 16; ++j) { const unsigned c = xb_ld(&bar[XB_XCNT(j)]); sum += c; cnt += (c > 0u) ? 1u : 0u; mine = (j == x) ? c : mine; }
        if (sum == G) break;
        __builtin_amdgcn_s_sleep(1);
        if ((++sp & 255u) == 0u) { if (xb_ld(&bar[XB_TMO])) break; if (sp > XB_SPIN_CAP) { atomicAdd(&bar[XB_TMO], 1u); break; } }
    }
    nloc = mine > 0u ? mine : 1u; nx = cnt > 0u ? cnt : 1u;
}
__device__ __forceinline__ void xcd_barrier(const XcdBarrier& b) {
    asm volatile("s_waitcnt vmcnt(0)" ::: "memory");
    __syncthreads();
    if (threadIdx.x == 0) {
        unsigned* bar = b.bar;
        __builtin_amdgcn_s_waitcnt(0);
        unsigned nloc = b.st[0], nx = b.st[1];
        if (nloc == 0u) { xcd_barrier_complete(bar, b.x, nloc, nx); b.st[0] = nloc; b.st[1] = nx; }
        const unsigned old = xb_add(&bar[XB_XSUB(b.x)], 1u);
        const unsigned gen = old / nloc;
        if (old + 1u == (gen + 1u) * nloc) {
            __builtin_amdgcn_fence(__ATOMIC_RELEASE, "agent");
            asm volatile("s_waitcnt vmcnt(0)" ::: "memory");
            const unsigned og = xb_add(&bar[XB_TOP], 1u);
            const unsigned tg = og / nx;
            if (og + 1u == (tg + 1u) * nx) xb_add(&bar[XB_TOPGEN], 1u);
            else XB_SPIN(xb_ld(&bar[XB_TOPGEN]) == tg, bar);
            __builtin_amdgcn_fence(__ATOMIC_ACQUIRE, "agent");
            xb_add(&bar[XB_XGEN(b.x)], 1u);
            asm volatile("s_waitcnt vmcnt(0)" ::: "memory");
        } else {
            XB_SPIN(xb_ld(&bar[XB_XGEN(b.x)]) == gen, bar);
            __builtin_amdgcn_fence(__ATOMIC_ACQUIRE, "agent");
            asm volatile("s_waitcnt vmcnt(0)" ::: "memory");
        }
    }
    __syncthreads();
}

template <int ph> __device__ __forceinline__ void run_phase(const Params& p, char* smem) {
    unsigned char* ws = p.ws;
    float* MOD = (float*)(ws + WS_MOD); float* Hc = (float*)(ws + WS_HC); float* Hl = p.out; bf16_t* U = (bf16_t*)(ws + WS_U);
    if constexpr (ph == 0) { phase_prologue(p, smem); }
    if constexpr (ph == 1) { phase_ln(p.x, p.ctx, p.norm1_w, MOD, 0, 1, false, U); }
    if constexpr (ph == 2) { { EpiInEven e{(bf16_t*)(ws + R0_Q), (bf16_t*)(ws + R0_K), (bf16_t*)(ws + R0_VT), (bf16_t*)(ws + R0_XL), (bf16_t*)(ws + R0_GG)};
        gemm_phase(smem, U, 1024, (const bf16_t*)(ws + WS_WINE), 1024, 132, 20, 0, 0, e); } }
    if constexpr (ph == 3) { phase_na(p, smem); }
    if constexpr (ph == 4) { { EpiLru e{(const bf16_t*)(ws + R0_XC), (__half2*)(ws + R0_AB), p.lru_ba, p.lru_bx, p.lru_lambda};
        gemm_phase(smem, (const bf16_t*)(ws + R0_XC), 512, (const bf16_t*)(ws + WS_WLRU), 64, 132, 16, 0, 1, e); } }
    if constexpr (ph == 5) { phase_scan1(p); }
    if constexpr (ph == 6) { phase_scan2(p); }
    if constexpr (ph == 7) { { EpiResid e{p.x, p.ctx, Hl, Hc, MOD, 2}; gemm_phase(smem, U, 1024, (const bf16_t*)(ws + WS_WOUTE), 1024, 132, 8, 0, 0, e); } }
    if constexpr (ph == 8) { phase_ln(Hl, Hc, p.norm2_w, MOD, 3, 4, false, U); }
    if constexpr (ph == 9) { { EpiFF1 e{(bf16_t*)(ws + R_FF)}; gemm_phase(smem, U, 1024, (const bf16_t*)(ws + WS_WFF1), 1024, 132, 32, 0, 0, e); } }
    if constexpr (ph == 10) { { EpiResid e{Hl, Hc, Hl, Hc, MOD, 5}; gemm_phase(smem, (const bf16_t*)(ws + R_FF), 4096, (const bf16_t*)(ws + WS_WFF2), 4096, 132, 8, 0, 0, e); } }
    if constexpr (ph == 11) { phase_ln(Hl, Hc, p.norm1_w + 1024, MOD + 3 * 6144, 0, 1, false, U); }
    if constexpr (ph == 12) { { EpiInOdd e{(bf16_t*)(ws + R1_GQ), (bf16_t*)(ws + R1_GK), (bf16_t*)(ws + R1_GV), (bf16_t*)(ws + R1_GG), (bf16_t*)(ws + R1_QG), (bf16_t*)(ws + R1_KG), (bf16_t*)(ws + R1_VTG),
                          (float*)(ws + R1_LR), p.gqa_q_norm_w, p.gqa_k_norm_w, (const float2*)(ws + WS_ROPE)};
        gemm_phase(smem, U, 1024, (const bf16_t*)(ws + WS_WINO), 1024, 132, 19, 0, 0, e); } }
    if constexpr (ph == 13) { phase_gla1(p, smem); }
    if constexpr (ph == 14) { phase_gla2(p); phase_gqa(p, smem); }
    if constexpr (ph == 15) { phase_gla3(p, smem); }
    if constexpr (ph == 16) { { EpiResid e{Hl, Hc, Hl, Hc, MOD + 3 * 6144, 2}; gemm_phase(smem, U, 1024, (const bf16_t*)(ws + WS_WOUTO), 1024, 128, 8, 1, 0, e); } }
    if constexpr (ph == 17) { phase_ln(Hl, Hc, p.norm2_w + 1024, MOD + 3 * 6144, 3, 4, true, U); }
    if constexpr (ph == 18) { { EpiFF1 e{(bf16_t*)(ws + R_FF)}; gemm_phase(smem, U, 1024, (const bf16_t*)(ws + WS_WFF1) + (size_t)4096 * 1024, 1024, 128, 32, 1, 0, e); } }
    if constexpr (ph == 19) { { EpiResid e{Hl, Hc, Hl, Hc, MOD + 3 * 6144, 5}; gemm_phase(smem, (const bf16_t*)(ws + R_FF), 4096, (const bf16_t*)(ws + WS_WFF2) + (size_t)4096 * 1024, 4096, 128, 8, 1, 0, e); } }
    if constexpr (ph == 20) { phase_final(p.final_norm_w, Hl); }
}

#if MEGA
template <int PH> __device__ __forceinline__ void run_all(const Params& p, char* smem, cg::grid_group& grid, const XcdBarrier& xb) {
    if constexpr (PH < NPHASE) {
        run_phase<PH>(p, smem);
        if constexpr (PH + 1 < NPHASE) { if constexpr (PH == 0) grid.sync(); else xcd_barrier(xb); }
        run_all<PH + 1>(p, smem, grid, xb);
    }
}
__global__ void __launch_bounds__(256, 2) hybrid_fwd(Params p) {
    extern __shared__ __attribute__((aligned(16))) char smem[];
    __shared__ uint4 xb_words;
    cg::grid_group grid = cg::this_grid();
    if (threadIdx.x == 0) xb_words = make_uint4(0u, 0u, 0u, 0u);
    __syncthreads();
    const XcdBarrier xb = xcd_barrier_post((unsigned*)(p.ws + WS_BAR), (volatile LAS unsigned*)&xb_words);
    run_all<0>(p, smem, grid, xb);
}
#else
template <int PH> __global__ void __launch_bounds__(256, 2) phase_k(Params p) {
    extern __shared__ __attribute__((aligned(16))) char smem[];
    run_phase<PH>(p, smem);
}
template <int PH> static bool setup_all() {
    if constexpr (PH < NPHASE) { if (hipFuncSetAttribute((const void*)phase_k<PH>, hipFuncAttributeMaxDynamicSharedMemorySize, LDS_BYTES) != hipSuccess) return false; return setup_all<PH + 1>(); }
    else return true;
}
template <int PH> static void launch_all(const Params& p, int grid, hipStream_t stream) {
    if constexpr (PH < NPHASE) { hipLaunchKernelGGL(phase_k<PH>, dim3(grid), dim3(256), LDS_BYTES, stream, p); launch_all<PH + 1>(p, grid, stream); }
}
#endif

extern "C" void kernel_launch(void* const* d_in, const int* in_sizes, int n_in, void* d_out, int out_size, void* d_ws, size_t ws_size, hipStream_t stream) {
    static int grid_blocks = 0;
    if (grid_blocks == 0) {
        if (n_in != 28 || out_size != NB * SEQ * DM || ws_size < WS_NEED) { fprintf(stderr, "kernel_launch: unexpected shapes (n_in %d out %d ws %zu need %zu)\n", n_in, out_size, ws_size, (size_t)WS_NEED); grid_blocks = -1; return; }
        int dev = 0, cus = 0, per_cu = 0;
        if (hipGetDevice(&dev) != hipSuccess || hipDeviceGetAttribute(&cus, hipDeviceAttributeMultiprocessorCount, dev) != hipSuccess) { grid_blocks = -1; return; }
#if MEGA
        if (hipFuncSetAttribute((const void*)hybrid_fwd, hipFuncAttributeMaxDynamicSharedMemorySize, LDS_BYTES) != hipSuccess) { fprintf(stderr, "kernel_launch: hipFuncSetAttribute failed\n"); grid_blocks = -1; return; }
        if (hipOccupancyMaxActiveBlocksPerMultiprocessor(&per_cu, (const void*)hybrid_fwd, 256, LDS_BYTES) != hipSuccess || per_cu < 1) { fprintf(stderr, "kernel_launch: occupancy query failed (%d)\n", per_cu); grid_blocks = -1; return; }
        if (per_cu > 2) per_cu = 2;
#else
        if (!setup_all<0>()) { fprintf(stderr, "kernel_launch: hipFuncSetAttribute failed\n"); grid_blocks = -1; return; }
        per_cu = 2;
#endif
        grid_blocks = cus * per_cu;
    }
    if (grid_blocks < 0) return;
    Params p{};
    const float** pp = (const float**)&p;
    for (int i = 0; i < 28; ++i) pp[i] = (const float*)d_in[i];
    p.out = (float*)d_out; p.ws = (unsigned char*)d_ws;
    p.ph_lo = 0; p.ph_hi = NPHASE;
#if MEGA
    if (hipMemsetAsync((char*)d_ws + WS_BAR, 0, 16384, stream) != hipSuccess) { fprintf(stderr, "kernel_launch: memset failed\n"); return; }
    void* args[] = {&p};
    hipError_t e = hipLaunchCooperativeKernel((const void*)hybrid_fwd, dim3(grid_blocks), dim3(256), args, LDS_BYTES, stream);
    if (e != hipSuccess) fprintf(stderr, "cooperative launch failed: %s (grid %d)\n", hipGetErrorString(e), grid_blocks);
#else
    launch_all<0>(p, grid_blocks, stream);
#endif
}
```

```cpp
#include <hip/hip_runtime.h>
#include <hip/hip_cooperative_groups.h>
#include <hip/hip_fp16.h>
#include <cstdio>
#include <cstdint>
namespace cg = cooperative_groups;

#ifndef MEGA
#define MEGA 1
#endif

typedef unsigned short bf16_t;
typedef short bf16x8 __attribute__((ext_vector_type(8)));
typedef short s16x4 __attribute__((ext_vector_type(4)));
typedef float f32x4 __attribute__((ext_vector_type(4)));
typedef float f32x16 __attribute__((ext_vector_type(16)));
typedef unsigned u32x4 __attribute__((ext_vector_type(4)));
typedef unsigned u32x2 __attribute__((ext_vector_type(2)));

constexpr int DM = 1024, NB = 2, SEQ = 8192, CTX = 256, PP = SEQ + CTX, NR = NB * PP;
constexpr float EPS = 1e-6f;
constexpr float LOG2E = 1.4426950408889634f;
constexpr int HALF_LDS = 71680;
constexpr int LDS_BYTES = 2 * HALF_LDS;
#define VT ((int)(threadIdx.x & 255))
#define VB ((int)(blockIdx.x * 2 + (threadIdx.x >> 8)))
#define NVB ((int)(gridDim.x * 2))
constexpr int NPHASE = 21;

constexpr size_t WS_WFF1 = 0;
constexpr size_t WS_WFF2 = WS_WFF1 + 2ull * 4096 * 1024 * 2;
constexpr size_t WS_WINE = WS_WFF2 + 2ull * 4096 * 1024 * 2;
constexpr size_t WS_WOUTE = WS_WINE + 2560ull * 1024 * 2;
constexpr size_t WS_WINO = WS_WOUTE + 1024ull * 1024 * 2;
constexpr size_t WS_WOUTO = WS_WINO + 2560ull * 1024 * 2;
constexpr size_t WS_WLRU = WS_WOUTO + 1024ull * 1024 * 2;
constexpr size_t WS_MOD = WS_WLRU + 2048ull * 64 * 2;
constexpr size_t WS_ROPE = WS_MOD + 2ull * 3 * 6144 * 4;
constexpr size_t WS_HC = WS_ROPE + 128ull * 16 * 8;
constexpr size_t WS_U = WS_HC + 512ull * 1024 * 4;
constexpr size_t WS_REG = WS_U + (size_t)NR * 1024 * 2;
constexpr size_t R0_Q = WS_REG;
constexpr size_t R0_K = R0_Q + (size_t)NR * 512 * 2;
constexpr size_t R0_VT = R0_K + (size_t)NR * 512 * 2;
constexpr size_t R0_XL = R0_VT + (size_t)NR * 512 * 2;
constexpr size_t R0_GG = R0_XL + (size_t)NR * 512 * 2;
constexpr size_t R0_XC = R0_GG + (size_t)NR * 512 * 2;
constexpr size_t R0_AB = R0_XC + (size_t)NR * 512 * 2;
constexpr size_t R0_SUM = R0_AB + 2ull * NR * 512 * 4;
constexpr size_t R0_END = R0_SUM + 2ull * 2 * 132 * 512 * 8;
constexpr size_t R_FF = WS_REG;
constexpr size_t RFF_END = R_FF + (size_t)NR * 4096 * 2;
constexpr size_t R1_GQ = WS_REG;
constexpr size_t R1_GK = R1_GQ + (size_t)NR * 256 * 2;
constexpr size_t R1_GV = R1_GK + (size_t)NR * 256 * 2;
constexpr size_t R1_GG = R1_GV + (size_t)NR * 512 * 2;
constexpr size_t R1_LR = R1_GG + (size_t)NR * 512 * 2;
constexpr size_t R1_QG = R1_LR + (size_t)NR * 32 * 4;
constexpr size_t R1_KG = R1_QG + (size_t)NR * 512 * 2;
constexpr size_t R1_VTG = R1_KG + (size_t)NR * 128 * 2;
constexpr size_t R1_UC = R1_VTG + (size_t)NR * 128 * 2;
constexpr size_t R1_DEC = R1_UC + 16ull * 132 * 8192 * 4;
constexpr size_t R1_END = R1_DEC + 16ull * 132 * 64 * 4;
constexpr size_t WS_BAR = 268435456ull - 16384ull;
constexpr size_t WS_NEED0 = (R0_END > RFF_END ? (R0_END > R1_END ? R0_END : R1_END) : (RFF_END > R1_END ? RFF_END : R1_END));
static_assert(WS_NEED0 <= WS_BAR, "workspace overlay runs into the barrier words");
constexpr size_t WS_NEED = 268435456ull;

struct Params {
    const float *x, *c, *ctx, *c_ctx, *norm1_w, *norm2_w, *w_mod, *b_mod, *w_ff1, *w_ff2;
    const float *w_in_even, *na_rpb, *lru_conv_w, *lru_conv_b, *lru_wa, *lru_ba, *lru_wx, *lru_bx, *lru_lambda, *w_out_even;
    const float *w_in_odd, *gla_wa2, *gla_ba, *gla_norm_w, *gqa_q_norm_w, *gqa_k_norm_w, *w_out_odd, *final_norm_w;
    float* out;
    unsigned char* ws;
    int ph_lo, ph_hi;
};

__device__ __forceinline__ unsigned f2bf(float f) { unsigned u = __float_as_uint(f); u += 0x7fffu + ((u >> 16) & 1u); return u >> 16; }
__device__ __forceinline__ unsigned pack2(float a, float b) { return f2bf(a) | (f2bf(b) << 16); }
__device__ __forceinline__ float bf2f(unsigned h) { return __uint_as_float(h << 16); }
__device__ __forceinline__ float bflo(unsigned w) { return __uint_as_float(w << 16); }
__device__ __forceinline__ float bfhi(unsigned w) { return __uint_as_float(w & 0xffff0000u); }
__device__ __forceinline__ float sigmoidf_(float z) { return 1.f / (1.f + __expf(-z)); }
__device__ __forceinline__ float wave_sum(float v) {
#pragma unroll
    for (int o = 32; o > 0; o >>= 1) v += __shfl_xor(v, o);
    return v;
}
__device__ __forceinline__ int clampi(int v, int lo, int hi) { return v < lo ? lo : (v > hi ? hi : v); }

__host__ __device__ __forceinline__ int phys2log(int P) { const int t = P >> 8, q = P & 255, bj = q >> 7, wc = (q >> 5) & 3, r = q & 31; return (t << 8) + 64 * wc + 32 * bj + r; }
__device__ __forceinline__ void tr_job(float* tile, const float* __restrict__ src, int Nsrc, bf16_t* __restrict__ dst, int K, int Ndst, int mode) {
    const int tid = VT;
    const int nkt = K >> 6, ntiles = (Ndst >> 6) * nkt;
    for (int t = VB; t < ntiles; t += NVB) {
        const int n0 = (t / nkt) << 6, k0 = (t % nkt) << 6;
        __syncthreads();
        {
            const int n = tid & 63; const int nn = phys2log(n0 + n); bool valid = true; int on = nn;
            if (mode == 1) { if (nn >= 2336) valid = false; else if (nn >= 2304) on = nn - 2304 + 1536; else if (nn >= 1536) on = nn + 32; }
#pragma unroll
            for (int i = 0; i < 16; ++i) { const int k = i * 4 + (tid >> 6); tile[k * 65 + n] = valid ? src[(size_t)(k0 + k) * Nsrc + on] : 0.f; }
        }
        __syncthreads();
        {
            const int n = tid >> 2, kq = (tid & 3) * 16; unsigned w[8];
#pragma unroll
            for (int j = 0; j < 8; ++j) w[j] = pack2(tile[(kq + 2 * j) * 65 + n], tile[(kq + 2 * j + 1) * 65 + n]);
            u32x4* d = (u32x4*)(dst + (size_t)(n0 + n) * K + k0 + kq);
            d[0] = (u32x4){w[0], w[1], w[2], w[3]}; d[1] = (u32x4){w[4], w[5], w[6], w[7]};
        }
    }
}

__device__ __forceinline__ void phase_prologue(const Params& p, char* smem) {
    const int tid = VT, bid = VB, nblk = NVB;
    unsigned char* ws = p.ws;
    {
        float* sv = (float*)smem; float* red = sv + 3072; float* MOD = (float*)(ws + WS_MOD);
        for (int i = tid; i < 3072; i += 256) { const int j = i >> 10, k = i & 1023; const float v = j < 2 ? p.c[j * 1024 + k] : p.c_ctx[k]; sv[i] = v / (1.f + __expf(-v)); }
        __syncthreads();
        for (int it = bid; it < 192; it += nblk) {
            const int l = it / 96, n0 = (it % 96) * 64, col = tid & 63, kg = tid >> 6;
            const float* w = p.w_mod + (size_t)l * 1024 * 6144 + n0 + col;
            float a0 = 0.f, a1 = 0.f, a2 = 0.f;
#pragma unroll 8
            for (int k = kg * 256; k < kg * 256 + 256; ++k) { const float wv = w[(size_t)k * 6144]; a0 += sv[k] * wv; a1 += sv[1024 + k] * wv; a2 += sv[2048 + k] * wv; }
            red[(kg * 3 + 0) * 64 + col] = a0; red[(kg * 3 + 1) * 64 + col] = a1; red[(kg * 3 + 2) * 64 + col] = a2;
            __syncthreads();
            if (tid < 192) { const int j = tid >> 6, cc = tid & 63;
                const float s = red[(0 * 3 + j) * 64 + cc] + red[(1 * 3 + j) * 64 + cc] + red[(2 * 3 + j) * 64 + cc] + red[(3 * 3 + j) * 64 + cc];
                MOD[(l * 3 + j) * 6144 + n0 + cc] = s + p.b_mod[l * 6144 + n0 + cc]; }
            __syncthreads();
        }
    }
    {
        const int gt = bid * 256 + tid, gn = nblk * 256;
        float2* rope = (float2*)(ws + WS_ROPE);
        for (int i = gt; i < 2048; i += gn) { const int pos = i >> 4, f = i & 15; const float inv = powf(10000.f, -(float)f / 16.f); const float ang = (float)pos * inv; float s, c; sincosf(ang, &s, &c); rope[i] = make_float2(c, s); }
        bf16_t* wl = (bf16_t*)(ws + WS_WLRU);
        for (int i = gt; i < 2048 * 64; i += gn) { const int n = i >> 6, k = i & 63; const int h = n >> 8, d = (n >> 7) & 1, j = (n & 127) >> 1, g = n & 1;
            const float* W = g ? p.lru_wx : p.lru_wa; wl[i] = (bf16_t)f2bf(W[(((size_t)(d * 8 + h) * 64 + k) * 64) + j]); }
    }
    float* tile = (float*)smem;
    for (int l = 0; l < 2; ++l) {
        tr_job(tile, p.w_ff1 + (size_t)l * 1024 * 4096, 4096, (bf16_t*)(ws + WS_WFF1) + (size_t)l * 4096 * 1024, 1024, 4096, 0);
        tr_job(tile, p.w_ff2 + (size_t)l * 4096 * 1024, 1024, (bf16_t*)(ws + WS_WFF2) + (size_t)l * 4096 * 1024, 4096, 1024, 0);
    }
    tr_job(tile, p.w_in_even, 2560, (bf16_t*)(ws + WS_WINE), 1024, 2560, 0);
    tr_job(tile, p.w_out_even, 1024, (bf16_t*)(ws + WS_WOUTE), 1024, 1024, 0);
    tr_job(tile, p.w_in_odd, 2336, (bf16_t*)(ws + WS_WINO), 1024, 2560, 1);
    tr_job(tile, p.w_out_odd, 1024, (bf16_t*)(ws + WS_WOUTO), 1024, 1024, 0);
}

__device__ __forceinline__ void phase_ln(const float* __restrict__ srcL, const float* __restrict__ srcC, const float* __restrict__ nw, const float* __restrict__ mod, int sh_slot, int sc_slot, bool latent_only, bf16_t* __restrict__ U) {
    const int lane = VT & 63, gw = VB * 4 + (VT >> 6), nwt = NVB * 4;
    const int nrows = latent_only ? NB * SEQ : NR;
    for (int idx = gw; idx < nrows; idx += nwt) {
        int b, pi; if (latent_only) { b = idx >> 13; pi = 256 + (idx & 8191); } else { b = idx / PP; pi = idx - b * PP; }
        const int R = b * PP + pi; const bool isc = pi < 256; const int ms = isc ? 2 : b;
        const float* src = isc ? srcC + (size_t)(b * 256 + pi) * 1024 : srcL + (size_t)(b * 8192 + pi - 256) * 1024;
        f32x4 v[4]; float ss = 0.f;
#pragma unroll
        for (int i = 0; i < 4; ++i) { v[i] = *(const f32x4*)(src + i * 256 + lane * 4); ss += v[i][0] * v[i][0] + v[i][1] * v[i][1] + v[i][2] * v[i][2] + v[i][3] * v[i][3]; }
        ss = wave_sum(ss);
        const float rstd = rsqrtf(ss * (1.f / 1024.f) + EPS);
        const float* sh = mod + ms * 6144 + sh_slot * 1024; const float* sc = mod + ms * 6144 + sc_slot * 1024;
#pragma unroll
        for (int i = 0; i < 4; ++i) { const int n = i * 256 + lane * 4;
            const f32x4 w4 = *(const f32x4*)(nw + n), s4 = *(const f32x4*)(sc + n), h4 = *(const f32x4*)(sh + n);
            const f32x4 y = v[i] * rstd * w4 * (s4 + 1.f) + h4;
            *(u32x2*)(U + (size_t)R * 1024 + n) = (u32x2){pack2(y[0], y[1]), pack2(y[2], y[3])}; }
    }
}

__device__ __forceinline__ void phase_final(const float* __restrict__ fw, float* __restrict__ out) {
    const int lane = VT & 63, gw = VB * 4 + (VT >> 6), nwt = NVB * 4;
    for (int idx = gw; idx < NB * SEQ; idx += nwt) {
        float* row = out + (size_t)idx * 1024;
        f32x4 v[4]; float ss = 0.f;
#pragma unroll
        for (int i = 0; i < 4; ++i) { v[i] = *(const f32x4*)(row + i * 256 + lane * 4); ss += v[i][0] * v[i][0] + v[i][1] * v[i][1] + v[i][2] * v[i][2] + v[i][3] * v[i][3]; }
        ss = wave_sum(ss);
        const float rstd = rsqrtf(ss * (1.f / 1024.f) + EPS);
#pragma unroll
        for (int i = 0; i < 4; ++i) { const int n = i * 256 + lane * 4; const f32x4 w4 = *(const f32x4*)(fw + n); *(f32x4*)(row + n) = v[i] * rstd * w4; }
    }
}

template <class Epi>
__device__ __forceinline__ void gemm128_phase(char* smem, const bf16_t* __restrict__ A, int lda, const bf16_t* __restrict__ WT, int K, int nMt, int nNt, int rowmode, int lru, const Epi& epi) {
    bf16_t* As = (bf16_t*)smem; bf16_t* Bs = As + 128 * 72;
    const int tid = VT, lane = tid & 63, wid = tid >> 6, wm = wid >> 1, wn = wid & 1;
    const int lr = lane & 15, lq = lane >> 4;
    const int ntiles = nMt * nNt;
    for (int tile = VB; tile < ntiles; tile += NVB) {
        const int mt = tile / nNt, nt = tile - mt * nNt;
        const int row0 = rowmode ? ((mt >> 6) * PP + 256 + (mt & 63) * 128) : mt * 128;
        const bf16_t* Ag = A + (size_t)row0 * lda + (lru ? (nt >> 1) * 64 : 0);
        const bf16_t* Bg = WT + (size_t)nt * 128 * K;
        f32x4 acc[4][4];
#pragma unroll
        for (int i = 0; i < 4; ++i)
#pragma unroll
            for (int j = 0; j < 4; ++j) acc[i][j] = (f32x4){0.f, 0.f, 0.f, 0.f};
        u32x4 ra[4], rb[4];
#pragma unroll
        for (int i = 0; i < 4; ++i) { const int c = tid + 256 * i, r = c >> 3, kc = (c & 7) * 8; ra[i] = *(const u32x4*)(Ag + (size_t)r * lda + kc); rb[i] = *(const u32x4*)(Bg + (size_t)r * K + kc); }
        for (int k0 = 0; k0 < K; k0 += 64) {
            __syncthreads();
#pragma unroll
            for (int i = 0; i < 4; ++i) { const int c = tid + 256 * i, r = c >> 3, kc = (c & 7) * 8; *(u32x4*)(As + r * 72 + kc) = ra[i]; *(u32x4*)(Bs + r * 72 + kc) = rb[i]; }
            __syncthreads();
            if (k0 + 64 < K) {
#pragma unroll
                for (int i = 0; i < 4; ++i) { const int c = tid + 256 * i, r = c >> 3, kc = (c & 7) * 8 + k0 + 64; ra[i] = *(const u32x4*)(Ag + (size_t)r * lda + kc); rb[i] = *(const u32x4*)(Bg + (size_t)r * K + kc); }
            }
#pragma unroll
            for (int ks = 0; ks < 2; ++ks) {
                bf16x8 af[4], bfr[4];
#pragma unroll
                for (int i = 0; i < 4; ++i) { af[i] = *(const bf16x8*)(As + (wm * 64 + i * 16 + lr) * 72 + ks * 32 + lq * 8); bfr[i] = *(const bf16x8*)(Bs + (wn * 64 + i * 16 + lr) * 72 + ks * 32 + lq * 8); }
#pragma unroll
                for (int mi = 0; mi < 4; ++mi)
#pragma unroll
                    for (int ni = 0; ni < 4; ++ni) acc[mi][ni] = __builtin_amdgcn_mfma_f32_16x16x32_bf16(bfr[ni], af[mi], acc[mi][ni], 0, 0, 0);
            }
        }
        epi(acc, row0 + wm * 64, nt * 128 + wn * 64, lane);
    }
}

struct EpiResid {
    const float* srcL; const float* srcC; float* dstL; float* dstC; const float* mod; int slot;
    __device__ __forceinline__ void operator()(const f32x4 (&acc)[4][4], int Rb, int nb, int lane) const {
        const int lr = lane & 15, lq = lane >> 4;
#pragma unroll
        for (int mi = 0; mi < 4; ++mi) {
            const int R = Rb + mi * 16 + lr; const int b = R / PP, pi = R - b * PP; const bool isc = pi < 256; const int ms = isc ? 2 : b;
            const size_t ro = isc ? (size_t)(b * 256 + pi) * 1024 : (size_t)(b * 8192 + pi - 256) * 1024;
            const float* s = (isc ? srcC : srcL) + ro; float* d = (isc ? dstC : dstL) + ro; const float* g = mod + ms * 6144 + slot * 1024;
#pragma unroll
            for (int ni = 0; ni < 4; ++ni) { const int n = nb + ni * 16 + lq * 4; const f32x4 h = *(const f32x4*)(s + n), gg = *(const f32x4*)(g + n); *(f32x4*)(d + n) = h + gg * acc[mi][ni]; }
        }
    }
};
struct EpiFF1 {
    bf16_t* FF;
    __device__ __forceinline__ void operator()(const f32x4 (&acc)[4][4], int Rb, int nb, int lane) const {
        const int lr = lane & 15, lq = lane >> 4;
#pragma unroll
        for (int mi = 0; mi < 4; ++mi) { const int R = Rb + mi * 16 + lr;
#pragma unroll
            for (int ni = 0; ni < 4; ++ni) { const int n = nb + ni * 16 + lq * 4; f32x4 v = acc[mi][ni];
#pragma unroll
                for (int e = 0; e < 4; ++e) { const float r = fmaxf(v[e], 0.f); v[e] = r * r; }
                *(u32x2*)(FF + (size_t)R * 4096 + n) = (u32x2){pack2(v[0], v[1]), pack2(v[2], v[3])}; } }
    }
};
__device__ __forceinline__ float gelu_tanh(float x) { const float u = 0.7978845608028654f * (x + 0.044715f * x * x * x); const float t = 1.f - 2.f / (1.f + __expf(2.f * u)); return 0.5f * x * (1.f + t); }
struct EpiInEven {
    bf16_t *Qn, *Kn, *VTn, *XL, *GG;
    __device__ __forceinline__ void operator()(const f32x4 (&acc)[4][4], int Rb, int nb, int lane) const {
        const int lr = lane & 15, lq = lane >> 4;
#pragma unroll
        for (int mi = 0; mi < 4; ++mi) { const int R = Rb + mi * 16 + lr; const int b = R / PP, pi = R - b * PP;
#pragma unroll
            for (int ni = 0; ni < 4; ++ni) { const int n = nb + ni * 16 + lq * 4; const f32x4 a = acc[mi][ni];
                if (n < 512) *(u32x2*)(Qn + (size_t)R * 512 + n) = (u32x2){pack2(a[0] * 0.125f, a[1] * 0.125f), pack2(a[2] * 0.125f, a[3] * 0.125f)};
                else if (n < 1024) *(u32x2*)(Kn + (size_t)R * 512 + (n - 512)) = (u32x2){pack2(a[0], a[1]), pack2(a[2], a[3])};
                else if (n < 1536) { const int hh = (n - 1024) >> 6, d0 = (n - 1024) & 63; bf16_t* vp = VTn + ((size_t)((b * 8 + hh) * 64 + d0)) * PP + pi;
#pragma unroll
                    for (int e = 0; e < 4; ++e) vp[(size_t)e * PP] = (bf16_t)f2bf(a[e]); }
                else if (n < 2048) *(u32x2*)(XL + (size_t)R * 512 + (n - 1536)) = (u32x2){pack2(a[0], a[1]), pack2(a[2], a[3])};
                else *(u32x2*)(GG + (size_t)R * 512 + (n - 2048)) = (u32x2){pack2(gelu_tanh(a[0]), gelu_tanh(a[1])), pack2(gelu_tanh(a[2]), gelu_tanh(a[3]))};
            } }
    }
};
struct EpiLru {
    const bf16_t* XC; __half2* AB; const float *ba, *bx, *lam;
    __device__ __forceinline__ void operator()(const f32x4 (&acc)[4][4], int Rb, int nb, int lane) const {
        const int lr = lane & 15, lq = lane >> 4;
        const int h = nb >> 8, d = (nb >> 7) & 1, colb = nb & 127;
#pragma unroll
        for (int mi = 0; mi < 4; ++mi) { const int R = Rb + mi * 16 + lr;
#pragma unroll
            for (int ni = 0; ni < 4; ++ni) { const int j0 = (colb + ni * 16 + lq * 4) >> 1; const int c = h * 64 + j0; __half2 o[2];
#pragma unroll
                for (int e2 = 0; e2 < 2; ++e2) { const int cc = c + e2;
                    const float za = acc[mi][ni][2 * e2] + ba[d * 512 + cc], zx = acc[mi][ni][2 * e2 + 1] + bx[d * 512 + cc];
                    const float r = sigmoidf_(za), ig = sigmoidf_(zx);
                    const float sp = log1pf(__expf(-lam[d * 512 + cc]));
                    const float la = -8.f * r * sp;
                    const float xv = bf2f(XC[(size_t)R * 512 + cc]);
                    const float bb = sqrtf(fmaxf(-expm1f(2.f * la), 0.f)) * ig * xv;
                    o[e2] = __floats2half2_rn(la, bb); }
                __half2* dst = AB + ((size_t)d * NR + R) * 512 + c; dst[0] = o[0]; dst[1] = o[1]; } }
    }
};
struct EpiInOdd {
    bf16_t *Gq, *Gk, *Gv, *Gg, *Qg, *Kg, *VTg; float* LR; const float *qnw, *knw; const float2* rope;
    __device__ __forceinline__ void operator()(const f32x4 (&acc)[4][4], int Rb, int nb, int lane) const {
        const int lr = lane & 15, lq = lane >> 4;
        if (nb < 1536) {
#pragma unroll
            for (int mi = 0; mi < 4; ++mi) { const int R = Rb + mi * 16 + lr;
#pragma unroll
                for (int ni = 0; ni < 4; ++ni) { const int n = nb + ni * 16 + lq * 4; const f32x4 a = acc[mi][ni];
                    if (n < 256) *(u32x2*)(Gq + (size_t)R * 256 + n) = (u32x2){pack2(a[0], a[1]), pack2(a[2], a[3])};
                    else if (n < 512) *(u32x2*)(Gk + (size_t)R * 256 + (n - 256)) = (u32x2){pack2(a[0], a[1]), pack2(a[2], a[3])};
                    else if (n < 1024) *(u32x2*)(Gv + (size_t)R * 512 + (n - 512)) = (u32x2){pack2(a[0], a[1]), pack2(a[2], a[3])};
                    else { f32x4 s;
#pragma unroll
                        for (int e = 0; e < 4; ++e) s[e] = a[e] * sigmoidf_(a[e]);
                        *(u32x2*)(Gg + (size_t)R * 512 + (n - 1024)) = (u32x2){pack2(s[0], s[1]), pack2(s[2], s[3])}; } } }
        } else if (nb < 2176) {
            const bool isq = nb < 2048; const float* nwp = isq ? qnw : knw;
#pragma unroll
            for (int mi = 0; mi < 4; ++mi) { const int R = Rb + mi * 16 + lr; const int b = R / PP, pi = R - b * PP;
                float ss = 0.f;
#pragma unroll
                for (int ni = 0; ni < 4; ++ni)
#pragma unroll
                    for (int e = 0; e < 4; ++e) ss += acc[mi][ni][e] * acc[mi][ni][e];
                ss += __shfl_xor(ss, 16); ss += __shfl_xor(ss, 32);
                const float rstd = rsqrtf(ss * (1.f / 64.f) + EPS);
                f32x4 y[4];
#pragma unroll
                for (int ni = 0; ni < 4; ++ni) { const f32x4 w4 = *(const f32x4*)(nwp + ni * 16 + lq * 4); y[ni] = acc[mi][ni] * rstd * w4; }
                if (pi >= 256) { const int t = pi - 256, prow = t >> 6, pcol = t & 63;
#pragma unroll
                    for (int e = 0; e < 4; ++e) { const int i = lq * 4 + e; const float2 cr = rope[prow * 16 + i], cc = rope[pcol * 16 + i];
                        const float a1 = y[0][e], a2 = y[1][e]; y[0][e] = a1 * cr.x - a2 * cr.y; y[1][e] = a2 * cr.x + a1 * cr.y;
                        const float b1 = y[2][e], b2 = y[3][e]; y[2][e] = b1 * cc.x - b2 * cc.y; y[3][e] = b2 * cc.x + b1 * cc.y; } }
                if (isq) {
#pragma unroll
                    for (int ni = 0; ni < 4; ++ni) { const f32x4 v = y[ni] * 0.125f; *(u32x2*)(Qg + (size_t)R * 512 + (nb - 1536) + ni * 16 + lq * 4) = (u32x2){pack2(v[0], v[1]), pack2(v[2], v[3])}; }
                } else {
#pragma unroll
                    for (int ni = 0; ni < 4; ++ni) { const f32x4 v = y[ni]; *(u32x2*)(Kg + (size_t)R * 128 + (nb - 2048) + ni * 16 + lq * 4) = (u32x2){pack2(v[0], v[1]), pack2(v[2], v[3])}; }
                } }
        } else if (nb < 2304) {
            const int kvh = (nb - 2176) >> 6;
#pragma unroll
            for (int mi = 0; mi < 4; ++mi) { const int R = Rb + mi * 16 + lr; const int b = R / PP, pi = R - b * PP;
#pragma unroll
                for (int ni = 0; ni < 4; ++ni) { bf16_t* vp = VTg + ((size_t)((b * 2 + kvh) * 64 + ni * 16 + lq * 4)) * PP + pi;
#pragma unroll
                    for (int e = 0; e < 4; ++e) vp[(size_t)e * PP] = (bf16_t)f2bf(acc[mi][ni][e]); } }
        } else if (nb == 2304) {
#pragma unroll
            for (int mi = 0; mi < 4; ++mi) { const int R = Rb + mi * 16 + lr;
#pragma unroll
                for (int ni = 0; ni < 2; ++ni) *(f32x4*)(LR + (size_t)R * 32 + ni * 16 + lq * 4) = acc[mi][ni]; }
        }
    }
};

__device__ __forceinline__ void attn_unit(char* smem, const bf16_t* __restrict__ Qp, int ldq, const bf16_t* __restrict__ Kp, int ldk, const bf16_t* __restrict__ VTp,
                                          bf16_t* __restrict__ Op, int ldo, int ntiles, int mode, int r0, int rs0, const float* __restrict__ rpb_h) {
    bf16_t* Ks = (bf16_t*)smem;
    bf16_t* Vs = Ks + 2 * 64 * 72;
    float* rp = (float*)(Vs + 2 * 64 * 72);
    const int tid = VT, lane = tid & 63, w = tid >> 6, l31 = lane & 31, lh = lane >> 5;
    if (mode == 1) { for (int i = tid; i < 465; i += 256) rp[i] = rpb_h[i]; }
    bf16x8 qf[4];
    { const bf16_t* q = Qp + (size_t)(w * 32 + l31) * ldq + lh * 8;
#pragma unroll
        for (int ks = 0; ks < 4; ++ks) qf[ks] = *(const bf16x8*)(q + ks * 16); }
    f32x16 ot[2];
#pragma unroll
    for (int i = 0; i < 16; ++i) { ot[0][i] = 0.f; ot[1][i] = 0.f; }
    float m = -1e30f, l = 0.f;
    u32x4 rk[2], rv[2];
#define ATT_GLOAD(t_) do { const int t__ = (t_); const int pos__ = (mode == 1) ? (t__ < 4 ? t__ * 64 : 256 + (rs0 + t__ - 4) * 64) : t__ * 64; \
        _Pragma("unroll") for (int i = 0; i < 2; ++i) { const int c = tid + 256 * i, r = c >> 3, cc = (c & 7) * 8; \
            rk[i] = *(const u32x4*)(Kp + (size_t)(pos__ + r) * ldk + cc); rv[i] = *(const u32x4*)(VTp + (size_t)r * PP + pos__ + cc); } } while (0)
#define ATT_SSTORE(buf_) do { _Pragma("unroll") for (int i = 0; i < 2; ++i) { const int c = tid + 256 * i, r = c >> 3, cc = (c & 7) * 8; \
            *(u32x4*)(Ks + (buf_) * 64 * 72 + r * 72 + cc) = rk[i]; *(u32x4*)(Vs + (buf_) * 64 * 72 + r * 72 + cc) = rv[i]; } } while (0)
    ATT_GLOAD(0); ATT_SSTORE(0); __syncthreads();
    for (int t = 0; t < ntiles; ++t) {
        if (t + 1 < ntiles) ATT_GLOAD(t + 1);
        const bf16_t* ks_ = Ks + (t & 1) * 64 * 72; const bf16_t* vs_ = Vs + (t & 1) * 64 * 72;
        bool skip = false; int kr = 0, rq = 0;
        const bool local = (mode == 1) && (t >= 4);
        if (local) { kr = rs0 + t - 4; rq = r0 + (w >> 1); const int rsq = clampi(rq - 4, 0, 120); skip = (kr < rsq) || (kr >= rsq + 8); }
        if (!skip) {
            f32x16 st[2];
#pragma unroll
            for (int i = 0; i < 16; ++i) { st[0][i] = 0.f; st[1][i] = 0.f; }
#pragma unroll
            for (int kt = 0; kt < 2; ++kt)
#pragma unroll
                for (int ks = 0; ks < 4; ++ks) { const bf16x8 kf = *(const bf16x8*)(ks_ + (kt * 32 + l31) * 72 + ks * 16 + lh * 8); st[kt] = __builtin_amdgcn_mfma_f32_32x32x16_bf16(kf, qf[ks], st[kt], 0, 0, 0); }
            if (local) { const int qc = (w & 1) * 32 + l31, cs = clampi(qc - 8, 0, 48); const float* rrow = rp + (kr - rq + 7) * 31;
#pragma unroll
                for (int kt = 0; kt < 2; ++kt)
#pragma unroll
                    for (int i = 0; i < 16; ++i) { const int kc = kt * 32 + (i & 3) + 8 * (i >> 2) + 4 * lh; const bool ok = (kc >= cs) && (kc < cs + 16);
                        const float bias = rrow[clampi(kc - qc + 15, 0, 30)]; st[kt][i] = ok ? st[kt][i] + bias : -1e30f; } }
            float mx = st[0][0];
#pragma unroll
            for (int i = 1; i < 16; ++i) mx = fmaxf(mx, st[0][i]);
#pragma unroll
            for (int i = 0; i < 16; ++i) mx = fmaxf(mx, st[1][i]);
            mx = fmaxf(mx, __shfl_xor(mx, 32));
            const float mn = fmaxf(m, mx); const float alpha = exp2f((m - mn) * LOG2E); m = mn;
            const float mb = mn * LOG2E; float ps = 0.f;
#pragma unroll
            for (int kt = 0; kt < 2; ++kt)
#pragma unroll
                for (int i = 0; i < 16; ++i) { const float pe = exp2f(st[kt][i] * LOG2E - mb); st[kt][i] = pe; ps += pe; }
            l = l * alpha + ps;
#pragma unroll
            for (int i = 0; i < 16; ++i) { ot[0][i] *= alpha; ot[1][i] *= alpha; }
#pragma unroll
            for (int kt = 0; kt < 2; ++kt)
#pragma unroll
                for (int s = 0; s < 2; ++s) {
                    u32x4 pw; pw[0] = pack2(st[kt][8 * s + 0], st[kt][8 * s + 1]); pw[1] = pack2(st[kt][8 * s + 2], st[kt][8 * s + 3]); pw[2] = pack2(st[kt][8 * s + 4], st[kt][8 * s + 5]); pw[3] = pack2(st[kt][8 * s + 6], st[kt][8 * s + 7]);
                    const bf16x8 pf = __builtin_bit_cast(bf16x8, pw);
#pragma unroll
                    for (int dt = 0; dt < 2; ++dt) { const bf16_t* vp = vs_ + (dt * 32 + l31) * 72 + kt * 32 + s * 16 + lh * 4;
                        const u32x2 v0 = *(const u32x2*)vp, v1 = *(const u32x2*)(vp + 8); const u32x4 vw = (u32x4){v0[0], v0[1], v1[0], v1[1]};
                        ot[dt] = __builtin_amdgcn_mfma_f32_32x32x16_bf16(__builtin_bit_cast(bf16x8, vw), pf, ot[dt], 0, 0, 0); } }
        }
        if (t + 1 < ntiles) ATT_SSTORE((t + 1) & 1);
        __syncthreads();
    }
#undef ATT_GLOAD
#undef ATT_SSTORE
    l += __shfl_xor(l, 32);
    const float inv = 1.f / l;
    bf16_t* o = Op + (size_t)(w * 32 + l31) * ldo;
#pragma unroll
    for (int dt = 0; dt < 2; ++dt)
#pragma unroll
        for (int g = 0; g < 4; ++g) { const int d = dt * 32 + 8 * g + 4 * lh;
            *(u32x2*)(o + d) = (u32x2){pack2(ot[dt][4 * g] * inv, ot[dt][4 * g + 1] * inv), pack2(ot[dt][4 * g + 2] * inv, ot[dt][4 * g + 3] * inv)}; }
}

__device__ __forceinline__ void phase_na(const Params& p, char* smem) {
    unsigned char* ws = p.ws;
    const bf16_t* Qn = (const bf16_t*)(ws + R0_Q); const bf16_t* Kn = (const bf16_t*)(ws + R0_K); const bf16_t* VTn = (const bf16_t*)(ws + R0_VT);
    bf16_t* MO = (bf16_t*)(ws + WS_U);
    for (int u = VB; u < 1024 + 32; u += NVB) {
        if (u < 1024) { const int b = u >> 9, h = (u >> 6) & 7, qb = u & 63; const int r0 = qb * 2;
            const int rs0 = clampi(r0 - 4, 0, 120), rs1 = clampi(r0 - 3, 0, 120); const int nl = rs1 + 8 - rs0;
            const size_t Rq = (size_t)b * PP + 256 + qb * 128;
            attn_unit(smem, Qn + Rq * 512 + h * 64, 512, Kn + (size_t)b * PP * 512 + h * 64, 512, VTn + (size_t)((b * 8 + h) * 64) * PP, MO + Rq * 1024 + h * 64, 1024, 4 + nl, 1, r0, rs0, p.na_rpb + h * 465);
        } else { const int v = u - 1024; const int b = v >> 4, h = (v >> 1) & 7, qb = v & 1;
            const size_t Rq = (size_t)b * PP + qb * 128;
            attn_unit(smem, Qn + Rq * 512 + h * 64, 512, Kn + (size_t)b * PP * 512 + h * 64, 512, VTn + (size_t)((b * 8 + h) * 64) * PP, MO + Rq * 1024 + h * 64, 1024, 4, 0, 0, 0, nullptr);
        }
    }
    const bf16_t* XL = (const bf16_t*)(ws + R0_XL); bf16_t* XC = (bf16_t*)(ws + R0_XC);
    const int gt = VB * 256 + VT, gn = NVB * 256;
    for (int idx = gt; idx < NR * 64; idx += gn) {
        const int R = idx >> 6, c8 = (idx & 63) * 8; const int b = R / PP, pi = R - b * PP; const int lo = pi < 256 ? 0 : 256, hi = pi < 256 ? 256 : PP;
        float a[8];
        { const f32x4 b0 = *(const f32x4*)(p.lru_conv_b + c8), b1 = *(const f32x4*)(p.lru_conv_b + c8 + 4); a[0] = b0[0]; a[1] = b0[1]; a[2] = b0[2]; a[3] = b0[3]; a[4] = b1[0]; a[5] = b1[1]; a[6] = b1[2]; a[7] = b1[3]; }
#pragma unroll
        for (int j = 0; j < 4; ++j) { const int pj = pi + j - 2;
            if (pj >= lo && pj < hi) { const u32x4 xv = *(const u32x4*)(XL + (size_t)(b * PP + pj) * 512 + c8);
                const f32x4 w0 = *(const f32x4*)(p.lru_conv_w + j * 512 + c8), w1 = *(const f32x4*)(p.lru_conv_w + j * 512 + c8 + 4);
                a[0] += w0[0] * bflo(xv[0]); a[1] += w0[1] * bfhi(xv[0]); a[2] += w0[2] * bflo(xv[1]); a[3] += w0[3] * bfhi(xv[1]);
                a[4] += w1[0] * bflo(xv[2]); a[5] += w1[1] * bfhi(xv[2]); a[6] += w1[2] * bflo(xv[3]); a[7] += w1[3] * bfhi(xv[3]); } }
        *(u32x4*)(XC + (size_t)R * 512 + c8) = (u32x4){pack2(a[0], a[1]), pack2(a[2], a[3]), pack2(a[4], a[5]), pack2(a[6], a[7])};
    }
}

__device__ __forceinline__ void phase_scan1(const Params& p) {
    const __half2* AB = (const __half2*)(p.ws + R0_AB); float2* SUM = (float2*)(p.ws + R0_SUM);
    for (int it = VB; it < 1056; it += NVB) {
        const int cgp = it & 1, tc = (it >> 1) % 132, db = (it >> 1) / 132, b = db & 1, d = db >> 1;
        const int c = cgp * 256 + VT;
        const __half2* ab = AB + ((size_t)d * NR + (size_t)b * PP + tc * 64) * 512 + c;
        float h = 0.f, ap = 0.f;
#pragma unroll 8
        for (int s = 0; s < 64; ++s) { const int tt = d ? 63 - s : s; const __half2 v = ab[(size_t)tt * 512]; const float la = __low2float(v), bb = __high2float(v); h = __expf(la) * h + bb; ap += la; }
        SUM[((size_t)(d * 2 + b) * 132 + tc) * 512 + c] = make_float2(__expf(ap), h);
    }
}
__device__ __forceinline__ void phase_scan2(const Params& p) {
    const __half2* AB = (const __half2*)(p.ws + R0_AB); const float2* SUM = (const float2*)(p.ws + R0_SUM);
    const bf16_t* GG = (const bf16_t*)(p.ws + R0_GG); bf16_t* MO = (bf16_t*)(p.ws + WS_U);
    for (int it = VB; it < 528; it += NVB) {
        const int cgp = it & 1, tc = (it >> 1) % 132, b = (it >> 1) / 132;
        const int c = cgp * 256 + VT; const size_t R0 = (size_t)b * PP + tc * 64;
        float hf[64];
        {
            float h = 0.f; const float2* sm = SUM + ((size_t)(0 * 2 + b) * 132) * 512 + c;
            for (int jj = 0; jj < tc; ++jj) { const float2 s = sm[(size_t)jj * 512]; h = s.x * h + s.y; }
            const __half2* ab = AB + ((size_t)0 * NR + R0) * 512 + c;
#pragma unroll
            for (int s = 0; s < 64; ++s) { const __half2 v = ab[(size_t)s * 512]; h = __expf(__low2float(v)) * h + __high2float(v); hf[s] = h; }
        }
        {
            const int j = tc < 4 ? 3 - tc : 135 - tc;
            float h = 0.f; const float2* sm = SUM + ((size_t)(1 * 2 + b) * 132) * 512 + c;
            for (int jj = 0; jj < j; ++jj) { const int tcj = jj < 4 ? 3 - jj : 135 - jj; const float2 s = sm[(size_t)tcj * 512]; h = s.x * h + s.y; }
            const __half2* ab = AB + ((size_t)1 * NR + R0) * 512 + c;
#pragma unroll
            for (int s = 0; s < 64; ++s) { const int tt = 63 - s; const __half2 v = ab[(size_t)tt * 512]; h = __expf(__low2float(v)) * h + __high2float(v);
                const float g = bf2f(GG[(R0 + tt) * 512 + c]);
                MO[(R0 + tt) * 1024 + 512 + c] = (bf16_t)f2bf((hf[tt] + h) * g); }
        }
    }
}

__device__ __forceinline__ void gla_gates(const Params& p, float* gs, const float* __restrict__ LR, size_t R0, int d, int h) {
    const int tid = VT, dk = tid & 63, tg = tid >> 6;
    float wv[16];
#pragma unroll
    for (int r = 0; r < 16; ++r) wv[r] = p.gla_wa2[(d * 16 + r) * 256 + h * 64 + dk];
    const float bav = p.gla_ba[d * 256 + h * 64 + dk];
    for (int ti = 0; ti < 16; ++ti) { const int t = tg * 16 + ti; const float* lrp = LR + (R0 + t) * 32 + d * 16; float z = bav;
#pragma unroll
        for (int r = 0; r < 16; ++r) z += lrp[r] * wv[r];
        const float ls = fminf(z, 0.f) - log1pf(__expf(-fabsf(z))); gs[t * 64 + dk] = ls * (1.f / 16.f); }
    __syncthreads();
    if (tid < 64) { float s = 0.f;
        if (d == 0) { for (int t = 0; t < 64; ++t) { s += gs[t * 64 + tid]; gs[t * 64 + tid] = s; } }
        else { for (int t = 63; t >= 0; --t) { s += gs[t * 64 + tid]; gs[t * 64 + tid] = s; } } }
    __syncthreads();
}
__device__ __forceinline__ void gla_load_vt(bf16_t* VTs, const bf16_t* __restrict__ Gv, size_t R0, int h) {
    const int tid = VT, t = tid >> 2, vq = (tid & 3) * 32; const bf16_t* src = Gv + (R0 + t) * 512 + h * 128 + vq;
#pragma unroll
    for (int q = 0; q < 4; ++q) { const u32x4 v = *(const u32x4*)(src + q * 8);
#pragma unroll
        for (int e = 0; e < 4; ++e) { VTs[(vq + q * 8 + 2 * e) * 72 + t] = (bf16_t)(v[e] & 0xffffu); VTs[(vq + q * 8 + 2 * e + 1) * 72 + t] = (bf16_t)(v[e] >> 16); } }
}
__device__ __forceinline__ void phase_gla1(const Params& p, char* smem) {
    unsigned char* ws = p.ws;
    const bf16_t* Gk = (const bf16_t*)(ws + R1_GK); const bf16_t* Gv = (const bf16_t*)(ws + R1_GV); const float* LR = (const float*)(ws + R1_LR);
    float* UC = (float*)(ws + R1_UC); float* DEC = (float*)(ws + R1_DEC);
    float* gs = (float*)smem; bf16_t* KD = (bf16_t*)(smem + 16384); bf16_t* VTs = KD + 64 * 72;
    const int tid = VT, lane = tid & 63, w = tid >> 6, lr = lane & 15, lq = lane >> 4;
    for (int it = VB; it < 2112; it += NVB) {
        const int tc = it % 132, h = (it / 132) & 3, d = (it / 528) & 1, b = it / 1056;
        const size_t R0 = (size_t)b * PP + tc * 64;
        __syncthreads();
        gla_gates(p, gs, LR, R0, d, h);
        const int tl = d ? 0 : 63;
        { const int t = tid >> 2, dq = (tid & 3) * 16; const bf16_t* src = Gk + (R0 + t) * 256 + h * 64 + dq;
#pragma unroll
            for (int q = 0; q < 2; ++q) { const u32x4 v = *(const u32x4*)(src + q * 8);
#pragma unroll
                for (int e = 0; e < 4; ++e) { const int dk0 = dq + q * 8 + 2 * e;
                    const float k0 = bflo(v[e]) * __expf(gs[tl * 64 + dk0] - gs[t * 64 + dk0]); const float k1 = bfhi(v[e]) * __expf(gs[tl * 64 + dk0 + 1] - gs[t * 64 + dk0 + 1]);
                    KD[dk0 * 72 + t] = (bf16_t)f2bf(k0); KD[(dk0 + 1) * 72 + t] = (bf16_t)f2bf(k1); } } }
        gla_load_vt(VTs, Gv, R0, h);
        __syncthreads();
        f32x4 acc[8];
#pragma unroll
        for (int i = 0; i < 8; ++i) acc[i] = (f32x4){0.f, 0.f, 0.f, 0.f};
#pragma unroll
        for (int ks = 0; ks < 2; ++ks) { const bf16x8 a = *(const bf16x8*)(KD + (16 * w + lr) * 72 + ks * 32 + lq * 8);
#pragma unroll
            for (int nt = 0; nt < 8; ++nt) { const bf16x8 bb = *(const bf16x8*)(VTs + (16 * nt + lr) * 72 + ks * 32 + lq * 8); acc[nt] = __builtin_amdgcn_mfma_f32_16x16x32_bf16(a, bb, acc[nt], 0, 0, 0); } }
        const int j = d == 0 ? tc : (tc < 4 ? 3 - tc : 135 - tc);
        const size_t chain = (size_t)((b * 2 + d) * 4 + h);
        float* up = UC + (chain * 132 + j) * 8192;
#pragma unroll
        for (int nt = 0; nt < 8; ++nt)
#pragma unroll
            for (int e = 0; e < 4; ++e) up[(16 * w + 4 * lq + e) * 128 + 16 * nt + lr] = acc[nt][e];
        if (tid < 64) DEC[(chain * 132 + j) * 64 + tid] = __expf(gs[tl * 64 + tid]);
    }
}
__device__ __forceinline__ void phase_gla2(const Params& p) {
    float* UC = (float*)(p.ws + R1_UC); const float* DEC = (const float*)(p.ws + R1_DEC);
    const int gt = VB * 256 + VT, gn = NVB * 256;
    for (int e = gt; e < 16 * 8192; e += gn) { const int chain = e >> 13, el = e & 8191, dk = el >> 7;
        float* u = UC + (size_t)chain * 132 * 8192 + el; const float* dec = DEC + (size_t)chain * 132 * 64 + dk; float S = 0.f;
#pragma unroll 4
        for (int j = 0; j < 132; ++j) { const float uv = u[(size_t)j * 8192]; const float dv = dec[j * 64]; u[(size_t)j * 8192] = S; S = dv * S + uv; } }
}
__device__ __forceinline__ void phase_gla3(const Params& p, char* smem) {
    unsigned char* ws = p.ws;
    const bf16_t* Gq = (const bf16_t*)(ws + R1_GQ); const bf16_t* Gk = (const bf16_t*)(ws + R1_GK); const bf16_t* Gv = (const bf16_t*)(ws + R1_GV); const bf16_t* Gg = (const bf16_t*)(ws + R1_GG);
    const float* LR = (const float*)(ws + R1_LR); const float* UC = (const float*)(ws + R1_UC); bf16_t* MO = (bf16_t*)(ws + WS_U);
    float* gs = (float*)smem; bf16_t* ATT = (bf16_t*)smem; bf16_t* QI = (bf16_t*)(smem + 16384); bf16_t* KI = QI + 64 * 72; bf16_t* VTs = KI + 64 * 72; bf16_t* SPT = VTs + 128 * 72;
    const int tid = VT, lane = tid & 63, w = tid >> 6, lr = lane & 15, lq = lane >> 4;
    for (int it = VB; it < 1024; it += NVB) {
        const int tcl = it & 127, h = (it >> 7) & 3, b = it >> 9; const int tc = 4 + tcl;
        const size_t R0 = (size_t)b * PP + tc * 64;
        __syncthreads();
        gla_load_vt(VTs, Gv, R0, h);
        f32x4 acc[8];
#pragma unroll
        for (int i = 0; i < 8; ++i) acc[i] = (f32x4){0.f, 0.f, 0.f, 0.f};
        for (int d = 0; d < 2; ++d) {
            const int j = d == 0 ? tc : 135 - tc; const size_t chain = (size_t)((b * 2 + d) * 4 + h);
            __syncthreads();
            gla_gates(p, gs, LR, R0, d, h);
            { const int t = tid >> 2, dq = (tid & 3) * 16; const bf16_t* qs = Gq + (R0 + t) * 256 + h * 64 + dq; const bf16_t* ksrc = Gk + (R0 + t) * 256 + h * 64 + dq;
#pragma unroll
                for (int q = 0; q < 2; ++q) { const u32x4 qv = *(const u32x4*)(qs + q * 8), kv = *(const u32x4*)(ksrc + q * 8); u32x4 qo, ko;
#pragma unroll
                    for (int e = 0; e < 4; ++e) { const int dk0 = dq + q * 8 + 2 * e; const float g0 = gs[t * 64 + dk0], g1 = gs[t * 64 + dk0 + 1];
                        const float e0 = __expf(g0), e1 = __expf(g1);
                        qo[e] = pack2(bflo(qv[e]) * 0.125f * e0, bfhi(qv[e]) * 0.125f * e1); ko[e] = pack2(bflo(kv[e]) / e0, bfhi(kv[e]) / e1); }
                    *(u32x4*)(QI + t * 72 + dq + q * 8) = qo; *(u32x4*)(KI + t * 72 + dq + q * 8) = ko; } }
            { const int dk = tid >> 2, vq = (tid & 3) * 32; const float* sp = UC + (chain * 132 + j) * 8192 + dk * 128 + vq;
#pragma unroll
                for (int q = 0; q < 8; ++q) { const f32x4 v = *(const f32x4*)(sp + q * 4);
#pragma unroll
                    for (int e = 0; e < 4; ++e) SPT[(vq + q * 4 + e) * 72 + dk] = (bf16_t)f2bf(v[e]); } }
            __syncthreads();
            f32x4 at[4];
#pragma unroll
            for (int i = 0; i < 4; ++i) at[i] = (f32x4){0.f, 0.f, 0.f, 0.f};
#pragma unroll
            for (int ks = 0; ks < 2; ++ks) { const bf16x8 a = *(const bf16x8*)(QI + (16 * w + lr) * 72 + ks * 32 + lq * 8);
#pragma unroll
                for (int nt = 0; nt < 4; ++nt) { const bf16x8 bb = *(const bf16x8*)(KI + (16 * nt + lr) * 72 + ks * 32 + lq * 8); at[nt] = __builtin_amdgcn_mfma_f32_16x16x32_bf16(a, bb, at[nt], 0, 0, 0); } }
#pragma unroll
            for (int nt = 0; nt < 4; ++nt)
#pragma unroll
                for (int e = 0; e < 4; ++e) { const int t = 16 * w + 4 * lq + e, s = 16 * nt + lr; const bool keep = d == 0 ? (s <= t) : (s >= t); ATT[t * 72 + s] = (bf16_t)f2bf(keep ? at[nt][e] : 0.f); }
            __syncthreads();
#pragma unroll
            for (int ks = 0; ks < 2; ++ks) { const bf16x8 a1 = *(const bf16x8*)(ATT + (16 * w + lr) * 72 + ks * 32 + lq * 8); const bf16x8 a2 = *(const bf16x8*)(QI + (16 * w + lr) * 72 + ks * 32 + lq * 8);
#pragma unroll
                for (int nt = 0; nt < 8; ++nt) { const bf16x8 b1 = *(const bf16x8*)(VTs + (16 * nt + lr) * 72 + ks * 32 + lq * 8); const bf16x8 b2 = *(const bf16x8*)(SPT + (16 * nt + lr) * 72 + ks * 32 + lq * 8);
                    acc[nt] = __builtin_amdgcn_mfma_f32_16x16x32_bf16(a1, b1, acc[nt], 0, 0, 0); acc[nt] = __builtin_amdgcn_mfma_f32_16x16x32_bf16(a2, b2, acc[nt], 0, 0, 0); } }
        }
#pragma unroll
        for (int e = 0; e < 4; ++e) { float ss = 0.f;
#pragma unroll
            for (int nt = 0; nt < 8; ++nt) ss += acc[nt][e] * acc[nt][e];
            ss += __shfl_xor(ss, 1); ss += __shfl_xor(ss, 2); ss += __shfl_xor(ss, 4); ss += __shfl_xor(ss, 8);
            const float rstd = rsqrtf(ss * (1.f / 128.f) + EPS); const size_t R = R0 + 16 * w + 4 * lq + e;
#pragma unroll
            for (int nt = 0; nt < 8; ++nt) { const int v = 16 * nt + lr; const float y = acc[nt][e] * rstd * p.gla_norm_w[v] * bf2f(Gg[R * 512 + h * 128 + v]); MO[R * 1024 + h * 128 + v] = (bf16_t)f2bf(y); } }
    }
}
__device__ __forceinline__ void phase_gqa(const Params& p, char* smem) {
    unsigned char* ws = p.ws;
    const bf16_t* Qg = (const bf16_t*)(ws + R1_QG); const bf16_t* Kg = (const bf16_t*)(ws + R1_KG); const bf16_t* VTg = (const bf16_t*)(ws + R1_VTG); bf16_t* MO = (bf16_t*)(ws + WS_U);
    for (int u = VB; u < 1024; u += NVB) { const int b = u >> 9, hq = (u >> 6) & 7, qb = u & 63, kvh = hq >> 2;
        const size_t Rq = (size_t)b * PP + 256 + qb * 128;
        attn_unit(smem, Qg + Rq * 512 + hq * 64, 512, Kg + (size_t)b * PP * 128 + kvh * 64, 128, VTg + (size_t)((b * 2 + kvh) * 64) * PP, MO + Rq * 1024 + 512 + hq * 64, 1024, 132, 0, 0, 0, nullptr); }
}


#define XB_TMO      128
#define XB_XCNT(j)  (256  + 64 * (j))
#define XB_XSUB(j)  (1280 + 64 * (j))
#define XB_XGEN(j)  (2304 + 64 * (j))
#define XB_TOP      3328
#define XB_TOPGEN   3392
#define XCD_BAR_WORDS 3456
#define XB_SPIN_CAP (1u << 20)
#define LAS __attribute__((address_space(3)))
__device__ __forceinline__ unsigned xb_ld(unsigned* p)              { return __hip_atomic_load(p, __ATOMIC_RELAXED, __HIP_MEMORY_SCOPE_AGENT); }
__device__ __forceinline__ unsigned xb_add(unsigned* p, unsigned v) { return __hip_atomic_fetch_add(p, v, __ATOMIC_RELAXED, __HIP_MEMORY_SCOPE_AGENT); }
__device__ __forceinline__ unsigned xb_xcc_id() { return (unsigned)__builtin_amdgcn_s_getreg((3 << 11) | 20) & 0xFu; }
#define XB_SPIN(cond, bar) do { unsigned _sp = 0; while (cond) { __builtin_amdgcn_s_sleep(1); \
    if ((++_sp & 255u) == 0u) { if (xb_ld(&(bar)[XB_TMO])) break; if (_sp > XB_SPIN_CAP) { atomicAdd(&(bar)[XB_TMO], 1u); break; } } } } while (0)
struct XcdBarrier { unsigned* bar; unsigned x; volatile LAS unsigned* st; };
__device__ __forceinline__ XcdBarrier xcd_barrier_post(unsigned* bar, volatile LAS unsigned* st) {
    XcdBarrier b; b.bar = bar; b.x = xb_xcc_id(); b.st = st;
    if (threadIdx.x == 0) (void)xb_add(&bar[XB_XCNT(b.x)], 1u);
    return b;
}
__device__ __forceinline__ void xcd_barrier_complete(unsigned* bar, unsigned x, unsigned& nloc, unsigned& nx) {
    const unsigned G = gridDim.x * gridDim.y * gridDim.z;
    unsigned sum, cnt, mine, sp = 0u;
    for (;;) {
        sum = 0u; cnt = 0u; mine = 0u;
#pragma unroll
        for (unsigned j = 0; j < 16; ++j) { const unsigned c = xb_ld(&bar[XB_XCNT(j)]); sum += c; cnt += (c > 0u) ? 1u : 0u; mine = (j == x) ? c : mine; }
        if (sum == G) break;
        __builtin_amdgcn_s_sleep(1);
        if ((++sp & 255u) == 0u) { if (xb_ld(&bar[XB_TMO])) break; if (sp > XB_SPIN_CAP) { atomicAdd(&bar[XB_TMO], 1u); break; } }
    }
    nloc = mine > 0u ? mine : 1u; nx = cnt > 0u ? cnt : 1u;
}
__device__ __forceinline__ void xcd_barrier(const XcdBarrier& b) {
    asm volatile("s_waitcnt vmcnt(0)" ::: "memory");
    __syncthreads();
    if (threadIdx.x == 0) {
        unsigned* bar = b.bar;
        __builtin_amdgcn_s_waitcnt(0);
        unsigned nloc = b.st[0], nx = b.st[1];
        if (nloc == 0u) { xcd_barrier_complete(bar, b.x, nloc, nx); b.st[0] = nloc; b.st[1] = nx; }
        const unsigned old = xb_add(&bar[XB_XSUB(b.x)], 1u);
        const unsigned gen = old / nloc;
        if (old + 1u == (gen + 1u) * nloc) {
            __builtin_amdgcn_fence(__ATOMIC_RELEASE, "agent");
            asm volatile("s_waitcnt vmcnt(0)" ::: "memory");
            const unsigned og = xb_add(&bar[XB_TOP], 1u);
            const unsigned tg = og / nx;
            if (og + 1u == (tg + 1u) * nx) xb_add(&bar[XB_TOPGEN], 1u);
            else XB_SPIN(xb_ld(&bar[XB_TOPGEN]) == tg, bar);
            __builtin_amdgcn_fence(__ATOMIC_ACQUIRE, "agent");
            xb_add(&bar[XB_XGEN(b.x)], 1u);
            asm volatile("s_waitcnt vmcnt(0)" ::: "memory");
        } else {
            XB_SPIN(xb_ld(&bar[XB_XGEN(b.x)]) == gen, bar);
            __builtin_amdgcn_fence(__ATOMIC_ACQUIRE, "agent");
            asm volatile("s_waitcnt vmcnt(0)" ::: "memory");
        }
    }
    __syncthreads();
}


namespace pg8 {
#define PG8_LAS __attribute__((address_space(3)))
typedef unsigned short bf16_t;
typedef short bf16x8 __attribute__((ext_vector_type(8)));
typedef float f32x4 __attribute__((ext_vector_type(4)));
typedef unsigned u32x4 __attribute__((ext_vector_type(4)));
constexpr int BM = 256, BK = 64, HALF = 128, HTB = HALF * BK * 2  , STAGE_BYTES = 8 * HTB, NXCD = 8, WGM = 8;

__host__ __device__ __forceinline__ int lds_byte(int r, int c) { const int st = (r >> 4) * 2 + (c >> 5), rr = r & 15, cc = c & 31, ob = rr * 64 + cc * 2; return st * 1024 + (ob ^ (((ob >> 9) & 1) << 5)); }
__host__ __device__ __forceinline__ void stage_rc(int b, int& R, int& C) { const int st = b / 1024, sb = b % 1024, swz = sb ^ (((sb >> 9) & 1) << 5); R = (st >> 1) * 16 + swz / 64; C = (st & 1) * 32 + (swz % 64) / 2; }
__host__ __device__ __forceinline__ int perm32(int rho) { const int n = rho >> 4, i = rho & 15; return 8 * (i >> 2) + 4 * n + (i & 3); }

struct Unit { int pm, pn; };
struct Gemm { const bf16_t* A; const bf16_t* Bt; int M, N, K; };

struct StaticOrder {
    int nM, nN, nwg, G, c;
    __host__ __device__ void init(int M, int N, int G_, int c_) { nM = M / BM; nN = N / BM; nwg = nM * nN; G = G_; c = c_; }
    __host__ __device__ bool next(int i, Unit& u) const {
        const long L = (long)i * G + c; if (L >= nwg) return false;
        int wgid = (int)L; { const int q = nwg / NXCD, r = nwg % NXCD, xcd = wgid % NXCD, off = wgid / NXCD; wgid = (xcd < r ? xcd * (q + 1) : r * (q + 1) + (xcd - r) * q) + off; }
        const int nig = WGM * nN, gid = wgid / nig, fm = gid * WGM, gsz = (nM - fm) < WGM ? (nM - fm) : WGM;
        u.pm = fm + ((wgid % nig) % gsz); u.pn = (wgid % nig) / gsz; return true;
    }
    __device__ __forceinline__ void a_ready(const Unit&) const {}
    __device__ __forceinline__ void done(const Unit&) const {}
};
template <class Epi, class Sched, bool ALIGN_EPI = false, bool SP2 = false>
__device__ __forceinline__ void gemm_phase(PG8_LAS unsigned char* lds, const Gemm g, const Sched& S, const Epi& E) {
    const int tid = threadIdx.x, wid = __builtin_amdgcn_readfirstlane(tid >> 6), lane = tid & 63, wr = wid >> 2, wc = wid & 3, fr = lane & 15, fq = lane >> 4;
    const int K = g.K, nt = K / BK;
    unsigned voffA[2], voffB[2];
#pragma unroll
    for (int i = 0; i < 2; ++i) { int R, C; stage_rc(tid * 16 + i * 8192, R, C); const int Rb = Epi::PERM ? ((R & ~31) + perm32(R & 31)) : R;
        voffA[i] = (unsigned)(R * K + C) * 2u; voffB[i] = (unsigned)(Rb * K + C) * 2u; }
    const size_t kstep = (size_t)(BK * 2);
    const size_t hstep = (size_t)HALF * K * 2;
    const size_t tstep = 2 * hstep;
    const unsigned ldsw = (unsigned)wid * 1024u;
    const int aoff = lds_byte(wr * 64 + fr, fq * 8), boff = lds_byte(wc * 32 + fr, fq * 8);
#define PG8_SA(b, h) (((b) * 2 + (h)) * HTB)
#define PG8_SB(b, h) ((4 + (b) * 2 + (h)) * HTB)
#define PG8_STAGE(bufoff, gbase, voff) do { _Pragma("unroll") for (int _i = 0; _i < 2; ++_i) \
        __builtin_amdgcn_global_load_lds((const unsigned*)((const char*)(gbase) + (voff)[_i]), (PG8_LAS unsigned*)(lds + (bufoff) + ldsw + _i * 8192), 16, 0, 0); } while (0)
#define PG8_LDA(dst, b, h) do { _Pragma("unroll") for (int m = 0; m < 4; ++m) _Pragma("unroll") for (int k = 0; k < 2; ++k) dst[m][k] = *(const PG8_LAS bf16x8*)(lds + PG8_SA(b, h) + aoff + m * 2048 + k * 1024); } while (0)
#define PG8_LDB(dst, b, h) do { _Pragma("unroll") for (int n = 0; n < 2; ++n) _Pragma("unroll") for (int k = 0; k < 2; ++k) dst[n][k] = *(const PG8_LAS bf16x8*)(lds + PG8_SB(b, h) + boff + n * 2048 + k * 1024); } while (0)
#define PG8_MMA(ai, bj, At, Bt) do { __builtin_amdgcn_s_setprio(1); _Pragma("unroll") for (int m = 0; m < 4; ++m) _Pragma("unroll") for (int n = 0; n < 2; ++n) _Pragma("unroll") for (int k = 0; k < 2; ++k) \
        acc[ai][bj][m][n] = __builtin_amdgcn_mfma_f32_16x16x32_bf16(Bt[n][k], At[m][k], acc[ai][bj][m][n], 0, 0, 0); __builtin_amdgcn_s_setprio(0); } while (0)
#define PG8_WAIT_V(n) asm volatile("s_waitcnt vmcnt(" #n ")" ::: "memory")
#define PG8_WAIT_L(n) asm volatile("s_waitcnt lgkmcnt(" #n ")" ::: "memory")
#define PG8_BAR __builtin_amdgcn_s_barrier()
#define PG8_SCHED __builtin_amdgcn_sched_barrier(0)
    Unit cur, nxt; int ui = 0;
    if (!S.next(0, cur)) return;
    f32x4 acc[2][2][4][2];
#pragma unroll
    for (int a = 0; a < 2; ++a)
#pragma unroll
        for (int b = 0; b < 2; ++b)
#pragma unroll
            for (int m = 0; m < 4; ++m)
#pragma unroll
                for (int n = 0; n < 2; ++n) acc[a][b][m][n] = (f32x4){0.f, 0.f, 0.f, 0.f};
    bf16x8 At[4][2], B0[2][2], B1[2][2];
    const char* cA = (const char*)g.A + (size_t)cur.pm * tstep; const char* cB = (const char*)g.Bt + (size_t)cur.pn * tstep;
    S.a_ready(cur);
    if constexpr (SP2) {
        PG8_STAGE(PG8_SB(0, 0), cB, voffB); PG8_STAGE(PG8_SB(0, 1), cB + hstep, voffB); PG8_STAGE(PG8_SA(0, 0), cA, voffA); PG8_STAGE(PG8_SA(0, 1), cA + hstep, voffA);
        if (wr == 1) PG8_BAR;
        PG8_WAIT_V(2); PG8_BAR;
        PG8_STAGE(PG8_SB(1, 0), cB + kstep, voffB); PG8_STAGE(PG8_SA(1, 0), cA + kstep, voffA); PG8_STAGE(PG8_SB(1, 1), cB + hstep + kstep, voffB);
        PG8_WAIT_V(6); PG8_BAR;
    } else {
        PG8_STAGE(PG8_SB(0, 0), cB, voffB); PG8_STAGE(PG8_SA(0, 0), cA, voffA); PG8_STAGE(PG8_SB(0, 1), cB + hstep, voffB); PG8_STAGE(PG8_SA(0, 1), cA + hstep, voffA);
        if (wr == 1) PG8_BAR;
        PG8_WAIT_V(4); PG8_BAR;
        PG8_STAGE(PG8_SB(1, 0), cB + kstep, voffB); PG8_STAGE(PG8_SA(1, 0), cA + kstep, voffA); PG8_STAGE(PG8_SB(1, 1), cB + hstep + kstep, voffB);
        PG8_WAIT_V(6); PG8_BAR;
    }
    for (;;) {
        const bool has_next = S.next(ui + 1, nxt);
        const char* nA = has_next ? (const char*)g.A + (size_t)nxt.pm * tstep : cA; const char* nB = has_next ? (const char*)g.Bt + (size_t)nxt.pn * tstep : cB;
        for (int t = 0; t < nt; t += 2) {
            const bool last = (t == nt - 2);
            const char* a1 = cA + (size_t)(t + 1) * kstep;
            const char* a2 = last ? nA : cA + (size_t)(t + 2) * kstep; const char* b2 = last ? nB : cB + (size_t)(t + 2) * kstep;
            const char* a3 = a2 + kstep; const char* b3 = b2 + kstep;
            if (last && has_next) S.a_ready(nxt);
            if constexpr (SP2) {
            PG8_LDB(B0, 0, 0); PG8_LDB(B1, 0, 1); PG8_SCHED; PG8_LDA(At, 0, 0); PG8_STAGE(PG8_SA(1, 1), a1 + hstep, voffA);
            PG8_WAIT_V(8); PG8_WAIT_L(0); PG8_BAR; PG8_MMA(0, 0, At, B0); PG8_MMA(0, 1, At, B1); PG8_BAR; PG8_SCHED;
            PG8_LDA(At, 0, 1); PG8_STAGE(PG8_SB(0, 0), b2, voffB); PG8_STAGE(PG8_SB(0, 1), b2 + hstep, voffB); PG8_STAGE(PG8_SA(0, 0), a2, voffA);
            PG8_WAIT_V(8); PG8_WAIT_L(0); PG8_BAR; PG8_MMA(1, 0, At, B0); PG8_MMA(1, 1, At, B1); PG8_BAR; PG8_SCHED;
            PG8_LDB(B0, 1, 0); PG8_LDB(B1, 1, 1); PG8_SCHED; PG8_LDA(At, 1, 0); PG8_STAGE(PG8_SA(0, 1), a2 + hstep, voffA);
            PG8_WAIT_V(8); PG8_WAIT_L(0); PG8_BAR; PG8_MMA(0, 0, At, B0); PG8_MMA(0, 1, At, B1); PG8_BAR; PG8_SCHED;
            PG8_LDA(At, 1, 1); PG8_STAGE(PG8_SB(1, 0), b3, voffB); PG8_STAGE(PG8_SB(1, 1), b3 + hstep, voffB); PG8_STAGE(PG8_SA(1, 0), a3, voffA);
            PG8_WAIT_V(8); PG8_WAIT_L(0); PG8_BAR; PG8_MMA(1, 0, At, B0); PG8_MMA(1, 1, At, B1); PG8_BAR; PG8_SCHED;
            } else {
            PG8_LDB(B0, 0, 0); PG8_SCHED; PG8_LDA(At, 0, 0); PG8_STAGE(PG8_SA(1, 1), a1 + hstep, voffA);
            PG8_WAIT_L(8); PG8_BAR; PG8_WAIT_L(0); PG8_MMA(0, 0, At, B0); PG8_BAR; PG8_SCHED;
            PG8_LDB(B1, 0, 1); PG8_STAGE(PG8_SB(0, 0), b2, voffB);
            PG8_BAR; PG8_WAIT_L(0); PG8_MMA(0, 1, At, B1); PG8_BAR;
            PG8_LDA(At, 0, 1); PG8_STAGE(PG8_SA(0, 0), a2, voffA);
            PG8_BAR; PG8_WAIT_L(0); PG8_MMA(1, 0, At, B0); PG8_BAR; PG8_SCHED;
            PG8_STAGE(PG8_SB(0, 1), b2 + hstep, voffB);
            PG8_WAIT_V(6); PG8_BAR; PG8_MMA(1, 1, At, B1); PG8_BAR;
            PG8_LDB(B0, 1, 0); PG8_SCHED; PG8_LDA(At, 1, 0); PG8_STAGE(PG8_SA(0, 1), a2 + hstep, voffA);
            PG8_WAIT_L(8); PG8_BAR; PG8_WAIT_L(0); PG8_MMA(0, 0, At, B0); PG8_BAR; PG8_SCHED;
            PG8_LDB(B1, 1, 1); PG8_STAGE(PG8_SB(1, 0), b3, voffB);
            PG8_BAR; PG8_WAIT_L(0); PG8_MMA(0, 1, At, B1); PG8_BAR;
            PG8_LDA(At, 1, 1); PG8_STAGE(PG8_SA(1, 0), a3, voffA);
            PG8_BAR; PG8_WAIT_L(0); PG8_MMA(1, 0, At, B0); PG8_BAR; PG8_SCHED;
            PG8_STAGE(PG8_SB(1, 1), b3 + hstep, voffB);
            PG8_WAIT_V(6); PG8_BAR; PG8_MMA(1, 1, At, B1); PG8_BAR;
            }
        }
        if constexpr (ALIGN_EPI) { if (wr == 0) PG8_BAR; }
        if constexpr (!Epi::AFTER_DRAIN) { E(acc, cur, wr, wc, fr, fq); S.done(cur); }
        if (!has_next) break;
#pragma unroll
        for (int a = 0; a < 2; ++a)
#pragma unroll
            for (int b = 0; b < 2; ++b)
#pragma unroll
                for (int m = 0; m < 4; ++m)
#pragma unroll
                    for (int n = 0; n < 2; ++n) acc[a][b][m][n] = (f32x4){0.f, 0.f, 0.f, 0.f};
        cur = nxt; cA = nA; cB = nB; ++ui;
        if constexpr (ALIGN_EPI) { if (wr == 1) PG8_BAR; }
    }
    PG8_WAIT_V(0);
    if constexpr (!ALIGN_EPI) { if (wr == 0) PG8_BAR; }
    PG8_BAR;
    if constexpr (Epi::AFTER_DRAIN) { E.fused(acc, cur, wr, wc, fr, fq, lds, wid, lane); S.done(cur); }
#undef PG8_SA
#undef PG8_SB
#undef PG8_STAGE
#undef PG8_LDA
#undef PG8_LDB
#undef PG8_MMA
#undef PG8_WAIT_V
#undef PG8_WAIT_L
#undef PG8_BAR
#undef PG8_SCHED
}
}

template <class E> struct EpiAdapt {
    static constexpr bool PERM = false, AFTER_DRAIN = false;
    E e;
    __device__ __forceinline__ void operator()(const f32x4 (&acc)[2][2][4][2], const pg8::Unit& u, int wr, int wc, int fr, int fq) const {
        const int lane = fq * 16 + fr;
#pragma unroll
        for (int ai = 0; ai < 2; ++ai) {
            f32x4 a2[4][4];
#pragma unroll
            for (int m = 0; m < 4; ++m)
#pragma unroll
                for (int bj = 0; bj < 2; ++bj)
#pragma unroll
                    for (int n = 0; n < 2; ++n) a2[m][bj * 2 + n] = acc[ai][bj][m][n];
            e(a2, u.pm * 256 + ai * 128 + wr * 64, u.pn * 256 + wc * 64, lane);
        }
    }
};
struct LatentOrder {
    pg8::StaticOrder S;
    __device__ void init(int N, int G, int c) { S.init(64 * 256, N, G, c); }
    __device__ bool next(int i, pg8::Unit& u) const { if (!S.next(i, u)) return false; u.pm = u.pm + 1 + (u.pm >= 32 ? 1 : 0); return true; }
    __device__ __forceinline__ void a_ready(const pg8::Unit&) const {}
    __device__ __forceinline__ void done(const pg8::Unit&) const {}
};
template <class E> __device__ __forceinline__ void gemm256(char* smem_all, const bf16_t* A, const bf16_t* WT, int N, int K, bool latent_only, const E& e) {
    PG8_LAS unsigned char* lds = (PG8_LAS unsigned char*)smem_all;
    pg8::Gemm g{A, WT, NR, N, K};
    EpiAdapt<E> ea{e};
    if (latent_only) { LatentOrder S; S.init(N, (int)gridDim.x, (int)blockIdx.x); pg8::gemm_phase<EpiAdapt<E>, LatentOrder, true, true>(lds, g, S, ea); }
    else { pg8::StaticOrder S; S.init(NR, N, (int)gridDim.x, (int)blockIdx.x); pg8::gemm_phase<EpiAdapt<E>, pg8::StaticOrder, true, true>(lds, g, S, ea); }
}

template <int ph> __device__ __forceinline__ void run_phase(const Params& p, char* smem_all) {
    char* smem = smem_all + (threadIdx.x >> 8) * HALF_LDS;
    unsigned char* ws = p.ws;
    float* MOD = (float*)(ws + WS_MOD); float* Hc = (float*)(ws + WS_HC); float* Hl = p.out; bf16_t* U = (bf16_t*)(ws + WS_U);
    if constexpr (ph == 0) { phase_prologue(p, smem); }
    if constexpr (ph == 1) { phase_ln(p.x, p.ctx, p.norm1_w, MOD, 0, 1, false, U); }
    if constexpr (ph == 2) { { EpiInEven e{(bf16_t*)(ws + R0_Q), (bf16_t*)(ws + R0_K), (bf16_t*)(ws + R0_VT), (bf16_t*)(ws + R0_XL), (bf16_t*)(ws + R0_GG)};
        gemm256(smem_all, U, (const bf16_t*)(ws + WS_WINE), 2560, 1024, false, e); } }
    if constexpr (ph == 3) { phase_na(p, smem); }
    if constexpr (ph == 4) { { EpiLru e{(const bf16_t*)(ws + R0_XC), (__half2*)(ws + R0_AB), p.lru_ba, p.lru_bx, p.lru_lambda};
        gemm128_phase(smem, (const bf16_t*)(ws + R0_XC), 512, (const bf16_t*)(ws + WS_WLRU), 64, 132, 16, 0, 1, e); } }
    if constexpr (ph == 5) { phase_scan1(p); }
    if constexpr (ph == 6) { phase_scan2(p); }
    if constexpr (ph == 7) { { EpiResid e{p.x, p.ctx, Hl, Hc, MOD, 2}; gemm256(smem_all, U, (const bf16_t*)(ws + WS_WOUTE), 1024, 1024, false, e); } }
    if constexpr (ph == 8) { phase_ln(Hl, Hc, p.norm2_w, MOD, 3, 4, false, U); }
    if constexpr (ph == 9) { { EpiFF1 e{(bf16_t*)(ws + R_FF)}; gemm256(smem_all, U, (const bf16_t*)(ws + WS_WFF1), 4096, 1024, false, e); } }
    if constexpr (ph == 10) { { EpiResid e{Hl, Hc, Hl, Hc, MOD, 5}; gemm256(smem_all, (const bf16_t*)(ws + R_FF), (const bf16_t*)(ws + WS_WFF2), 1024, 4096, false, e); } }
    if constexpr (ph == 11) { phase_ln(Hl, Hc, p.norm1_w + 1024, MOD + 3 * 6144, 0, 1, false, U); }
    if constexpr (ph == 12) { { EpiInOdd e{(bf16_t*)(ws + R1_GQ), (bf16_t*)(ws + R1_GK), (bf16_t*)(ws + R1_GV), (bf16_t*)(ws + R1_GG), (bf16_t*)(ws + R1_QG), (bf16_t*)(ws + R1_KG), (bf16_t*)(ws + R1_VTG),
                          (float*)(ws + R1_LR), p.gqa_q_norm_w, p.gqa_k_norm_w, (const float2*)(ws + WS_ROPE)};
        gemm256(smem_all, U, (const bf16_t*)(ws + WS_WINO), 2560, 1024, false, e); } }
    if constexpr (ph == 13) { phase_gla1(p, smem); }
    if constexpr (ph == 14) { phase_gla2(p); phase_gqa(p, smem); }
    if constexpr (ph == 15) { phase_gla3(p, smem); }
    if constexpr (ph == 16) { { EpiResid e{Hl, Hc, Hl, Hc, MOD + 3 * 6144, 2}; gemm256(smem_all, U, (const bf16_t*)(ws + WS_WOUTO), 1024, 1024, true, e); } }
    if constexpr (ph == 17) { phase_ln(Hl, Hc, p.norm2_w + 1024, MOD + 3 * 6144, 3, 4, true, U); }
    if constexpr (ph == 18) { { EpiFF1 e{(bf16_t*)(ws + R_FF)}; gemm256(smem_all, U, (const bf16_t*)(ws + WS_WFF1) + (size_t)4096 * 1024, 4096, 1024, true, e); } }
    if constexpr (ph == 19) { { EpiResid e{Hl, Hc, Hl, Hc, MOD + 3 * 6144, 5}; gemm256(smem_all, (const bf16_t*)(ws + R_FF), (const bf16_t*)(ws + WS_WFF2) + (size_t)4096 * 1024, 1024, 4096, true, e); } }
    if constexpr (ph == 20) { phase_final(p.final_norm_w, Hl); }
}

#if MEGA
template <int PH> __device__ __forceinline__ void run_all(const Params& p, char* smem, cg::grid_group& grid, const XcdBarrier& xb) {
    if constexpr (PH < NPHASE) {
        run_phase<PH>(p, smem);
        if constexpr (PH + 1 < NPHASE) { if constexpr (PH == 0) grid.sync(); else xcd_barrier(xb); }
        run_all<PH + 1>(p, smem, grid, xb);
    }
}
__global__ void __launch_bounds__(512, 2) hybrid_fwd(Params p) {
    extern __shared__ __attribute__((aligned(16))) char smem[];
    __shared__ uint4 xb_words;
    cg::grid_group grid = cg::this_grid();
    if (threadIdx.x == 0) xb_words = make_uint4(0u, 0u, 0u, 0u);
    __syncthreads();
    const XcdBarrier xb = xcd_barrier_post((unsigned*)(p.ws + WS_BAR), (volatile LAS unsigned*)&xb_words);
    run_all<0>(p, smem, grid, xb);
}
#else
template <int PH> __global__ void __launch_bounds__(512, 2) phase_k(Params p) {
    extern __shared__ __attribute__((aligned(16))) char smem[];
    run_phase<PH>(p, smem);
}
template <int PH> static bool setup_all() {
    if constexpr (PH < NPHASE) { if (hipFuncSetAttribute((const void*)phase_k<PH>, hipFuncAttributeMaxDynamicSharedMemorySize, LDS_BYTES) != hipSuccess) return false; return setup_all<PH + 1>(); }
    else return true;
}
template <int PH> static void launch_all(const Params& p, int grid, hipStream_t stream) {
    if constexpr (PH < NPHASE) { hipLaunchKernelGGL(phase_k<PH>, dim3(grid), dim3(512), LDS_BYTES, stream, p); launch_all<PH + 1>(p, grid, stream); }
}
#endif

extern "C" void kernel_launch(void* const* d_in, const int* in_sizes, int n_in, void* d_out, int out_size, void* d_ws, size_t ws_size, hipStream_t stream) {
    static int grid_blocks = 0;
    if (grid_blocks == 0) {
        if (n_in != 28 || out_size != NB * SEQ * DM || ws_size < WS_NEED) { fprintf(stderr, "kernel_launch: unexpected shapes (n_in %d out %d ws %zu need %zu)\n", n_in, out_size, ws_size, (size_t)WS_NEED); grid_blocks = -1; return; }
        int dev = 0, cus = 0, per_cu = 0;
        if (hipGetDevice(&dev) != hipSuccess || hipDeviceGetAttribute(&cus, hipDeviceAttributeMultiprocessorCount, dev) != hipSuccess) { grid_blocks = -1; return; }
#if MEGA
        if (hipFuncSetAttribute((const void*)hybrid_fwd, hipFuncAttributeMaxDynamicSharedMemorySize, LDS_BYTES) != hipSuccess) { fprintf(stderr, "kernel_launch: hipFuncSetAttribute failed\n"); grid_blocks = -1; return; }
        if (hipOccupancyMaxActiveBlocksPerMultiprocessor(&per_cu, (const void*)hybrid_fwd, 512, LDS_BYTES) != hipSuccess || per_cu < 1) { fprintf(stderr, "kernel_launch: occupancy query failed (%d)\n", per_cu); grid_blocks = -1; return; }
        if (per_cu > 1) per_cu = 1;
#else
        if (!setup_all<0>()) { fprintf(stderr, "kernel_launch: hipFuncSetAttribute failed\n"); grid_blocks = -1; return; }
        per_cu = 1;
#endif
        grid_blocks = cus * per_cu;
    }
    if (grid_blocks < 0) return;
    Params p{};
    const float** pp = (const float**)&p;
    for (int i = 0; i < 28; ++i) pp[i] = (const float*)d_in[i];
    p.out = (float*)d_out; p.ws = (unsigned char*)d_ws;
    p.ph_lo = 0; p.ph_hi = NPHASE;
#if MEGA
    if (hipMemsetAsync((char*)d_ws + WS_BAR, 0, 16384, stream) != hipSuccess) { fprintf(stderr, "kernel_launch: memset failed\n"); return; }
    void* args[] = {&p};
    hipError_t e = hipLaunchCooperativeKernel((const void*)hybrid_fwd, dim3(grid_blocks), dim3(512), args, LDS_BYTES, stream);
    if (e != hipSuccess) fprintf(stderr, "cooperative launch failed: %s (grid %d)\n", hipGetErrorString(e), grid_blocks);
#else
    launch_all<0>(p, grid_blocks, stream);
#endif
}
```

```cpp
#include <hip/hip_runtime.h>
#include <hip/hip_cooperative_groups.h>
#include <hip/hip_fp16.h>
#include <cstdio>
#include <cstdint>
namespace cg = cooperative_groups;

#ifndef MEGA
#define MEGA 1
#endif
#ifndef REPMASK
#define REPMASK 0
#endif

typedef unsigned short bf16_t;
typedef short bf16x8 __attribute__((ext_vector_type(8)));
typedef short s16x4 __attribute__((ext_vector_type(4)));
typedef float f32x4 __attribute__((ext_vector_type(4)));
typedef float f32x16 __attribute__((ext_vector_type(16)));
typedef unsigned u32x4 __attribute__((ext_vector_type(4)));
typedef unsigned u32x2 __attribute__((ext_vector_type(2)));

constexpr int DM = 1024, NB = 2, SEQ = 8192, CTX = 256, PP = SEQ + CTX, NR = NB * PP;
constexpr float EPS = 1e-6f;
constexpr float LOG2E = 1.4426950408889634f;
constexpr int HALF_LDS = 71680;
constexpr int LDS_BYTES = 2 * HALF_LDS;
#define VT ((int)(threadIdx.x & 255))
#define VB ((int)(blockIdx.x * 2 + (threadIdx.x >> 8)))
#define NVB ((int)(gridDim.x * 2))
constexpr int NPHASE = 21;

constexpr size_t WS_WFF1 = 0;
constexpr size_t WS_WFF2 = WS_WFF1 + 2ull * 4096 * 1024 * 2;
constexpr size_t WS_WINE = WS_WFF2 + 2ull * 4096 * 1024 * 2;
constexpr size_t WS_WOUTE = WS_WINE + 2560ull * 1024 * 2;
constexpr size_t WS_WINO = WS_WOUTE + 1024ull * 1024 * 2;
constexpr size_t WS_WOUTO = WS_WINO + 2560ull * 1024 * 2;
constexpr size_t WS_WLRU = WS_WOUTO + 1024ull * 1024 * 2;
constexpr size_t WS_MOD = WS_WLRU + 2048ull * 64 * 2;
constexpr size_t WS_ROPE = WS_MOD + 2ull * 3 * 6144 * 4;
constexpr size_t WS_HC = WS_ROPE + 128ull * 16 * 8;
constexpr size_t WS_U = WS_HC + 512ull * 1024 * 4;
constexpr size_t WS_REG = WS_U + (size_t)NR * 1024 * 2;
constexpr size_t R0_Q = WS_REG;
constexpr size_t R0_K = R0_Q + (size_t)NR * 512 * 2;
constexpr size_t R0_VT = R0_K + (size_t)NR * 512 * 2;
constexpr size_t R0_XL = R0_VT + (size_t)NR * 512 * 2;
constexpr size_t R0_GG = R0_XL + (size_t)NR * 512 * 2;
constexpr size_t R0_XC = R0_GG + (size_t)NR * 512 * 2;
constexpr size_t R0_AB = R0_XC + (size_t)NR * 512 * 2;
constexpr size_t R0_SUM = R0_AB + 2ull * NR * 512 * 4;
constexpr size_t R0_END = R0_SUM + 2ull * 2 * 132 * 512 * 8;
constexpr size_t R_FF = WS_REG;
constexpr size_t RFF_END = R_FF + (size_t)NR * 4096 * 2;
constexpr size_t R1_GQ = WS_REG;
constexpr size_t R1_GK = R1_GQ + (size_t)NR * 256 * 2;
constexpr size_t R1_GV = R1_GK + (size_t)NR * 256 * 2;
constexpr size_t R1_GG = R1_GV + (size_t)NR * 512 * 2;
constexpr size_t R1_LR = R1_GG + (size_t)NR * 512 * 2;
constexpr size_t R1_QG = R1_LR + (size_t)NR * 32 * 4;
constexpr size_t R1_KG = R1_QG + (size_t)NR * 512 * 2;
constexpr size_t R1_VTG = R1_KG + (size_t)NR * 128 * 2;
constexpr size_t R1_UC = R1_VTG + (size_t)NR * 128 * 2;
constexpr size_t R1_DEC = R1_UC + 16ull * 132 * 8192 * 4;
constexpr size_t R1_END = R1_DEC + 16ull * 132 * 64 * 4;
constexpr size_t WS_BAR = 268435456ull - 16384ull;
constexpr size_t WS_NEED0 = (R0_END > RFF_END ? (R0_END > R1_END ? R0_END : R1_END) : (RFF_END > R1_END ? RFF_END : R1_END));
static_assert(WS_NEED0 <= WS_BAR, "workspace overlay runs into the barrier words");
constexpr size_t WS_NEED = 268435456ull;

struct Params {
    const float *x, *c, *ctx, *c_ctx, *norm1_w, *norm2_w, *w_mod, *b_mod, *w_ff1, *w_ff2;
    const float *w_in_even, *na_rpb, *lru_conv_w, *lru_conv_b, *lru_wa, *lru_ba, *lru_wx, *lru_bx, *lru_lambda, *w_out_even;
    const float *w_in_odd, *gla_wa2, *gla_ba, *gla_norm_w, *gqa_q_norm_w, *gqa_k_norm_w, *w_out_odd, *final_norm_w;
    float* out;
    unsigned char* ws;
    int ph_lo, ph_hi;
};

__device__ __forceinline__ unsigned f2bf(float f) { unsigned u = __float_as_uint(f); u += 0x7fffu + ((u >> 16) & 1u); return u >> 16; }
typedef float f32x2_t __attribute__((ext_vector_type(2)));
typedef __bf16 bf16x2_t __attribute__((ext_vector_type(2)));
__device__ __forceinline__ unsigned pack2(float a, float b) { const f32x2_t v = {a, b}; const bf16x2_t r = __builtin_convertvector(v, bf16x2_t); return __builtin_bit_cast(unsigned, r); }
__device__ __forceinline__ float bf2f(unsigned h) { return __uint_as_float(h << 16); }
__device__ __forceinline__ float bflo(unsigned w) { return __uint_as_float(w << 16); }
__device__ __forceinline__ float bfhi(unsigned w) { return __uint_as_float(w & 0xffff0000u); }
__device__ __forceinline__ float sigmoidf_(float z) { return 1.f / (1.f + __expf(-z)); }
__device__ __forceinline__ float wave_sum(float v) {
#pragma unroll
    for (int o = 32; o > 0; o >>= 1) v += __shfl_xor(v, o);
    return v;
}
__device__ __forceinline__ int clampi(int v, int lo, int hi) { return v < lo ? lo : (v > hi ? hi : v); }

__host__ __device__ __forceinline__ int phys2log(int P) { const int t = P >> 8, q = P & 255, bj = q >> 7, wc = (q >> 5) & 3, r = q & 31; return (t << 8) + 64 * wc + 32 * bj + r; }
__device__ __forceinline__ void tr_job(float* tile, const float* __restrict__ src, int Nsrc, bf16_t* __restrict__ dst, int K, int Ndst, int mode) {
    const int tid = VT;
    const int nkt = K >> 6, ntiles = (Ndst >> 6) * nkt;
    for (int t = VB; t < ntiles; t += NVB) {
        const int n0 = (t / nkt) << 6, k0 = (t % nkt) << 6;
        __syncthreads();
        {
            const int n = tid & 63; const int nn = phys2log(n0 + n); bool valid = true; int on = nn;
            if (mode == 1) { if (nn >= 2336) valid = false; else if (nn >= 2304) on = nn - 2304 + 1536; else if (nn >= 1536) on = nn + 32; }
#pragma unroll
            for (int i = 0; i < 16; ++i) { const int k = i * 4 + (tid >> 6); tile[k * 65 + n] = valid ? src[(size_t)(k0 + k) * Nsrc + on] : 0.f; }
        }
        __syncthreads();
        {
            const int n = tid >> 2, kq = (tid & 3) * 16; unsigned w[8];
#pragma unroll
            for (int j = 0; j < 8; ++j) w[j] = pack2(tile[(kq + 2 * j) * 65 + n], tile[(kq + 2 * j + 1) * 65 + n]);
            u32x4* d = (u32x4*)(dst + (size_t)(n0 + n) * K + k0 + kq);
            d[0] = (u32x4){w[0], w[1], w[2], w[3]}; d[1] = (u32x4){w[4], w[5], w[6], w[7]};
        }
    }
}

__device__ __forceinline__ void phase_prologue(const Params& p, char* smem) {
    const int tid = VT, bid = VB, nblk = NVB;
    unsigned char* ws = p.ws;
    {
        float* sv = (float*)smem; float* red = sv + 3072; float* MOD = (float*)(ws + WS_MOD);
        for (int i = tid; i < 3072; i += 256) { const int j = i >> 10, k = i & 1023; const float v = j < 2 ? p.c[j * 1024 + k] : p.c_ctx[k]; sv[i] = v / (1.f + __expf(-v)); }
        __syncthreads();
        for (int it = bid; it < 192; it += nblk) {
            const int l = it / 96, n0 = (it % 96) * 64, col = tid & 63, kg = tid >> 6;
            const float* w = p.w_mod + (size_t)l * 1024 * 6144 + n0 + col;
            float a0 = 0.f, a1 = 0.f, a2 = 0.f;
#pragma unroll 8
            for (int k = kg * 256; k < kg * 256 + 256; ++k) { const float wv = w[(size_t)k * 6144]; a0 += sv[k] * wv; a1 += sv[1024 + k] * wv; a2 += sv[2048 + k] * wv; }
            red[(kg * 3 + 0) * 64 + col] = a0; red[(kg * 3 + 1) * 64 + col] = a1; red[(kg * 3 + 2) * 64 + col] = a2;
            __syncthreads();
            if (tid < 192) { const int j = tid >> 6, cc = tid & 63;
                const float s = red[(0 * 3 + j) * 64 + cc] + red[(1 * 3 + j) * 64 + cc] + red[(2 * 3 + j) * 64 + cc] + red[(3 * 3 + j) * 64 + cc];
                MOD[(l * 3 + j) * 6144 + n0 + cc] = s + p.b_mod[l * 6144 + n0 + cc]; }
            __syncthreads();
        }
    }
    {
        const int gt = bid * 256 + tid, gn = nblk * 256;
        float2* rope = (float2*)(ws + WS_ROPE);
        for (int i = gt; i < 2048; i += gn) { const int pos = i >> 4, f = i & 15; const float inv = powf(10000.f, -(float)f / 16.f); const float ang = (float)pos * inv; float s, c; sincosf(ang, &s, &c); rope[i] = make_float2(c, s); }
        bf16_t* wl = (bf16_t*)(ws + WS_WLRU);
        for (int i = gt; i < 2048 * 64; i += gn) { const int n = i >> 6, k = i & 63; const int h = n >> 8, d = (n >> 7) & 1, j = (n & 127) >> 1, g = n & 1;
            const float* W = g ? p.lru_wx : p.lru_wa; wl[i] = (bf16_t)f2bf(W[(((size_t)(d * 8 + h) * 64 + k) * 64) + j]); }
    }
    float* tile = (float*)smem;
    for (int l = 0; l < 2; ++l) {
        tr_job(tile, p.w_ff1 + (size_t)l * 1024 * 4096, 4096, (bf16_t*)(ws + WS_WFF1) + (size_t)l * 4096 * 1024, 1024, 4096, 0);
        tr_job(tile, p.w_ff2 + (size_t)l * 4096 * 1024, 1024, (bf16_t*)(ws + WS_WFF2) + (size_t)l * 4096 * 1024, 4096, 1024, 0);
    }
    tr_job(tile, p.w_in_even, 2560, (bf16_t*)(ws + WS_WINE), 1024, 2560, 0);
    tr_job(tile, p.w_out_even, 1024, (bf16_t*)(ws + WS_WOUTE), 1024, 1024, 0);
    tr_job(tile, p.w_in_odd, 2336, (bf16_t*)(ws + WS_WINO), 1024, 2560, 1);
    tr_job(tile, p.w_out_odd, 1024, (bf16_t*)(ws + WS_WOUTO), 1024, 1024, 0);
}

__device__ __forceinline__ void phase_ln(const float* __restrict__ srcL, const float* __restrict__ srcC, const float* __restrict__ nw, const float* __restrict__ mod, int sh_slot, int sc_slot, bool latent_only, bf16_t* __restrict__ U) {
    const int lane = VT & 63, gw = VB * 4 + (VT >> 6), nwt = NVB * 4;
    const int nrows = latent_only ? NB * SEQ : NR;
    for (int idx = gw; idx < nrows; idx += nwt) {
        int b, pi; if (latent_only) { b = idx >> 13; pi = 256 + (idx & 8191); } else { b = idx / PP; pi = idx - b * PP; }
        const int R = b * PP + pi; const bool isc = pi < 256; const int ms = isc ? 2 : b;
        const float* src = isc ? srcC + (size_t)(b * 256 + pi) * 1024 : srcL + (size_t)(b * 8192 + pi - 256) * 1024;
        f32x4 v[4]; float ss = 0.f;
#pragma unroll
        for (int i = 0; i < 4; ++i) { v[i] = *(const f32x4*)(src + i * 256 + lane * 4); ss += v[i][0] * v[i][0] + v[i][1] * v[i][1] + v[i][2] * v[i][2] + v[i][3] * v[i][3]; }
        ss = wave_sum(ss);
        const float rstd = rsqrtf(ss * (1.f / 1024.f) + EPS);
        const float* sh = mod + ms * 6144 + sh_slot * 1024; const float* sc = mod + ms * 6144 + sc_slot * 1024;
#pragma unroll
        for (int i = 0; i < 4; ++i) { const int n = i * 256 + lane * 4;
            const f32x4 w4 = *(const f32x4*)(nw + n), s4 = *(const f32x4*)(sc + n), h4 = *(const f32x4*)(sh + n);
            const f32x4 y = v[i] * rstd * w4 * (s4 + 1.f) + h4;
            *(u32x2*)(U + (size_t)R * 1024 + n) = (u32x2){pack2(y[0], y[1]), pack2(y[2], y[3])}; }
    }
}

__device__ __forceinline__ void phase_final(const float* __restrict__ fw, float* __restrict__ out) {
    const int lane = VT & 63, gw = VB * 4 + (VT >> 6), nwt = NVB * 4;
    for (int idx = gw; idx < NB * SEQ; idx += nwt) {
        float* row = out + (size_t)idx * 1024;
        f32x4 v[4]; float ss = 0.f;
#pragma unroll
        for (int i = 0; i < 4; ++i) { v[i] = *(const f32x4*)(row + i * 256 + lane * 4); ss += v[i][0] * v[i][0] + v[i][1] * v[i][1] + v[i][2] * v[i][2] + v[i][3] * v[i][3]; }
        ss = wave_sum(ss);
        const float rstd = rsqrtf(ss * (1.f / 1024.f) + EPS);
#pragma unroll
        for (int i = 0; i < 4; ++i) { const int n = i * 256 + lane * 4; const f32x4 w4 = *(const f32x4*)(fw + n); *(f32x4*)(row + n) = v[i] * rstd * w4; }
    }
}

template <class Epi>
__device__ __forceinline__ void gemm128_phase(char* smem, const bf16_t* __restrict__ A, int lda, const bf16_t* __restrict__ WT, int K, int nMt, int nNt, int rowmode, int lru, const Epi& epi) {
    bf16_t* As = (bf16_t*)smem; bf16_t* Bs = As + 128 * 72;
    const int tid = VT, lane = tid & 63, wid = tid >> 6, wm = wid >> 1, wn = wid & 1;
    const int lr = lane & 15, lq = lane >> 4;
    const int ntiles = nMt * nNt;
    for (int tile = VB; tile < ntiles; tile += NVB) {
        const int mt = tile / nNt, nt = tile - mt * nNt;
        const int row0 = rowmode ? ((mt >> 6) * PP + 256 + (mt & 63) * 128) : mt * 128;
        const bf16_t* Ag = A + (size_t)row0 * lda + (lru ? (nt >> 1) * 64 : 0);
        const bf16_t* Bg = WT + (size_t)nt * 128 * K;
        f32x4 acc[4][4];
#pragma unroll
        for (int i = 0; i < 4; ++i)
#pragma unroll
            for (int j = 0; j < 4; ++j) acc[i][j] = (f32x4){0.f, 0.f, 0.f, 0.f};
        u32x4 ra[4], rb[4];
#pragma unroll
        for (int i = 0; i < 4; ++i) { const int c = tid + 256 * i, r = c >> 3, kc = (c & 7) * 8; ra[i] = *(const u32x4*)(Ag + (size_t)r * lda + kc); rb[i] = *(const u32x4*)(Bg + (size_t)r * K + kc); }
        for (int k0 = 0; k0 < K; k0 += 64) {
            __syncthreads();
#pragma unroll
            for (int i = 0; i < 4; ++i) { const int c = tid + 256 * i, r = c >> 3, kc = (c & 7) * 8; *(u32x4*)(As + r * 72 + kc) = ra[i]; *(u32x4*)(Bs + r * 72 + kc) = rb[i]; }
            __syncthreads();
            if (k0 + 64 < K) {
#pragma unroll
                for (int i = 0; i < 4; ++i) { const int c = tid + 256 * i, r = c >> 3, kc = (c & 7) * 8 + k0 + 64; ra[i] = *(const u32x4*)(Ag + (size_t)r * lda + kc); rb[i] = *(const u32x4*)(Bg + (size_t)r * K + kc); }
            }
#pragma unroll
            for (int ks = 0; ks < 2; ++ks) {
                bf16x8 af[4], bfr[4];
#pragma unroll
                for (int i = 0; i < 4; ++i) { af[i] = *(const bf16x8*)(As + (wm * 64 + i * 16 + lr) * 72 + ks * 32 + lq * 8); bfr[i] = *(const bf16x8*)(Bs + (wn * 64 + i * 16 + lr) * 72 + ks * 32 + lq * 8); }
#pragma unroll
                for (int mi = 0; mi < 4; ++mi)
#pragma unroll
                    for (int ni = 0; ni < 4; ++ni) acc[mi][ni] = __builtin_amdgcn_mfma_f32_16x16x32_bf16(bfr[ni], af[mi], acc[mi][ni], 0, 0, 0);
            }
        }
        epi(acc, row0 + wm * 64, nt * 128 + wn * 64, lane);
    }
}

struct EpiResid {
    const float* srcL; const float* srcC; float* dstL; float* dstC; const float* mod; int slot;
    __device__ __forceinline__ void operator()(const f32x4 (&acc)[4][4], int Rb, int nb, int lane) const {
        const int lr = lane & 15, lq = lane >> 4;
#pragma unroll
        for (int mi = 0; mi < 4; ++mi) {
            const int R = Rb + mi * 16 + lr; const int b = R / PP, pi = R - b * PP; const bool isc = pi < 256; const int ms = isc ? 2 : b;
            const size_t ro = isc ? (size_t)(b * 256 + pi) * 1024 : (size_t)(b * 8192 + pi - 256) * 1024;
            const float* s = (isc ? srcC : srcL) + ro; float* d = (isc ? dstC : dstL) + ro; const float* g = mod + ms * 6144 + slot * 1024;
#pragma unroll
            for (int ni = 0; ni < 4; ++ni) { const int n = nb + ni * 16 + lq * 4; const f32x4 h = *(const f32x4*)(s + n), gg = *(const f32x4*)(g + n); *(f32x4*)(d + n) = h + gg * acc[mi][ni]; }
        }
    }
};
struct EpiFF1 {
    bf16_t* FF;
    __device__ __forceinline__ void operator()(const f32x4 (&acc)[4][4], int Rb, int nb, int lane) const {
        const int lr = lane & 15, lq = lane >> 4;
#pragma unroll
        for (int mi = 0; mi < 4; ++mi) { const int R = Rb + mi * 16 + lr;
#pragma unroll
            for (int ni = 0; ni < 4; ++ni) { const int n = nb + ni * 16 + lq * 4; f32x4 v = acc[mi][ni];
#pragma unroll
                for (int e = 0; e < 4; ++e) { const float r = fmaxf(v[e], 0.f); v[e] = r * r; }
                *(u32x2*)(FF + (size_t)R * 4096 + n) = (u32x2){pack2(v[0], v[1]), pack2(v[2], v[3])}; } }
    }
};
__device__ __forceinline__ float gelu_tanh(float x) { const float u = 0.7978845608028654f * (x + 0.044715f * x * x * x); const float t = 1.f - 2.f / (1.f + __expf(2.f * u)); return 0.5f * x * (1.f + t); }
struct EpiInEven {
    bf16_t *Qn, *Kn, *VTn, *XL, *GG;
    __device__ __forceinline__ void operator()(const f32x4 (&acc)[4][4], int Rb, int nb, int lane) const {
        const int lr = lane & 15, lq = lane >> 4;
#pragma unroll
        for (int mi = 0; mi < 4; ++mi) { const int R = Rb + mi * 16 + lr; const int b = R / PP, pi = R - b * PP;
#pragma unroll
            for (int ni = 0; ni < 4; ++ni) { const int n = nb + ni * 16 + lq * 4; const f32x4 a = acc[mi][ni];
                if (n < 512) *(u32x2*)(Qn + (size_t)R * 512 + n) = (u32x2){pack2(a[0] * (0.125f * LOG2E), a[1] * (0.125f * LOG2E)), pack2(a[2] * (0.125f * LOG2E), a[3] * (0.125f * LOG2E))};
                else if (n < 1024) *(u32x2*)(Kn + (size_t)R * 512 + (n - 512)) = (u32x2){pack2(a[0], a[1]), pack2(a[2], a[3])};
                else if (n < 1536) { const int hh = (n - 1024) >> 6, d0 = (n - 1024) & 63; bf16_t* vp = VTn + ((size_t)((b * 8 + hh) * 64 + d0)) * PP + pi;
#pragma unroll
                    for (int e = 0; e < 4; ++e) vp[(size_t)e * PP] = (bf16_t)f2bf(a[e]); }
                else if (n < 2048) *(u32x2*)(XL + (size_t)R * 512 + (n - 1536)) = (u32x2){pack2(a[0], a[1]), pack2(a[2], a[3])};
                else *(u32x2*)(GG + (size_t)R * 512 + (n - 2048)) = (u32x2){pack2(gelu_tanh(a[0]), gelu_tanh(a[1])), pack2(gelu_tanh(a[2]), gelu_tanh(a[3]))};
            } }
    }
};
struct EpiLru {
    const bf16_t* XC; __half2* AB; const float *ba, *bx, *lam;
    __device__ __forceinline__ void operator()(const f32x4 (&acc)[4][4], int Rb, int nb, int lane) const {
        const int lr = lane & 15, lq = lane >> 4;
        const int h = nb >> 8, d = (nb >> 7) & 1, colb = nb & 127;
#pragma unroll
        for (int mi = 0; mi < 4; ++mi) { const int R = Rb + mi * 16 + lr;
#pragma unroll
            for (int ni = 0; ni < 4; ++ni) { const int j0 = (colb + ni * 16 + lq * 4) >> 1; const int c = h * 64 + j0; __half2 o[2];
#pragma unroll
                for (int e2 = 0; e2 < 2; ++e2) { const int cc = c + e2;
                    const float za = acc[mi][ni][2 * e2] + ba[d * 512 + cc], zx = acc[mi][ni][2 * e2 + 1] + bx[d * 512 + cc];
                    const float r = sigmoidf_(za), ig = sigmoidf_(zx);
                    const float sp = log1pf(__expf(-lam[d * 512 + cc]));
                    const float la = -8.f * r * sp;
                    const float xv = bf2f(XC[(size_t)R * 512 + cc]);
                    const float bb = sqrtf(fmaxf(-expm1f(2.f * la), 0.f)) * ig * xv;
                    o[e2] = __floats2half2_rn(la, bb); }
                __half2* dst = AB + ((size_t)d * NR + R) * 512 + c; dst[0] = o[0]; dst[1] = o[1]; } }
    }
};
struct EpiInOdd {
    bf16_t *Gq, *Gk, *Gv, *Gg, *Qg, *Kg, *VTg; float* LR; const float *qnw, *knw; const float2* rope;
    __device__ __forceinline__ void operator()(const f32x4 (&acc)[4][4], int Rb, int nb, int lane) const {
        const int lr = lane & 15, lq = lane >> 4;
        if (nb < 1536) {
#pragma unroll
            for (int mi = 0; mi < 4; ++mi) { const int R = Rb + mi * 16 + lr;
#pragma unroll
                for (int ni = 0; ni < 4; ++ni) { const int n = nb + ni * 16 + lq * 4; const f32x4 a = acc[mi][ni];
                    if (n < 256) *(u32x2*)(Gq + (size_t)R * 256 + n) = (u32x2){pack2(a[0], a[1]), pack2(a[2], a[3])};
                    else if (n < 512) *(u32x2*)(Gk + (size_t)R * 256 + (n - 256)) = (u32x2){pack2(a[0], a[1]), pack2(a[2], a[3])};
                    else if (n < 1024) *(u32x2*)(Gv + (size_t)R * 512 + (n - 512)) = (u32x2){pack2(a[0], a[1]), pack2(a[2], a[3])};
                    else { f32x4 s;
#pragma unroll
                        for (int e = 0; e < 4; ++e) s[e] = a[e] * sigmoidf_(a[e]);
                        *(u32x2*)(Gg + (size_t)R * 512 + (n - 1024)) = (u32x2){pack2(s[0], s[1]), pack2(s[2], s[3])}; } } }
        } else if (nb < 2176) {
            const bool isq = nb < 2048; const float* nwp = isq ? qnw : knw;
#pragma unroll
            for (int mi = 0; mi < 4; ++mi) { const int R = Rb + mi * 16 + lr; const int b = R / PP, pi = R - b * PP;
                float ss = 0.f;
#pragma unroll
                for (int ni = 0; ni < 4; ++ni)
#pragma unroll
                    for (int e = 0; e < 4; ++e) ss += acc[mi][ni][e] * acc[mi][ni][e];
                ss += __shfl_xor(ss, 16); ss += __shfl_xor(ss, 32);
                const float rstd = rsqrtf(ss * (1.f / 64.f) + EPS);
                f32x4 y[4];
#pragma unroll
                for (int ni = 0; ni < 4; ++ni) { const f32x4 w4 = *(const f32x4*)(nwp + ni * 16 + lq * 4); y[ni] = acc[mi][ni] * rstd * w4; }
                if (pi >= 256) { const int t = pi - 256, prow = t >> 6, pcol = t & 63;
#pragma unroll
                    for (int e = 0; e < 4; ++e) { const int i = lq * 4 + e; const float2 cr = rope[prow * 16 + i], cc = rope[pcol * 16 + i];
                        const float a1 = y[0][e], a2 = y[1][e]; y[0][e] = a1 * cr.x - a2 * cr.y; y[1][e] = a2 * cr.x + a1 * cr.y;
                        const float b1 = y[2][e], b2 = y[3][e]; y[2][e] = b1 * cc.x - b2 * cc.y; y[3][e] = b2 * cc.x + b1 * cc.y; } }
                if (isq) {
#pragma unroll
                    for (int ni = 0; ni < 4; ++ni) { const f32x4 v = y[ni] * (0.125f * LOG2E); *(u32x2*)(Qg + (size_t)R * 512 + (nb - 1536) + ni * 16 + lq * 4) = (u32x2){pack2(v[0], v[1]), pack2(v[2], v[3])}; }
                } else {
#pragma unroll
                    for (int ni = 0; ni < 4; ++ni) { const f32x4 v = y[ni]; *(u32x2*)(Kg + (size_t)R * 128 + (nb - 2048) + ni * 16 + lq * 4) = (u32x2){pack2(v[0], v[1]), pack2(v[2], v[3])}; }
                } }
        } else if (nb < 2304) {
            const int kvh = (nb - 2176) >> 6;
#pragma unroll
            for (int mi = 0; mi < 4; ++mi) { const int R = Rb + mi * 16 + lr; const int b = R / PP, pi = R - b * PP;
#pragma unroll
                for (int ni = 0; ni < 4; ++ni) { bf16_t* vp = VTg + ((size_t)((b * 2 + kvh) * 64 + ni * 16 + lq * 4)) * PP + pi;
#pragma unroll
                    for (int e = 0; e < 4; ++e) vp[(size_t)e * PP] = (bf16_t)f2bf(acc[mi][ni][e]); } }
        } else if (nb == 2304) {
#pragma unroll
            for (int mi = 0; mi < 4; ++mi) { const int R = Rb + mi * 16 + lr;
#pragma unroll
                for (int ni = 0; ni < 2; ++ni) *(f32x4*)(LR + (size_t)R * 32 + ni * 16 + lq * 4) = acc[mi][ni]; }
        }
    }
};

#define ATT_THR 8.0f
__device__ __forceinline__ unsigned cvt_pk_bf16(float lo, float hi) { return pack2(lo, hi); }
__device__ __forceinline__ float vmax3(float a, float b, float c) { float r; asm("v_max3_f32 %0, %1, %2, %3" : "=v"(r) : "v"(a), "v"(b), "v"(c)); return r; }
__device__ __forceinline__ float vadd(float a, float b) { return a + b; }
__device__ __forceinline__ void attn_unit(char* smem, const bf16_t* __restrict__ Qp, int ldq, const bf16_t* __restrict__ Kp, int ldk, const bf16_t* __restrict__ VTp,
                                          bf16_t* __restrict__ Op, int ldo, int ntiles, int mode, int r0, int rs0, const float* __restrict__ rpb_h) {
    bf16_t* Ks = (bf16_t*)smem;
    bf16_t* Vs = Ks + 2 * 64 * 72;
    float* rp = (float*)(Vs + 2 * 64 * 72);
    const int tid = threadIdx.x, lane = tid & 63, w = tid >> 6, l31 = lane & 31, lh = lane >> 5;
    if (mode == 1) { for (int i = tid; i < 465; i += 512) rp[i] = rpb_h[i] * LOG2E; }
    bf16x8 qf[4];
    { const bf16_t* q = Qp + (size_t)(w * 32 + l31) * ldq + lh * 8;
#pragma unroll
        for (int ks = 0; ks < 4; ++ks) qf[ks] = *(const bf16x8*)(q + ks * 16); }
    f32x16 ot[2], negm;
#pragma unroll
    for (int i = 0; i < 16; ++i) { ot[0][i] = 0.f; ot[1][i] = 0.f; negm[i] = 0.f; }
    float l = 0.f;
    u32x4 rk, rv;
    const int sr = tid >> 3, scc = (tid & 7) * 8;
#define ATT_GLOAD(t_) do { const int t__ = (t_); const int pos__ = (mode == 1) ? (t__ < 4 ? t__ * 64 : 256 + (rs0 + t__ - 4) * 64) : t__ * 64; \
        rk = *(const u32x4*)(Kp + (size_t)(pos__ + sr) * ldk + scc); rv = *(const u32x4*)(VTp + (size_t)sr * PP + pos__ + scc); } while (0)
#define ATT_SSTORE(buf_) do { *(u32x4*)(Ks + (buf_) * 64 * 72 + sr * 72 + scc) = rk; *(u32x4*)(Vs + (buf_) * 64 * 72 + sr * 72 + scc) = rv; } while (0)
    ATT_GLOAD(0); ATT_SSTORE(0); __syncthreads();
    for (int t = 0; t < ntiles; ++t) {
        if (t + 1 < ntiles) ATT_GLOAD(t + 1);
        const bf16_t* ks_ = Ks + (t & 1) * 64 * 72; const bf16_t* vs_ = Vs + (t & 1) * 64 * 72;
        bool skip = false; int kr = 0, rq = 0;
        const bool local = (mode == 1) && (t >= 4);
        if (local) { kr = rs0 + t - 4; rq = r0 + (w >> 1); const int rsq = clampi(rq - 4, 0, 120); skip = (kr < rsq) || (kr >= rsq + 8); }
        if (!skip) {
            f32x16 st[2];
#pragma unroll
            for (int kt = 0; kt < 2; ++kt) {
                const bf16x8 kf0 = *(const bf16x8*)(ks_ + (kt * 32 + l31) * 72 + lh * 8);
                st[kt] = __builtin_amdgcn_mfma_f32_32x32x16_bf16(kf0, qf[0], negm, 0, 0, 0);
#pragma unroll
                for (int ks = 1; ks < 4; ++ks) { const bf16x8 kf = *(const bf16x8*)(ks_ + (kt * 32 + l31) * 72 + ks * 16 + lh * 8); st[kt] = __builtin_amdgcn_mfma_f32_32x32x16_bf16(kf, qf[ks], st[kt], 0, 0, 0); }
            }
            asm volatile("s_nop 11" : "+v"(st[0]), "+v"(st[1]));
            if (local) { const int qc = (w & 1) * 32 + l31, cs = clampi(qc - 8, 0, 48); const float* rrow = rp + (kr - rq + 7) * 31;
#pragma unroll
                for (int kt = 0; kt < 2; ++kt)
#pragma unroll
                    for (int i = 0; i < 16; ++i) { const int kc = kt * 32 + (i & 3) + 8 * (i >> 2) + 4 * lh; const bool ok = (kc >= cs) && (kc < cs + 16);
                        const float bias = rrow[clampi(kc - qc + 15, 0, 30)]; st[kt][i] = ok ? st[kt][i] + bias : -1e30f; } }
            float mx = vmax3(st[0][0], st[0][1], st[0][2]);
#pragma unroll
            for (int i = 3; i < 15; i += 2) mx = vmax3(mx, st[0][i], st[0][i + 1]);
            mx = vmax3(mx, st[0][15], st[1][0]);
#pragma unroll
            for (int i = 1; i < 15; i += 2) mx = vmax3(mx, st[1][i], st[1][i + 1]);
            mx = fmaxf(mx, st[1][15]);
            mx = fmaxf(mx, __shfl_xor(mx, 32));
            if (t == 0 || __any(mx > ATT_THR)) {
                const float adj = (t == 0) ? mx : fmaxf(mx, 0.f);
                const float sc = __builtin_amdgcn_exp2f(-adj);
                l *= sc;
#pragma unroll
                for (int i = 0; i < 16; ++i) { ot[0][i] *= sc; ot[1][i] *= sc; st[0][i] -= adj; st[1][i] -= adj; }
                const float nm = negm[0] - adj;
#pragma unroll
                for (int i = 0; i < 16; ++i) negm[i] = nm;
            }
            float ps0 = 0.f, ps1 = 0.f;
#pragma unroll
            for (int i = 0; i < 16; ++i) { st[0][i] = __builtin_amdgcn_exp2f(st[0][i]); st[1][i] = __builtin_amdgcn_exp2f(st[1][i]); ps0 = vadd(ps0, st[0][i]); ps1 = vadd(ps1, st[1][i]); }
            l += ps0 + ps1;
#pragma unroll
            for (int kt = 0; kt < 2; ++kt)
#pragma unroll
                for (int s = 0; s < 2; ++s) {
                    u32x4 pw; pw[0] = cvt_pk_bf16(st[kt][8 * s + 0], st[kt][8 * s + 1]); pw[1] = cvt_pk_bf16(st[kt][8 * s + 2], st[kt][8 * s + 3]); pw[2] = cvt_pk_bf16(st[kt][8 * s + 4], st[kt][8 * s + 5]); pw[3] = cvt_pk_bf16(st[kt][8 * s + 6], st[kt][8 * s + 7]);
                    const bf16x8 pf = __builtin_bit_cast(bf16x8, pw);
#pragma unroll
                    for (int dt = 0; dt < 2; ++dt) { const bf16_t* vp = vs_ + (dt * 32 + l31) * 72 + kt * 32 + s * 16 + lh * 4;
                        const u32x2 v0 = *(const u32x2*)vp, v1 = *(const u32x2*)(vp + 8); const u32x4 vw = (u32x4){v0[0], v0[1], v1[0], v1[1]};
                        ot[dt] = __builtin_amdgcn_mfma_f32_32x32x16_bf16(__builtin_bit_cast(bf16x8, vw), pf, ot[dt], 0, 0, 0); } }
        }
        if (t + 1 < ntiles) ATT_SSTORE((t + 1) & 1);
        __syncthreads();
    }
#undef ATT_GLOAD
#undef ATT_SSTORE
    l += __shfl_xor(l, 32);
    const float inv = 1.f / l;
    bf16_t* o = Op + (size_t)(w * 32 + l31) * ldo;
#pragma unroll
    for (int dt = 0; dt < 2; ++dt)
#pragma unroll
        for (int g = 0; g < 4; ++g) { const int d = dt * 32 + 8 * g + 4 * lh;
            *(u32x2*)(o + d) = (u32x2){cvt_pk_bf16(ot[dt][4 * g] * inv, ot[dt][4 * g + 1] * inv), cvt_pk_bf16(ot[dt][4 * g + 2] * inv, ot[dt][4 * g + 3] * inv)}; }
}

__device__ __forceinline__ void phase_na(const Params& p, char* smem) {
    unsigned char* ws = p.ws;
    const bf16_t* Qn = (const bf16_t*)(ws + R0_Q); const bf16_t* Kn = (const bf16_t*)(ws + R0_K); const bf16_t* VTn = (const bf16_t*)(ws + R0_VT);
    bf16_t* MO = (bf16_t*)(ws + WS_U);
    for (int u = blockIdx.x; u < 512 + 16; u += gridDim.x) {
        if (u < 512) { const int b = u >> 8, h = (u >> 5) & 7, qb = u & 31; const int r0 = qb * 4;
            const int rs0 = clampi(r0 - 4, 0, 120), rsl = clampi(r0 - 1, 0, 120); const int nl = rsl + 8 - rs0;
            const size_t Rq = (size_t)b * PP + 256 + qb * 256;
            attn_unit(smem, Qn + Rq * 512 + h * 64, 512, Kn + (size_t)b * PP * 512 + h * 64, 512, VTn + (size_t)((b * 8 + h) * 64) * PP, MO + Rq * 1024 + h * 64, 1024, 4 + nl, 1, r0, rs0, p.na_rpb + h * 465);
        } else { const int v = u - 512; const int b = v >> 3, h = v & 7;
            const size_t Rq = (size_t)b * PP;
            attn_unit(smem, Qn + Rq * 512 + h * 64, 512, Kn + (size_t)b * PP * 512 + h * 64, 512, VTn + (size_t)((b * 8 + h) * 64) * PP, MO + Rq * 1024 + h * 64, 1024, 4, 0, 0, 0, nullptr);
        }
    }
    const bf16_t* XL = (const bf16_t*)(ws + R0_XL); bf16_t* XC = (bf16_t*)(ws + R0_XC);
    const int gt = VB * 256 + VT, gn = NVB * 256;
    for (int idx = gt; idx < NR * 64; idx += gn) {
        const int R = idx >> 6, c8 = (idx & 63) * 8; const int b = R / PP, pi = R - b * PP; const int lo = pi < 256 ? 0 : 256, hi = pi < 256 ? 256 : PP;
        float a[8];
        { const f32x4 b0 = *(const f32x4*)(p.lru_conv_b + c8), b1 = *(const f32x4*)(p.lru_conv_b + c8 + 4); a[0] = b0[0]; a[1] = b0[1]; a[2] = b0[2]; a[3] = b0[3]; a[4] = b1[0]; a[5] = b1[1]; a[6] = b1[2]; a[7] = b1[3]; }
#pragma unroll
        for (int j = 0; j < 4; ++j) { const int pj = pi + j - 2;
            if (pj >= lo && pj < hi) { const u32x4 xv = *(const u32x4*)(XL + (size_t)(b * PP + pj) * 512 + c8);
                const f32x4 w0 = *(const f32x4*)(p.lru_conv_w + j * 512 + c8), w1 = *(const f32x4*)(p.lru_conv_w + j * 512 + c8 + 4);
                a[0] += w0[0] * bflo(xv[0]); a[1] += w0[1] * bfhi(xv[0]); a[2] += w0[2] * bflo(xv[1]); a[3] += w0[3] * bfhi(xv[1]);
                a[4] += w1[0] * bflo(xv[2]); a[5] += w1[1] * bfhi(xv[2]); a[6] += w1[2] * bflo(xv[3]); a[7] += w1[3] * bfhi(xv[3]); } }
        *(u32x4*)(XC + (size_t)R * 512 + c8) = (u32x4){pack2(a[0], a[1]), pack2(a[2], a[3]), pack2(a[4], a[5]), pack2(a[6], a[7])};
    }
}

__device__ __forceinline__ void phase_scan1(const Params& p) {
    const __half2* AB = (const __half2*)(p.ws + R0_AB); float2* SUM = (float2*)(p.ws + R0_SUM);
    for (int it = VB; it < 1056; it += NVB) {
        const int cgp = it & 1, tc = (it >> 1) % 132, db = (it >> 1) / 132, b = db & 1, d = db >> 1;
        const int c = cgp * 256 + VT;
        const __half2* ab = AB + ((size_t)d * NR + (size_t)b * PP + tc * 64) * 512 + c;
        float h = 0.f, ap = 0.f;
#pragma unroll 8
        for (int s = 0; s < 64; ++s) { const int tt = d ? 63 - s : s; const __half2 v = ab[(size_t)tt * 512]; const float la = __low2float(v), bb = __high2float(v); h = __expf(la) * h + bb; ap += la; }
        SUM[((size_t)(d * 2 + b) * 132 + tc) * 512 + c] = make_float2(__expf(ap), h);
    }
}
__device__ __forceinline__ void phase_scan2(const Params& p) {
    const __half2* AB = (const __half2*)(p.ws + R0_AB); const float2* SUM = (const float2*)(p.ws + R0_SUM);
    const bf16_t* GG = (const bf16_t*)(p.ws + R0_GG); bf16_t* MO = (bf16_t*)(p.ws + WS_U);
    for (int it = VB; it < 528; it += NVB) {
        const int cgp = it & 1, tc = (it >> 1) % 132, b = (it >> 1) / 132;
        const int c = cgp * 256 + VT; const size_t R0 = (size_t)b * PP + tc * 64;
        float hf[64];
        {
            float h = 0.f; const float2* sm = SUM + ((size_t)(0 * 2 + b) * 132) * 512 + c;
            for (int jj = 0; jj < tc; ++jj) { const float2 s = sm[(size_t)jj * 512]; h = s.x * h + s.y; }
            const __half2* ab = AB + ((size_t)0 * NR + R0) * 512 + c;
#pragma unroll
            for (int s = 0; s < 64; ++s) { const __half2 v = ab[(size_t)s * 512]; h = __expf(__low2float(v)) * h + __high2float(v); hf[s] = h; }
        }
        {
            const int j = tc < 4 ? 3 - tc : 135 - tc;
            float h = 0.f; const float2* sm = SUM + ((size_t)(1 * 2 + b) * 132) * 512 + c;
            for (int jj = 0; jj < j; ++jj) { const int tcj = jj < 4 ? 3 - jj : 135 - jj; const float2 s = sm[(size_t)tcj * 512]; h = s.x * h + s.y; }
            const __half2* ab = AB + ((size_t)1 * NR + R0) * 512 + c;
#pragma unroll
            for (int s = 0; s < 64; ++s) { const int tt = 63 - s; const __half2 v = ab[(size_t)tt * 512]; h = __expf(__low2float(v)) * h + __high2float(v);
                const float g = bf2f(GG[(R0 + tt) * 512 + c]);
                MO[(R0 + tt) * 1024 + 512 + c] = (bf16_t)f2bf((hf[tt] + h) * g); }
        }
    }
}

__device__ __forceinline__ void gla_gates(const Params& p, float* gs, const float* __restrict__ LR, size_t R0, int d, int h) {
    const int tid = VT, dk = tid & 63, tg = tid >> 6;
    float wv[16];
#pragma unroll
    for (int r = 0; r < 16; ++r) wv[r] = p.gla_wa2[(d * 16 + r) * 256 + h * 64 + dk];
    const float bav = p.gla_ba[d * 256 + h * 64 + dk];
    for (int ti = 0; ti < 16; ++ti) { const int t = tg * 16 + ti; const float* lrp = LR + (R0 + t) * 32 + d * 16; float z = bav;
#pragma unroll
        for (int r = 0; r < 16; ++r) z += lrp[r] * wv[r];
        const float ls = fminf(z, 0.f) - log1pf(__expf(-fabsf(z))); gs[t * 64 + dk] = ls * (1.f / 16.f); }
    __syncthreads();
    if (tid < 64) { float s = 0.f;
        if (d == 0) { for (int t = 0; t < 64; ++t) { s += gs[t * 64 + tid]; gs[t * 64 + tid] = s; } }
        else { for (int t = 63; t >= 0; --t) { s += gs[t * 64 + tid]; gs[t * 64 + tid] = s; } } }
    __syncthreads();
}
__device__ __forceinline__ void gla_load_vt(bf16_t* VTs, const bf16_t* __restrict__ Gv, size_t R0, int h) {
    const int tid = VT, t = tid >> 2, vq = (tid & 3) * 32; const bf16_t* src = Gv + (R0 + t) * 512 + h * 128 + vq;
#pragma unroll
    for (int q = 0; q < 4; ++q) { const u32x4 v = *(const u32x4*)(src + q * 8);
#pragma unroll
        for (int e = 0; e < 4; ++e) { VTs[(vq + q * 8 + 2 * e) * 72 + t] = (bf16_t)(v[e] & 0xffffu); VTs[(vq + q * 8 + 2 * e + 1) * 72 + t] = (bf16_t)(v[e] >> 16); } }
}
__device__ __forceinline__ void phase_gla1(const Params& p, char* smem) {
    unsigned char* ws = p.ws;
    const bf16_t* Gk = (const bf16_t*)(ws + R1_GK); const bf16_t* Gv = (const bf16_t*)(ws + R1_GV); const float* LR = (const float*)(ws + R1_LR);
    float* UC = (float*)(ws + R1_UC); float* DEC = (float*)(ws + R1_DEC);
    float* gs = (float*)smem; bf16_t* KD = (bf16_t*)(smem + 16384); bf16_t* VTs = KD + 64 * 72;
    const int tid = VT, lane = tid & 63, w = tid >> 6, lr = lane & 15, lq = lane >> 4;
    for (int it = VB; it < 2112; it += NVB) {
        const int tc = it % 132, h = (it / 132) & 3, d = (it / 528) & 1, b = it / 1056;
        const size_t R0 = (size_t)b * PP + tc * 64;
        __syncthreads();
        gla_gates(p, gs, LR, R0, d, h);
        const int tl = d ? 0 : 63;
        { const int t = tid >> 2, dq = (tid & 3) * 16; const bf16_t* src = Gk + (R0 + t) * 256 + h * 64 + dq;
#pragma unroll
            for (int q = 0; q < 2; ++q) { const u32x4 v = *(const u32x4*)(src + q * 8);
#pragma unroll
                for (int e = 0; e < 4; ++e) { const int dk0 = dq + q * 8 + 2 * e;
                    const float k0 = bflo(v[e]) * __expf(gs[tl * 64 + dk0] - gs[t * 64 + dk0]); const float k1 = bfhi(v[e]) * __expf(gs[tl * 64 + dk0 + 1] - gs[t * 64 + dk0 + 1]);
                    KD[dk0 * 72 + t] = (bf16_t)f2bf(k0); KD[(dk0 + 1) * 72 + t] = (bf16_t)f2bf(k1); } } }
        gla_load_vt(VTs, Gv, R0, h);
        __syncthreads();
        f32x4 acc[8];
#pragma unroll
        for (int i = 0; i < 8; ++i) acc[i] = (f32x4){0.f, 0.f, 0.f, 0.f};
#pragma unroll
        for (int ks = 0; ks < 2; ++ks) { const bf16x8 a = *(const bf16x8*)(KD + (16 * w + lr) * 72 + ks * 32 + lq * 8);
#pragma unroll
            for (int nt = 0; nt < 8; ++nt) { const bf16x8 bb = *(const bf16x8*)(VTs + (16 * nt + lr) * 72 + ks * 32 + lq * 8); acc[nt] = __builtin_amdgcn_mfma_f32_16x16x32_bf16(a, bb, acc[nt], 0, 0, 0); } }
        const int j = d == 0 ? tc : (tc < 4 ? 3 - tc : 135 - tc);
        const size_t chain = (size_t)((b * 2 + d) * 4 + h);
        float* up = UC + (chain * 132 + j) * 8192;
#pragma unroll
        for (int nt = 0; nt < 8; ++nt)
#pragma unroll
            for (int e = 0; e < 4; ++e) up[(16 * w + 4 * lq + e) * 128 + 16 * nt + lr] = acc[nt][e];
        if (tid < 64) DEC[(chain * 132 + j) * 64 + tid] = __expf(gs[tl * 64 + tid]);
    }
}
__device__ __forceinline__ void phase_gla2(const Params& p) {
    float* UC = (float*)(p.ws + R1_UC); const float* DEC = (const float*)(p.ws + R1_DEC);
    const int gt = VB * 256 + VT, gn = NVB * 256;
    for (int e = gt; e < 16 * 8192; e += gn) { const int chain = e >> 13, el = e & 8191, dk = el >> 7;
        float* u = UC + (size_t)chain * 132 * 8192 + el; const float* dec = DEC + (size_t)chain * 132 * 64 + dk; float S = 0.f;
#pragma unroll 4
        for (int j = 0; j < 132; ++j) { const float uv = u[(size_t)j * 8192]; const float dv = dec[j * 64]; u[(size_t)j * 8192] = S; S = dv * S + uv; } }
}
__device__ __forceinline__ void phase_gla3(const Params& p, char* smem) {
    unsigned char* ws = p.ws;
    const bf16_t* Gq = (const bf16_t*)(ws + R1_GQ); const bf16_t* Gk = (const bf16_t*)(ws + R1_GK); const bf16_t* Gv = (const bf16_t*)(ws + R1_GV); const bf16_t* Gg = (const bf16_t*)(ws + R1_GG);
    const float* LR = (const float*)(ws + R1_LR); const float* UC = (const float*)(ws + R1_UC); bf16_t* MO = (bf16_t*)(ws + WS_U);
    float* gs = (float*)smem; bf16_t* ATT = (bf16_t*)smem; bf16_t* QI = (bf16_t*)(smem + 16384); bf16_t* KI = QI + 64 * 72; bf16_t* VTs = KI + 64 * 72; bf16_t* SPT = VTs + 128 * 72;
    const int tid = VT, lane = tid & 63, w = tid >> 6, lr = lane & 15, lq = lane >> 4;
    for (int it = VB; it < 1024; it += NVB) {
        const int tcl = it & 127, h = (it >> 7) & 3, b = it >> 9; const int tc = 4 + tcl;
        const size_t R0 = (size_t)b * PP + tc * 64;
        __syncthreads();
        gla_load_vt(VTs, Gv, R0, h);
        f32x4 acc[8];
#pragma unroll
        for (int i = 0; i < 8; ++i) acc[i] = (f32x4){0.f, 0.f, 0.f, 0.f};
        for (int d = 0; d < 2; ++d) {
            const int j = d == 0 ? tc : 135 - tc; const size_t chain = (size_t)((b * 2 + d) * 4 + h);
            __syncthreads();
            gla_gates(p, gs, LR, R0, d, h);
            { const int t = tid >> 2, dq = (tid & 3) * 16; const bf16_t* qs = Gq + (R0 + t) * 256 + h * 64 + dq; const bf16_t* ksrc = Gk + (R0 + t) * 256 + h * 64 + dq;
#pragma unroll
                for (int q = 0; q < 2; ++q) { const u32x4 qv = *(const u32x4*)(qs + q * 8), kv = *(const u32x4*)(ksrc + q * 8); u32x4 qo, ko;
#pragma unroll
                    for (int e = 0; e < 4; ++e) { const int dk0 = dq + q * 8 + 2 * e; const float g0 = gs[t * 64 + dk0], g1 = gs[t * 64 + dk0 + 1];
                        const float e0 = __expf(g0), e1 = __expf(g1);
                        qo[e] = pack2(bflo(qv[e]) * 0.125f * e0, bfhi(qv[e]) * 0.125f * e1); ko[e] = pack2(bflo(kv[e]) / e0, bfhi(kv[e]) / e1); }
                    *(u32x4*)(QI + t * 72 + dq + q * 8) = qo; *(u32x4*)(KI + t * 72 + dq + q * 8) = ko; } }
            { const int dk = tid >> 2, vq = (tid & 3) * 32; const float* sp = UC + (chain * 132 + j) * 8192 + dk * 128 + vq;
#pragma unroll
                for (int q = 0; q < 8; ++q) { const f32x4 v = *(const f32x4*)(sp + q * 4);
#pragma unroll
                    for (int e = 0; e < 4; ++e) SPT[(vq + q * 4 + e) * 72 + dk] = (bf16_t)f2bf(v[e]); } }
            __syncthreads();
            f32x4 at[4];
#pragma unroll
            for (int i = 0; i < 4; ++i) at[i] = (f32x4){0.f, 0.f, 0.f, 0.f};
#pragma unroll
            for (int ks = 0; ks < 2; ++ks) { const bf16x8 a = *(const bf16x8*)(QI + (16 * w + lr) * 72 + ks * 32 + lq * 8);
#pragma unroll
                for (int nt = 0; nt < 4; ++nt) { const bf16x8 bb = *(const bf16x8*)(KI + (16 * nt + lr) * 72 + ks * 32 + lq * 8); at[nt] = __builtin_amdgcn_mfma_f32_16x16x32_bf16(a, bb, at[nt], 0, 0, 0); } }
#pragma unroll
            for (int nt = 0; nt < 4; ++nt)
#pragma unroll
                for (int e = 0; e < 4; ++e) { const int t = 16 * w + 4 * lq + e, s = 16 * nt + lr; const bool keep = d == 0 ? (s <= t) : (s >= t); ATT[t * 72 + s] = (bf16_t)f2bf(keep ? at[nt][e] : 0.f); }
            __syncthreads();
#pragma unroll
            for (int ks = 0; ks < 2; ++ks) { const bf16x8 a1 = *(const bf16x8*)(ATT + (16 * w + lr) * 72 + ks * 32 + lq * 8); const bf16x8 a2 = *(const bf16x8*)(QI + (16 * w + lr) * 72 + ks * 32 + lq * 8);
#pragma unroll
                for (int nt = 0; nt < 8; ++nt) { const bf16x8 b1 = *(const bf16x8*)(VTs + (16 * nt + lr) * 72 + ks * 32 + lq * 8); const bf16x8 b2 = *(const bf16x8*)(SPT + (16 * nt + lr) * 72 + ks * 32 + lq * 8);
                    acc[nt] = __builtin_amdgcn_mfma_f32_16x16x32_bf16(a1, b1, acc[nt], 0, 0, 0); acc[nt] = __builtin_amdgcn_mfma_f32_16x16x32_bf16(a2, b2, acc[nt], 0, 0, 0); } }
        }
#pragma unroll
        for (int e = 0; e < 4; ++e) { float ss = 0.f;
#pragma unroll
            for (int nt = 0; nt < 8; ++nt) ss += acc[nt][e] * acc[nt][e];
            ss += __shfl_xor(ss, 1); ss += __shfl_xor(ss, 2); ss += __shfl_xor(ss, 4); ss += __shfl_xor(ss, 8);
            const float rstd = rsqrtf(ss * (1.f / 128.f) + EPS); const size_t R = R0 + 16 * w + 4 * lq + e;
#pragma unroll
            for (int nt = 0; nt < 8; ++nt) { const int v = 16 * nt + lr; const float y = acc[nt][e] * rstd * p.gla_norm_w[v] * bf2f(Gg[R * 512 + h * 128 + v]); MO[R * 1024 + h * 128 + v] = (bf16_t)f2bf(y); } }
    }
}
__device__ __forceinline__ void phase_gqa(const Params& p, char* smem) {
    unsigned char* ws = p.ws;
    const bf16_t* Qg = (const bf16_t*)(ws + R1_QG); const bf16_t* Kg = (const bf16_t*)(ws + R1_KG); const bf16_t* VTg = (const bf16_t*)(ws + R1_VTG); bf16_t* MO = (bf16_t*)(ws + WS_U);
    for (int u = blockIdx.x; u < 512; u += gridDim.x) { const int b = u >> 8, hq = (u >> 5) & 7, qb = u & 31, kvh = hq >> 2;
        const size_t Rq = (size_t)b * PP + 256 + qb * 256;
        attn_unit(smem, Qg + Rq * 512 + hq * 64, 512, Kg + (size_t)b * PP * 128 + kvh * 64, 128, VTg + (size_t)((b * 2 + kvh) * 64) * PP, MO + Rq * 1024 + 512 + hq * 64, 1024, 132, 0, 0, 0, nullptr); }
}

#define XB_TMO      128
#define XB_XCNT(j)  (256  + 64 * (j))
#define XB_XSUB(j)  (1280 + 64 * (j))
#define XB_XGEN(j)  (2304 + 64 * (j))
#define XB_TOP      3328
#define XB_TOPGEN   3392
#define XCD_BAR_WORDS 3456
#define XB_SPIN_CAP (1u << 20)
#define LAS __attribute__((address_space(3)))
__device__ __forceinline__ unsigned xb_ld(unsigned* p)              { return __hip_atomic_load(p, __ATOMIC_RELAXED, __HIP_MEMORY_SCOPE_AGENT); }
__device__ __forceinline__ unsigned xb_add(unsigned* p, unsigned v) { return __hip_atomic_fetch_add(p, v, __ATOMIC_RELAXED, __HIP_MEMORY_SCOPE_AGENT); }
__device__ __forceinline__ unsigned xb_xcc_id() { return (unsigned)__builtin_amdgcn_s_getreg((3 << 11) | 20) & 0xFu; }
#define XB_SPIN(cond, bar) do { unsigned _sp = 0; while (cond) { __builtin_amdgcn_s_sleep(1); \
    if ((++_sp & 255u) == 0u) { if (xb_ld(&(bar)[XB_TMO])) break; if (_sp > XB_SPIN_CAP) { atomicAdd(&(bar)[XB_TMO], 1u); break; } } } } while (0)
struct XcdBarrier { unsigned* bar; unsigned x; volatile LAS unsigned* st; };
__device__ __forceinline__ XcdBarrier xcd_barrier_post(unsigned* bar, volatile LAS unsigned* st) {
    XcdBarrier b; b.bar = bar; b.x = xb_xcc_id(); b.st = st;
    if (threadIdx.x == 0) (void)xb_add(&bar[XB_XCNT(b.x)], 1u);
    return b;
}
__device__ __forceinline__ void xcd_barrier_complete(unsigned* bar, unsigned x, unsigned& nloc, unsigned& nx) {
    const unsigned G = gridDim.x * gridDim.y * gridDim.z;
    unsigned sum, cnt, mine, sp = 0u;
    for (;;) {
        sum = 0u; cnt = 0u; mine = 0u;
#pragma unroll
        for (unsigned j = 0; j < 16; ++j) { const unsigned c = xb_ld(&bar[XB_XCNT(j)]); sum += c; cnt += (c > 0u) ? 1u : 0u; mine = (j == x) ? c : mine; }
        if (sum == G) break;
        __builtin_amdgcn_s_sleep(1);
        if ((++sp & 255u) == 0u) { if (xb_ld(&bar[XB_TMO])) break; if (sp > XB_SPIN_CAP) { atomicAdd(&bar[XB_TMO], 1u); break; } }
    }
    nloc = mine > 0u ? mine : 1u; nx = cnt > 0u ? cnt : 1u;
}
__device__ __forceinline__ void xcd_barrier(const XcdBarrier& b) {
    asm volatile("s_waitcnt vmcnt(0)" ::: "memory");
    __syncthreads();
    if (threadIdx.x == 0) {
        unsigned* bar = b.bar;
        __builtin_amdgcn_s_waitcnt(0);
        unsigned nloc = b.st[0], nx = b.st[1];
        if (nloc == 0u) { xcd_barrier_complete(bar, b.x, nloc, nx); b.st[0] = nloc; b.st[1] = nx; }
        const unsigned old = xb_add(&bar[XB_XSUB(b.x)], 1u);
        const unsigned gen = old / nloc;
        if (old + 1u == (gen + 1u) * nloc) {
            __builtin_amdgcn_fence(__ATOMIC_RELEASE, "agent");
            asm volatile("s_waitcnt vmcnt(0)" ::: "memory");
            const unsigned og = xb_add(&bar[XB_TOP], 1u);
            const unsigned tg = og / nx;
            if (og + 1u == (tg + 1u) * nx) xb_add(&bar[XB_TOPGEN], 1u);
            else XB_SPIN(xb_ld(&bar[XB_TOPGEN]) == tg, bar);
            __builtin_amdgcn_fence(__ATOMIC_ACQUIRE, "agent");
            xb_add(&bar[XB_XGEN(b.x)], 1u);
            asm volatile("s_waitcnt vmcnt(0)" ::: "memory");
        } else {
            XB_SPIN(xb_ld(&bar[XB_XGEN(b.x)]) == gen, bar);
            __builtin_amdgcn_fence(__ATOMIC_ACQUIRE, "agent");
            asm volatile("s_waitcnt vmcnt(0)" ::: "memory");
        }
    }
    __syncthreads();
}


namespace pg8 {
#define PG8_LAS __attribute__((address_space(3)))
typedef unsigned short bf16_t;
typedef short bf16x8 __attribute__((ext_vector_type(8)));
typedef float f32x4 __attribute__((ext_vector_type(4)));
typedef unsigned u32x4 __attribute__((ext_vector_type(4)));
constexpr int BM = 256, BK = 64, HALF = 128, HTB = HALF * BK * 2  , STAGE_BYTES = 8 * HTB, NXCD = 8, WGM = 8;

__host__ __device__ __forceinline__ int lds_byte(int r, int c) { const int st = (r >> 4) * 2 + (c >> 5), rr = r & 15, cc = c & 31, ob = rr * 64 + cc * 2; return st * 1024 + (ob ^ (((ob >> 9) & 1) << 5)); }
__host__ __device__ __forceinline__ void stage_rc(int b, int& R, int& C) { const int st = b / 1024, sb = b % 1024, swz = sb ^ (((sb >> 9) & 1) << 5); R = (st >> 1) * 16 + swz / 64; C = (st & 1) * 32 + (swz % 64) / 2; }
__host__ __device__ __forceinline__ int perm32(int rho) { const int n = rho >> 4, i = rho & 15; return 8 * (i >> 2) + 4 * n + (i & 3); }

struct Unit { int pm, pn; };
struct Gemm { const bf16_t* A; const bf16_t* Bt; int M, N, K; };

struct StaticOrder {
    int nM, nN, nwg, G, c;
    __host__ __device__ void init(int M, int N, int G_, int c_) { nM = M / BM; nN = N / BM; nwg = nM * nN; G = G_; c = c_; }
    __host__ __device__ bool next(int i, Unit& u) const {
        const long L = (long)i * G + c; if (L >= nwg) return false;
        int wgid = (int)L; { const int q = nwg / NXCD, r = nwg % NXCD, xcd = wgid % NXCD, off = wgid / NXCD; wgid = (xcd < r ? xcd * (q + 1) : r * (q + 1) + (xcd - r) * q) + off; }
        const int nig = WGM * nN, gid = wgid / nig, fm = gid * WGM, gsz = (nM - fm) < WGM ? (nM - fm) : WGM;
        u.pm = fm + ((wgid % nig) % gsz); u.pn = (wgid % nig) / gsz; return true;
    }
    __device__ __forceinline__ void a_ready(const Unit&) const {}
    __device__ __forceinline__ void done(const Unit&) const {}
};
template <class Epi, class Sched, bool ALIGN_EPI = false, bool SP2 = false>
__device__ __forceinline__ void gemm_phase(PG8_LAS unsigned char* lds, const Gemm g, const Sched& S, const Epi& E) {
    const int tid = threadIdx.x, wid = __builtin_amdgcn_readfirstlane(tid >> 6), lane = tid & 63, wr = wid >> 2, wc = wid & 3, fr = lane & 15, fq = lane >> 4;
    const int K = g.K, nt = K / BK;
    unsigned voffA[2], voffB[2];
#pragma unroll
    for (int i = 0; i < 2; ++i) { int R, C; stage_rc(tid * 16 + i * 8192, R, C); const int Rb = Epi::PERM ? ((R & ~31) + perm32(R & 31)) : R;
        voffA[i] = (unsigned)(R * K + C) * 2u; voffB[i] = (unsigned)(Rb * K + C) * 2u; }
    const size_t kstep = (size_t)(BK * 2);
    const size_t hstep = (size_t)HALF * K * 2;
    const size_t tstep = 2 * hstep;
    const unsigned ldsw = (unsigned)wid * 1024u;
    const int aoff = lds_byte(wr * 64 + fr, fq * 8), boff = lds_byte(wc * 32 + fr, fq * 8);
#define PG8_SA(b, h) (((b) * 2 + (h)) * HTB)
#define PG8_SB(b, h) ((4 + (b) * 2 + (h)) * HTB)
#define PG8_STAGE(bufoff, gbase, voff) do { _Pragma("unroll") for (int _i = 0; _i < 2; ++_i) \
        __builtin_amdgcn_global_load_lds((const unsigned*)((const char*)(gbase) + (voff)[_i]), (PG8_LAS unsigned*)(lds + (bufoff) + ldsw + _i * 8192), 16, 0, 0); } while (0)
#define PG8_LDA(dst, b, h) do { _Pragma("unroll") for (int m = 0; m < 4; ++m) _Pragma("unroll") for (int k = 0; k < 2; ++k) dst[m][k] = *(const PG8_LAS bf16x8*)(lds + PG8_SA(b, h) + aoff + m * 2048 + k * 1024); } while (0)
#define PG8_LDB(dst, b, h) do { _Pragma("unroll") for (int n = 0; n < 2; ++n) _Pragma("unroll") for (int k = 0; k < 2; ++k) dst[n][k] = *(const PG8_LAS bf16x8*)(lds + PG8_SB(b, h) + boff + n * 2048 + k * 1024); } while (0)
#define PG8_MMA(ai, bj, At, Bt) do { __builtin_amdgcn_s_setprio(1); _Pragma("unroll") for (int m = 0; m < 4; ++m) _Pragma("unroll") for (int n = 0; n < 2; ++n) _Pragma("unroll") for (int k = 0; k < 2; ++k) \
        acc[ai][bj][m][n] = __builtin_amdgcn_mfma_f32_16x16x32_bf16(Bt[n][k], At[m][k], acc[ai][bj][m][n], 0, 0, 0); __builtin_amdgcn_s_setprio(0); } while (0)
#define PG8_WAIT_V(n) asm volatile("s_waitcnt vmcnt(" #n ")" ::: "memory")
#define PG8_WAIT_L(n) asm volatile("s_waitcnt lgkmcnt(" #n ")" ::: "memory")
#define PG8_BAR __builtin_amdgcn_s_barrier()
#define PG8_SCHED __builtin_amdgcn_sched_barrier(0)
    Unit cur, nxt; int ui = 0;
    if (!S.next(0, cur)) return;
    f32x4 acc[2][2][4][2];
#pragma unroll
    for (int a = 0; a < 2; ++a)
#pragma unroll
        for (int b = 0; b < 2; ++b)
#pragma unroll
            for (int m = 0; m < 4; ++m)
#pragma unroll
                for (int n = 0; n < 2; ++n) acc[a][b][m][n] = (f32x4){0.f, 0.f, 0.f, 0.f};
    bf16x8 At[4][2], B0[2][2], B1[2][2];
    const char* cA = (const char*)g.A + (size_t)cur.pm * tstep; const char* cB = (const char*)g.Bt + (size_t)cur.pn * tstep;
    S.a_ready(cur);
    if constexpr (SP2) {
        PG8_STAGE(PG8_SB(0, 0), cB, voffB); PG8_STAGE(PG8_SB(0, 1), cB + hstep, voffB); PG8_STAGE(PG8_SA(0, 0), cA, voffA); PG8_STAGE(PG8_SA(0, 1), cA + hstep, voffA);
        if (wr == 1) PG8_BAR;
        PG8_WAIT_V(2); PG8_BAR;
        PG8_STAGE(PG8_SB(1, 0), cB + kstep, voffB); PG8_STAGE(PG8_SA(1, 0), cA + kstep, voffA); PG8_STAGE(PG8_SB(1, 1), cB + hstep + kstep, voffB);
        PG8_WAIT_V(6); PG8_BAR;
    } else {
        PG8_STAGE(PG8_SB(0, 0), cB, voffB); PG8_STAGE(PG8_SA(0, 0), cA, voffA); PG8_STAGE(PG8_SB(0, 1), cB + hstep, voffB); PG8_STAGE(PG8_SA(0, 1), cA + hstep, voffA);
        if (wr == 1) PG8_BAR;
        PG8_WAIT_V(4); PG8_BAR;
        PG8_STAGE(PG8_SB(1, 0), cB + kstep, voffB); PG8_STAGE(PG8_SA(1, 0), cA + kstep, voffA); PG8_STAGE(PG8_SB(1, 1), cB + hstep + kstep, voffB);
        PG8_WAIT_V(6); PG8_BAR;
    }
    for (;;) {
        const bool has_next = S.next(ui + 1, nxt);
        const char* nA = has_next ? (const char*)g.A + (size_t)nxt.pm * tstep : cA; const char* nB = has_next ? (const char*)g.Bt + (size_t)nxt.pn * tstep : cB;
        for (int t = 0; t < nt; t += 2) {
            const bool last = (t == nt - 2);
            const char* a1 = cA + (size_t)(t + 1) * kstep;
            const char* a2 = last ? nA : cA + (size_t)(t + 2) * kstep; const char* b2 = last ? nB : cB + (size_t)(t + 2) * kstep;
            const char* a3 = a2 + kstep; const char* b3 = b2 + kstep;
            if (last && has_next) S.a_ready(nxt);
            if constexpr (SP2) {
            PG8_LDB(B0, 0, 0); PG8_LDB(B1, 0, 1); PG8_SCHED; PG8_LDA(At, 0, 0); PG8_STAGE(PG8_SA(1, 1), a1 + hstep, voffA);
            PG8_WAIT_V(8); PG8_WAIT_L(0); PG8_BAR; PG8_MMA(0, 0, At, B0); PG8_MMA(0, 1, At, B1); PG8_BAR; PG8_SCHED;
            PG8_LDA(At, 0, 1); PG8_STAGE(PG8_SB(0, 0), b2, voffB); PG8_STAGE(PG8_SB(0, 1), b2 + hstep, voffB); PG8_STAGE(PG8_SA(0, 0), a2, voffA);
            PG8_WAIT_V(8); PG8_WAIT_L(0); PG8_BAR; PG8_MMA(1, 0, At, B0); PG8_MMA(1, 1, At, B1); PG8_BAR; PG8_SCHED;
            PG8_LDB(B0, 1, 0); PG8_LDB(B1, 1, 1); PG8_SCHED; PG8_LDA(At, 1, 0); PG8_STAGE(PG8_SA(0, 1), a2 + hstep, voffA);
            PG8_WAIT_V(8); PG8_WAIT_L(0); PG8_BAR; PG8_MMA(0, 0, At, B0); PG8_MMA(0, 1, At, B1); PG8_BAR; PG8_SCHED;
            PG8_LDA(At, 1, 1); PG8_STAGE(PG8_SB(1, 0), b3, voffB); PG8_STAGE(PG8_SB(1, 1), b3 + hstep, voffB); PG8_STAGE(PG8_SA(1, 0), a3, voffA);
            PG8_WAIT_V(8); PG8_WAIT_L(0); PG8_BAR; PG8_MMA(1, 0, At, B0); PG8_MMA(1, 1, At, B1); PG8_BAR; PG8_SCHED;
            } else {
            PG8_LDB(B0, 0, 0); PG8_SCHED; PG8_LDA(At, 0, 0); PG8_STAGE(PG8_SA(1, 1), a1 + hstep, voffA);
            PG8_WAIT_L(8); PG8_BAR; PG8_WAIT_L(0); PG8_MMA(0, 0, At, B0); PG8_BAR; PG8_SCHED;
            PG8_LDB(B1, 0, 1); PG8_STAGE(PG8_SB(0, 0), b2, voffB);
            PG8_BAR; PG8_WAIT_L(0); PG8_MMA(0, 1, At, B1); PG8_BAR;
            PG8_LDA(At, 0, 1); PG8_STAGE(PG8_SA(0, 0), a2, voffA);
            PG8_BAR; PG8_WAIT_L(0); PG8_MMA(1, 0, At, B0); PG8_BAR; PG8_SCHED;
            PG8_STAGE(PG8_SB(0, 1), b2 + hstep, voffB);
            PG8_WAIT_V(6); PG8_BAR; PG8_MMA(1, 1, At, B1); PG8_BAR;
            PG8_LDB(B0, 1, 0); PG8_SCHED; PG8_LDA(At, 1, 0); PG8_STAGE(PG8_SA(0, 1), a2 + hstep, voffA);
            PG8_WAIT_L(8); PG8_BAR; PG8_WAIT_L(0); PG8_MMA(0, 0, At, B0); PG8_BAR; PG8_SCHED;
            PG8_LDB(B1, 1, 1); PG8_STAGE(PG8_SB(1, 0), b3, voffB);
            PG8_BAR; PG8_WAIT_L(0); PG8_MMA(0, 1, At, B1); PG8_BAR;
            PG8_LDA(At, 1, 1); PG8_STAGE(PG8_SA(1, 0), a3, voffA);
            PG8_BAR; PG8_WAIT_L(0); PG8_MMA(1, 0, At, B0); PG8_BAR; PG8_SCHED;
            PG8_STAGE(PG8_SB(1, 1), b3 + hstep, voffB);
            PG8_WAIT_V(6); PG8_BAR; PG8_MMA(1, 1, At, B1); PG8_BAR;
            }
        }
        if constexpr (ALIGN_EPI) { if (wr == 0) PG8_BAR; }
        if constexpr (!Epi::AFTER_DRAIN) { E(acc, cur, wr, wc, fr, fq); S.done(cur); }
        if (!has_next) break;
#pragma unroll
        for (int a = 0; a < 2; ++a)
#pragma unroll
            for (int b = 0; b < 2; ++b)
#pragma unroll
                for (int m = 0; m < 4; ++m)
#pragma unroll
                    for (int n = 0; n < 2; ++n) acc[a][b][m][n] = (f32x4){0.f, 0.f, 0.f, 0.f};
        cur = nxt; cA = nA; cB = nB; ++ui;
        if constexpr (ALIGN_EPI) { if (wr == 1) PG8_BAR; }
    }
    PG8_WAIT_V(0);
    if constexpr (!ALIGN_EPI) { if (wr == 0) PG8_BAR; }
    PG8_BAR;
    if constexpr (Epi::AFTER_DRAIN) { E.fused(acc, cur, wr, wc, fr, fq, lds, wid, lane); S.done(cur); }
#undef PG8_SA
#undef PG8_SB
#undef PG8_STAGE
#undef PG8_LDA
#undef PG8_LDB
#undef PG8_MMA
#undef PG8_WAIT_V
#undef PG8_WAIT_L
#undef PG8_BAR
#undef PG8_SCHED
}
}

template <class E> struct EpiAdapt {
    static constexpr bool PERM = false, AFTER_DRAIN = false;
    E e;
    __device__ __forceinline__ void operator()(const f32x4 (&acc)[2][2][4][2], const pg8::Unit& u, int wr, int wc, int fr, int fq) const {
        const int lane = fq * 16 + fr;
#pragma unroll
        for (int ai = 0; ai < 2; ++ai) {
            f32x4 a2[4][4];
#pragma unroll
            for (int m = 0; m < 4; ++m)
#pragma unroll
                for (int bj = 0; bj < 2; ++bj)
#pragma unroll
                    for (int n = 0; n < 2; ++n) a2[m][bj * 2 + n] = acc[ai][bj][m][n];
            e(a2, u.pm * 256 + ai * 128 + wr * 64, u.pn * 256 + wc * 64, lane);
        }
    }
};
struct LatentOrder {
    pg8::StaticOrder S;
    __device__ void init(int N, int G, int c) { S.init(64 * 256, N, G, c); }
    __device__ bool next(int i, pg8::Unit& u) const { if (!S.next(i, u)) return false; u.pm = u.pm + 1 + (u.pm >= 32 ? 1 : 0); return true; }
    __device__ __forceinline__ void a_ready(const pg8::Unit&) const {}
    __device__ __forceinline__ void done(const pg8::Unit&) const {}
};
template <class E> __device__ __forceinline__ void gemm256(char* smem_all, const bf16_t* A, const bf16_t* WT, int N, int K, bool latent_only, const E& e) {
    PG8_LAS unsigned char* lds = (PG8_LAS unsigned char*)smem_all;
    pg8::Gemm g{A, WT, NR, N, K};
    EpiAdapt<E> ea{e};
    if (latent_only) { LatentOrder S; S.init(N, (int)gridDim.x, (int)blockIdx.x); pg8::gemm_phase<EpiAdapt<E>, LatentOrder, true, true>(lds, g, S, ea); }
    else { pg8::StaticOrder S; S.init(NR, N, (int)gridDim.x, (int)blockIdx.x); pg8::gemm_phase<EpiAdapt<E>, pg8::StaticOrder, true, true>(lds, g, S, ea); }
}

template <int ph> __device__ __forceinline__ void run_phase(const Params& p, char* smem_all) {
    char* smem = smem_all + (threadIdx.x >> 8) * HALF_LDS;
    unsigned char* ws = p.ws;
    float* MOD = (float*)(ws + WS_MOD); float* Hc = (float*)(ws + WS_HC); float* Hl = p.out; bf16_t* U = (bf16_t*)(ws + WS_U);
    if constexpr (ph == 0) { phase_prologue(p, smem); }
    if constexpr (ph == 1) { phase_ln(p.x, p.ctx, p.norm1_w, MOD, 0, 1, false, U); }
    if constexpr (ph == 2) { { EpiInEven e{(bf16_t*)(ws + R0_Q), (bf16_t*)(ws + R0_K), (bf16_t*)(ws + R0_VT), (bf16_t*)(ws + R0_XL), (bf16_t*)(ws + R0_GG)};
        gemm256(smem_all, U, (const bf16_t*)(ws + WS_WINE), 2560, 1024, false, e); } }
    if constexpr (ph == 3) { phase_na(p, smem_all); }
    if constexpr (ph == 4) { { EpiLru e{(const bf16_t*)(ws + R0_XC), (__half2*)(ws + R0_AB), p.lru_ba, p.lru_bx, p.lru_lambda};
        gemm128_phase(smem, (const bf16_t*)(ws + R0_XC), 512, (const bf16_t*)(ws + WS_WLRU), 64, 132, 16, 0, 1, e); } }
    if constexpr (ph == 5) { phase_scan1(p); }
    if constexpr (ph == 6) { phase_scan2(p); }
    if constexpr (ph == 7) { { EpiResid e{p.x, p.ctx, Hl, Hc, MOD, 2}; gemm256(smem_all, U, (const bf16_t*)(ws + WS_WOUTE), 1024, 1024, false, e); } }
    if constexpr (ph == 8) { phase_ln(Hl, Hc, p.norm2_w, MOD, 3, 4, false, U); }
    if constexpr (ph == 9) { { EpiFF1 e{(bf16_t*)(ws + R_FF)}; gemm256(smem_all, U, (const bf16_t*)(ws + WS_WFF1), 4096, 1024, false, e); } }
    if constexpr (ph == 10) { { EpiResid e{Hl, Hc, Hl, Hc, MOD, 5}; gemm256(smem_all, (const bf16_t*)(ws + R_FF), (const bf16_t*)(ws + WS_WFF2), 1024, 4096, false, e); } }
    if constexpr (ph == 11) { phase_ln(Hl, Hc, p.norm1_w + 1024, MOD + 3 * 6144, 0, 1, false, U); }
    if constexpr (ph == 12) { { EpiInOdd e{(bf16_t*)(ws + R1_GQ), (bf16_t*)(ws + R1_GK), (bf16_t*)(ws + R1_GV), (bf16_t*)(ws + R1_GG), (bf16_t*)(ws + R1_QG), (bf16_t*)(ws + R1_KG), (bf16_t*)(ws + R1_VTG),
                          (float*)(ws + R1_LR), p.gqa_q_norm_w, p.gqa_k_norm_w, (const float2*)(ws + WS_ROPE)};
        gemm256(smem_all, U, (const bf16_t*)(ws + WS_WINO), 2560, 1024, false, e); } }
    if constexpr (ph == 13) { phase_gla1(p, smem); }
    if constexpr (ph == 14) { phase_gla2(p); phase_gqa(p, smem_all); }
    if constexpr (ph == 15) { phase_gla3(p, smem); }
    if constexpr (ph == 16) { { EpiResid e{Hl, Hc, Hl, Hc, MOD + 3 * 6144, 2}; gemm256(smem_all, U, (const bf16_t*)(ws + WS_WOUTO), 1024, 1024, true, e); } }
    if constexpr (ph == 17) { phase_ln(Hl, Hc, p.norm2_w + 1024, MOD + 3 * 6144, 3, 4, true, U); }
    if constexpr (ph == 18) { { EpiFF1 e{(bf16_t*)(ws + R_FF)}; gemm256(smem_all, U, (const bf16_t*)(ws + WS_WFF1) + (size_t)4096 * 1024, 4096, 1024, true, e); } }
    if constexpr (ph == 19) { { EpiResid e{Hl, Hc, Hl, Hc, MOD + 3 * 6144, 5}; gemm256(smem_all, (const bf16_t*)(ws + R_FF), (const bf16_t*)(ws + WS_WFF2) + (size_t)4096 * 1024, 1024, 4096, true, e); } }
    if constexpr (ph == 20) { phase_final(p.final_norm_w, Hl); }
}

#if MEGA
template <int PH> __device__ __forceinline__ void run_all(const Params& p, char* smem, cg::grid_group& grid, const XcdBarrier& xb) {
    if constexpr (PH < NPHASE) {
        run_phase<PH>(p, smem);
        if constexpr ((REPMASK >> PH) & 1) { xcd_barrier(xb); run_phase<PH>(p, smem); }
        if constexpr (PH + 1 < NPHASE) { if constexpr (PH == 0) grid.sync(); else xcd_barrier(xb); }
        run_all<PH + 1>(p, smem, grid, xb);
    }
}
__global__ void __launch_bounds__(512, 2) hybrid_fwd(Params p) {
    extern __shared__ __attribute__((aligned(16))) char smem[];
    __shared__ uint4 xb_words;
    cg::grid_group grid = cg::this_grid();
    if (threadIdx.x == 0) xb_words = make_uint4(0u, 0u, 0u, 0u);
    __syncthreads();
    const XcdBarrier xb = xcd_barrier_post((unsigned*)(p.ws + WS_BAR), (volatile LAS unsigned*)&xb_words);
    run_all<0>(p, smem, grid, xb);
}
#else
template <int PH> __global__ void __launch_bounds__(512, 2) phase_k(Params p) {
    extern __shared__ __attribute__((aligned(16))) char smem[];
    run_phase<PH>(p, smem);
}
template <int PH> static bool setup_all() {
    if constexpr (PH < NPHASE) { if (hipFuncSetAttribute((const void*)phase_k<PH>, hipFuncAttributeMaxDynamicSharedMemorySize, LDS_BYTES) != hipSuccess) return false; return setup_all<PH + 1>(); }
    else return true;
}
template <int PH> static void launch_all(const Params& p, int grid, hipStream_t stream) {
    if constexpr (PH < NPHASE) { hipLaunchKernelGGL(phase_k<PH>, dim3(grid), dim3(512), LDS_BYTES, stream, p); launch_all<PH + 1>(p, grid, stream); }
}
#endif

extern "C" void kernel_launch(void* const* d_in, const int* in_sizes, int n_in, void* d_out, int out_size, void* d_ws, size_t ws_size, hipStream_t stream) {
    static int grid_blocks = 0;
    if (grid_blocks == 0) {
        if (n_in != 28 || out_size != NB * SEQ * DM || ws_size < WS_NEED) { fprintf(stderr, "kernel_launch: unexpected shapes (n_in %d out %d ws %zu need %zu)\n", n_in, out_size, ws_size, (size_t)WS_NEED); grid_blocks = -1; return; }
        int dev = 0, cus = 0, per_cu = 0;
        if (hipGetDevice(&dev) != hipSuccess || hipDeviceGetAttribute(&cus, hipDeviceAttributeMultiprocessorCount, dev) != hipSuccess) { grid_blocks = -1; return; }
#if MEGA
        if (hipFuncSetAttribute((const void*)hybrid_fwd, hipFuncAttributeMaxDynamicSharedMemorySize, LDS_BYTES) != hipSuccess) { fprintf(stderr, "kernel_launch: hipFuncSetAttribute failed\n"); grid_blocks = -1; return; }
        if (hipOccupancyMaxActiveBlocksPerMultiprocessor(&per_cu, (const void*)hybrid_fwd, 512, LDS_BYTES) != hipSuccess || per_cu < 1) { fprintf(stderr, "kernel_launch: occupancy query failed (%d)\n", per_cu); grid_blocks = -1; return; }
        if (per_cu > 1) per_cu = 1;
#else
        if (!setup_all<0>()) { fprintf(stderr, "kernel_launch: hipFuncSetAttribute failed\n"); grid_blocks = -1; return; }
        per_cu = 1;
#endif
        grid_blocks = cus * per_cu;
    }
    if (grid_blocks < 0) return;
    Params p{};
    const float** pp = (const float**)&p;
    for (int i = 0; i < 28; ++i) pp[i] = (const float*)d_in[i];
    p.out = (float*)d_out; p.ws = (unsigned char*)d_ws;
    p.ph_lo = 0; p.ph_hi = NPHASE;
#if MEGA
    if (hipMemsetAsync((char*)d_ws + WS_BAR, 0, 16384, stream) != hipSuccess) { fprintf(stderr, "kernel_launch: memset failed\n"); return; }
    void* args[] = {&p};
    hipError_t e = hipLaunchCooperativeKernel((const void*)hybrid_fwd, dim3(grid_blocks), dim3(512), args, LDS_BYTES, stream);
    if (e != hipSuccess) fprintf(stderr, "cooperative launch failed: %s (grid %d)\n", hipGetErrorString(e), grid_blocks);
#else
    launch_all<0>(p, grid_blocks, stream);
#endif
}
```

```cpp
#include <hip/hip_runtime.h>
#include <hip/hip_cooperative_groups.h>
#include <hip/hip_fp16.h>
#include <cstdio>
#include <cstdint>
namespace cg = cooperative_groups;

#ifndef MEGA
#define MEGA 1
#endif
#ifndef REPMASK
#define REPMASK 0
#endif

typedef unsigned short bf16_t;
typedef short bf16x8 __attribute__((ext_vector_type(8)));
typedef short s16x4 __attribute__((ext_vector_type(4)));
typedef float f32x4 __attribute__((ext_vector_type(4)));
typedef float f32x16 __attribute__((ext_vector_type(16)));
typedef unsigned u32x4 __attribute__((ext_vector_type(4)));
typedef unsigned u32x2 __attribute__((ext_vector_type(2)));

constexpr int DM = 1024, NB = 2, SEQ = 8192, CTX = 256, PP = SEQ + CTX, NR = NB * PP;
constexpr float EPS = 1e-6f;
constexpr float LOG2E = 1.4426950408889634f;
constexpr int HALF_LDS = 72704;
constexpr int LDS_BYTES = 2 * HALF_LDS;
#define VT ((int)(threadIdx.x & 255))
#define VB ((int)(blockIdx.x * 2 + (threadIdx.x >> 8)))
#define NVB ((int)(gridDim.x * 2))
constexpr int NPHASE = 21;

constexpr size_t WS_WFF1 = 0;
constexpr size_t WS_WFF2 = WS_WFF1 + 2ull * 4096 * 1024 * 2;
constexpr size_t WS_WINE = WS_WFF2 + 2ull * 4096 * 1024 * 2;
constexpr size_t WS_WOUTE = WS_WINE + 2560ull * 1024 * 2;
constexpr size_t WS_WINO = WS_WOUTE + 1024ull * 1024 * 2;
constexpr size_t WS_WOUTO = WS_WINO + 2560ull * 1024 * 2;
constexpr size_t WS_WLRU = WS_WOUTO + 1024ull * 1024 * 2;
constexpr size_t WS_MOD = WS_WLRU + 2048ull * 64 * 2;
constexpr size_t WS_ROPE = WS_MOD + 2ull * 3 * 6144 * 4;
constexpr size_t WS_SP = WS_ROPE + 128ull * 16 * 8;
constexpr size_t WS_HC = WS_SP + 2ull * 512 * 4;
constexpr size_t WS_U = WS_HC + 512ull * 1024 * 4;
constexpr size_t WS_REG = WS_U + (size_t)NR * 1024 * 2;
constexpr size_t R0_Q = WS_REG;
constexpr size_t R0_K = R0_Q + (size_t)NR * 512 * 2;
constexpr size_t R0_VT = R0_K + (size_t)NR * 512 * 2;
constexpr size_t R0_XL = R0_VT + (size_t)NR * 512 * 2;
constexpr size_t R0_GG = R0_XL + (size_t)NR * 512 * 2;
constexpr size_t R0_XC = R0_GG + (size_t)NR * 512 * 2;
constexpr size_t R0_AB = R0_XC + (size_t)NR * 512 * 2;
constexpr size_t R0_SUM = R0_AB + 2ull * NR * 512 * 4;
constexpr size_t R0_END = R0_SUM + 2ull * 2 * 132 * 512 * 8;
constexpr size_t R_FF = WS_REG;
constexpr size_t RFF_END = R_FF + (size_t)NR * 4096 * 2;
constexpr size_t R1_GQ = WS_REG;
constexpr size_t R1_GK = R1_GQ + (size_t)NR * 256 * 2;
constexpr size_t R1_GV = R1_GK + (size_t)NR * 256 * 2;
constexpr size_t R1_GG = R1_GV + (size_t)NR * 512 * 2;
constexpr size_t R1_LR = R1_GG + (size_t)NR * 512 * 2;
constexpr size_t R1_QG = R1_LR + (size_t)NR * 32 * 4;
constexpr size_t R1_KG = R1_QG + (size_t)NR * 512 * 2;
constexpr size_t R1_VTG = R1_KG + (size_t)NR * 128 * 2;
constexpr size_t R1_UC = R1_VTG + (size_t)NR * 128 * 2;
constexpr size_t R1_DEC = R1_UC + 16ull * 132 * 8192 * 4;
constexpr size_t R1_END = R1_DEC + 16ull * 132 * 64 * 4;
constexpr size_t WS_BAR = 268435456ull - 16384ull;
constexpr size_t WS_NEED0 = (R0_END > RFF_END ? (R0_END > R1_END ? R0_END : R1_END) : (RFF_END > R1_END ? RFF_END : R1_END));
static_assert(WS_NEED0 <= WS_BAR, "workspace overlay runs into the barrier words");
constexpr size_t WS_NEED = 268435456ull;

struct Params {
    const float *x, *c, *ctx, *c_ctx, *norm1_w, *norm2_w, *w_mod, *b_mod, *w_ff1, *w_ff2;
    const float *w_in_even, *na_rpb, *lru_conv_w, *lru_conv_b, *lru_wa, *lru_ba, *lru_wx, *lru_bx, *lru_lambda, *w_out_even;
    const float *w_in_odd, *gla_wa2, *gla_ba, *gla_norm_w, *gqa_q_norm_w, *gqa_k_norm_w, *w_out_odd, *final_norm_w;
    float* out;
    unsigned char* ws;
    int ph_lo, ph_hi;
};

__device__ __forceinline__ unsigned f2bf(float f) { unsigned u = __float_as_uint(f); u += 0x7fffu + ((u >> 16) & 1u); return u >> 16; }
typedef float f32x2_t __attribute__((ext_vector_type(2)));
typedef __bf16 bf16x2_t __attribute__((ext_vector_type(2)));
__device__ __forceinline__ unsigned pack2(float a, float b) { const f32x2_t v = {a, b}; const bf16x2_t r = __builtin_convertvector(v, bf16x2_t); return __builtin_bit_cast(unsigned, r); }
__device__ __forceinline__ float bf2f(unsigned h) { return __uint_as_float(h << 16); }
__device__ __forceinline__ float bflo(unsigned w) { return __uint_as_float(w << 16); }
__device__ __forceinline__ float bfhi(unsigned w) { return __uint_as_float(w & 0xffff0000u); }
__device__ __forceinline__ float sigmoidf_(float z) { return __builtin_amdgcn_rcpf(1.f + __expf(-z)); }
__device__ __forceinline__ float wave_sum(float v) {
#pragma unroll
    for (int o = 32; o > 0; o >>= 1) v += __shfl_xor(v, o);
    return v;
}
__device__ __forceinline__ int clampi(int v, int lo, int hi) { return v < lo ? lo : (v > hi ? hi : v); }

__host__ __device__ __forceinline__ int phys2log(int P) { const int t = P >> 8, q = P & 255, bj = q >> 7, wc = (q >> 5) & 3, r = q & 31; return (t << 8) + 64 * wc + 32 * bj + r; }
__device__ __forceinline__ void tr_job(float* tile, const float* __restrict__ src, int Nsrc, bf16_t* __restrict__ dst, int K, int Ndst, int mode) {
    const int tid = VT;
    const int nkt = K >> 6, ntiles = (Ndst >> 6) * nkt;
    for (int t = VB; t < ntiles; t += NVB) {
        const int n0 = (t / nkt) << 6, k0 = (t % nkt) << 6;
        __syncthreads();
        {
            const int n = tid & 63; const int nn = phys2log(n0 + n); bool valid = true; int on = nn;
            if (mode == 1) { if (nn >= 2336) valid = false; else if (nn >= 2304) on = nn - 2304 + 1536; else if (nn >= 1536) on = nn + 32; }
#pragma unroll
            for (int i = 0; i < 16; ++i) { const int k = i * 4 + (tid >> 6); tile[k * 65 + n] = valid ? src[(size_t)(k0 + k) * Nsrc + on] : 0.f; }
        }
        __syncthreads();
        {
            const int n = tid >> 2, kq = (tid & 3) * 16; unsigned w[8];
#pragma unroll
            for (int j = 0; j < 8; ++j) w[j] = pack2(tile[(kq + 2 * j) * 65 + n], tile[(kq + 2 * j + 1) * 65 + n]);
            u32x4* d = (u32x4*)(dst + (size_t)(n0 + n) * K + k0 + kq);
            d[0] = (u32x4){w[0], w[1], w[2], w[3]}; d[1] = (u32x4){w[4], w[5], w[6], w[7]};
        }
    }
}

__device__ __forceinline__ void phase_prologue(const Params& p, char* smem) {
    const int tid = VT, bid = VB, nblk = NVB;
    unsigned char* ws = p.ws;
    {
        float* sv = (float*)smem; float* red = sv + 3072; float* MOD = (float*)(ws + WS_MOD);
        for (int i = tid; i < 3072; i += 256) { const int j = i >> 10, k = i & 1023; const float v = j < 2 ? p.c[j * 1024 + k] : p.c_ctx[k]; sv[i] = v / (1.f + __expf(-v)); }
        __syncthreads();
        for (int it = bid; it < 192; it += nblk) {
            const int l = it / 96, n0 = (it % 96) * 64, col = tid & 63, kg = tid >> 6;
            const float* w = p.w_mod + (size_t)l * 1024 * 6144 + n0 + col;
            float a0 = 0.f, a1 = 0.f, a2 = 0.f;
#pragma unroll 8
            for (int k = kg * 256; k < kg * 256 + 256; ++k) { const float wv = w[(size_t)k * 6144]; a0 += sv[k] * wv; a1 += sv[1024 + k] * wv; a2 += sv[2048 + k] * wv; }
            red[(kg * 3 + 0) * 64 + col] = a0; red[(kg * 3 + 1) * 64 + col] = a1; red[(kg * 3 + 2) * 64 + col] = a2;
            __syncthreads();
            if (tid < 192) { const int j = tid >> 6, cc = tid & 63;
                const float s = red[(0 * 3 + j) * 64 + cc] + red[(1 * 3 + j) * 64 + cc] + red[(2 * 3 + j) * 64 + cc] + red[(3 * 3 + j) * 64 + cc];
                MOD[(l * 3 + j) * 6144 + n0 + cc] = s + p.b_mod[l * 6144 + n0 + cc]; }
            __syncthreads();
        }
    }
    {
        const int gt = bid * 256 + tid, gn = nblk * 256;
        float2* rope = (float2*)(ws + WS_ROPE);
        for (int i = gt; i < 2048; i += gn) { const int pos = i >> 4, f = i & 15; const float inv = powf(10000.f, -(float)f / 16.f); const float ang = (float)pos * inv; float s, c; sincosf(ang, &s, &c); rope[i] = make_float2(c, s); }
        float* spt = (float*)(ws + WS_SP);
        for (int i = gt; i < 1024; i += gn) spt[i] = log1pf(__expf(-p.lru_lambda[i]));
        bf16_t* wl = (bf16_t*)(ws + WS_WLRU);
        for (int i = gt; i < 2048 * 64; i += gn) { const int n = i >> 6, k = i & 63; const int h = n >> 8, d = (n >> 7) & 1, j = (n & 127) >> 1, g = n & 1;
            const float* W = g ? p.lru_wx : p.lru_wa; wl[i] = (bf16_t)f2bf(W[(((size_t)(d * 8 + h) * 64 + k) * 64) + j]); }
    }
    float* tile = (float*)smem;
    for (int l = 0; l < 2; ++l) {
        tr_job(tile, p.w_ff1 + (size_t)l * 1024 * 4096, 4096, (bf16_t*)(ws + WS_WFF1) + (size_t)l * 4096 * 1024, 1024, 4096, 0);
        tr_job(tile, p.w_ff2 + (size_t)l * 4096 * 1024, 1024, (bf16_t*)(ws + WS_WFF2) + (size_t)l * 4096 * 1024, 4096, 1024, 0);
    }
    tr_job(tile, p.w_in_even, 2560, (bf16_t*)(ws + WS_WINE), 1024, 2560, 0);
    tr_job(tile, p.w_out_even, 1024, (bf16_t*)(ws + WS_WOUTE), 1024, 1024, 0);
    tr_job(tile, p.w_in_odd, 2336, (bf16_t*)(ws + WS_WINO), 1024, 2560, 1);
    tr_job(tile, p.w_out_odd, 1024, (bf16_t*)(ws + WS_WOUTO), 1024, 1024, 0);
}

__device__ __forceinline__ void phase_ln(const float* __restrict__ srcL, const float* __restrict__ srcC, const float* __restrict__ nw, const float* __restrict__ mod, int sh_slot, int sc_slot, bool latent_only, bf16_t* __restrict__ U) {
    const int lane = VT & 63, gw = VB * 4 + (VT >> 6), nwt = NVB * 4;
    const int nrows = latent_only ? NB * SEQ : NR;
    for (int idx = gw; idx < nrows; idx += nwt) {
        int b, pi; if (latent_only) { b = idx >> 13; pi = 256 + (idx & 8191); } else { b = idx / PP; pi = idx - b * PP; }
        const int R = b * PP + pi; const bool isc = pi < 256; const int ms = isc ? 2 : b;
        const float* src = isc ? srcC + (size_t)(b * 256 + pi) * 1024 : srcL + (size_t)(b * 8192 + pi - 256) * 1024;
        f32x4 v[4]; float ss = 0.f;
#pragma unroll
        for (int i = 0; i < 4; ++i) { v[i] = *(const f32x4*)(src + i * 256 + lane * 4); ss += v[i][0] * v[i][0] + v[i][1] * v[i][1] + v[i][2] * v[i][2] + v[i][3] * v[i][3]; }
        ss = wave_sum(ss);
        const float rstd = rsqrtf(ss * (1.f / 1024.f) + EPS);
        const float* sh = mod + ms * 6144 + sh_slot * 1024; const float* sc = mod + ms * 6144 + sc_slot * 1024;
#pragma unroll
        for (int i = 0; i < 4; ++i) { const int n = i * 256 + lane * 4;
            const f32x4 w4 = *(const f32x4*)(nw + n), s4 = *(const f32x4*)(sc + n), h4 = *(const f32x4*)(sh + n);
            const f32x4 y = v[i] * rstd * w4 * (s4 + 1.f) + h4;
            *(u32x2*)(U + (size_t)R * 1024 + n) = (u32x2){pack2(y[0], y[1]), pack2(y[2], y[3])}; }
    }
}

__device__ __forceinline__ void phase_final(const float* __restrict__ fw, float* __restrict__ out) {
    const int lane = VT & 63, gw = VB * 4 + (VT >> 6), nwt = NVB * 4;
    for (int idx = gw; idx < NB * SEQ; idx += nwt) {
        float* row = out + (size_t)idx * 1024;
        f32x4 v[4]; float ss = 0.f;
#pragma unroll
        for (int i = 0; i < 4; ++i) { v[i] = *(const f32x4*)(row + i * 256 + lane * 4); ss += v[i][0] * v[i][0] + v[i][1] * v[i][1] + v[i][2] * v[i][2] + v[i][3] * v[i][3]; }
        ss = wave_sum(ss);
        const float rstd = rsqrtf(ss * (1.f / 1024.f) + EPS);
#pragma unroll
        for (int i = 0; i < 4; ++i) { const int n = i * 256 + lane * 4; const f32x4 w4 = *(const f32x4*)(fw + n); *(f32x4*)(row + n) = v[i] * rstd * w4; }
    }
}

template <class Epi>
__device__ __forceinline__ void gemm128_phase(char* smem, const bf16_t* __restrict__ A, int lda, const bf16_t* __restrict__ WT, int K, int nMt, int nNt, int rowmode, int lru, const Epi& epi) {
    bf16_t* As = (bf16_t*)smem; bf16_t* Bs = As + 128 * 72;
    const int tid = VT, lane = tid & 63, wid = tid >> 6, wm = wid >> 1, wn = wid & 1;
    const int lr = lane & 15, lq = lane >> 4;
    const int ntiles = nMt * nNt;
    for (int tile = VB; tile < ntiles; tile += NVB) {
        const int mt = tile / nNt, nt = tile - mt * nNt;
        const int row0 = rowmode ? ((mt >> 6) * PP + 256 + (mt & 63) * 128) : mt * 128;
        const bf16_t* Ag = A + (size_t)row0 * lda + (lru ? (nt >> 1) * 64 : 0);
        const bf16_t* Bg = WT + (size_t)nt * 128 * K;
        f32x4 acc[4][4];
#pragma unroll
        for (int i = 0; i < 4; ++i)
#pragma unroll
            for (int j = 0; j < 4; ++j) acc[i][j] = (f32x4){0.f, 0.f, 0.f, 0.f};
        u32x4 ra[4], rb[4];
#pragma unroll
        for (int i = 0; i < 4; ++i) { const int c = tid + 256 * i, r = c >> 3, kc = (c & 7) * 8; ra[i] = *(const u32x4*)(Ag + (size_t)r * lda + kc); rb[i] = *(const u32x4*)(Bg + (size_t)r * K + kc); }
        for (int k0 = 0; k0 < K; k0 += 64) {
            __syncthreads();
#pragma unroll
            for (int i = 0; i < 4; ++i) { const int c = tid + 256 * i, r = c >> 3, kc = (c & 7) * 8; *(u32x4*)(As + r * 72 + kc) = ra[i]; *(u32x4*)(Bs + r * 72 + kc) = rb[i]; }
            __syncthreads();
            if (k0 + 64 < K) {
#pragma unroll
                for (int i = 0; i < 4; ++i) { const int c = tid + 256 * i, r = c >> 3, kc = (c & 7) * 8 + k0 + 64; ra[i] = *(const u32x4*)(Ag + (size_t)r * lda + kc); rb[i] = *(const u32x4*)(Bg + (size_t)r * K + kc); }
            }
#pragma unroll
            for (int ks = 0; ks < 2; ++ks) {
                bf16x8 af[4], bfr[4];
#pragma unroll
                for (int i = 0; i < 4; ++i) { af[i] = *(const bf16x8*)(As + (wm * 64 + i * 16 + lr) * 72 + ks * 32 + lq * 8); bfr[i] = *(const bf16x8*)(Bs + (wn * 64 + i * 16 + lr) * 72 + ks * 32 + lq * 8); }
#pragma unroll
                for (int mi = 0; mi < 4; ++mi)
#pragma unroll
                    for (int ni = 0; ni < 4; ++ni) acc[mi][ni] = __builtin_amdgcn_mfma_f32_16x16x32_bf16(bfr[ni], af[mi], acc[mi][ni], 0, 0, 0);
            }
        }
        epi(acc, row0 + wm * 64, nt * 128 + wn * 64, lane);
    }
}

struct EpiResid {
    const float* srcL; const float* srcC; float* dstL; float* dstC; const float* mod; int slot;
    __device__ __forceinline__ void operator()(const f32x4 (&acc)[4][4], int Rb, int nb, int lane) const {
        const int lr = lane & 15, lq = lane >> 4;
#pragma unroll
        for (int mi = 0; mi < 4; ++mi) {
            const int R = Rb + mi * 16 + lr; const int b = R / PP, pi = R - b * PP; const bool isc = pi < 256; const int ms = isc ? 2 : b;
            const size_t ro = isc ? (size_t)(b * 256 + pi) * 1024 : (size_t)(b * 8192 + pi - 256) * 1024;
            const float* s = (isc ? srcC : srcL) + ro; float* d = (isc ? dstC : dstL) + ro; const float* g = mod + ms * 6144 + slot * 1024;
#pragma unroll
            for (int ni = 0; ni < 4; ++ni) { const int n = nb + ni * 16 + lq * 4; const f32x4 h = *(const f32x4*)(s + n), gg = *(const f32x4*)(g + n); *(f32x4*)(d + n) = h + gg * acc[mi][ni]; }
        }
    }
};
struct EpiFF1 {
    bf16_t* FF;
    __device__ __forceinline__ void operator()(const f32x4 (&acc)[4][4], int Rb, int nb, int lane) const {
        const int lr = lane & 15, lq = lane >> 4;
#pragma unroll
        for (int mi = 0; mi < 4; ++mi) { const int R = Rb + mi * 16 + lr;
#pragma unroll
            for (int ni = 0; ni < 4; ++ni) { const int n = nb + ni * 16 + lq * 4; f32x4 v = acc[mi][ni];
#pragma unroll
                for (int e = 0; e < 4; ++e) { const float r = fmaxf(v[e], 0.f); v[e] = r * r; }
                *(u32x2*)(FF + (size_t)R * 4096 + n) = (u32x2){pack2(v[0], v[1]), pack2(v[2], v[3])}; } }
    }
};
__device__ __forceinline__ float gelu_tanh(float x) { const float u = 0.7978845608028654f * (x + 0.044715f * x * x * x); const float t = 1.f - 2.f / (1.f + __expf(2.f * u)); return 0.5f * x * (1.f + t); }
struct EpiInEven {
    bf16_t *Qn, *Kn, *VTn, *XL, *GG;
    __device__ __forceinline__ void operator()(const f32x4 (&acc)[4][4], int Rb, int nb, int lane) const {
        const int lr = lane & 15, lq = lane >> 4;
#pragma unroll
        for (int mi = 0; mi < 4; ++mi) { const int R = Rb + mi * 16 + lr; const int b = R / PP, pi = R - b * PP;
#pragma unroll
            for (int ni = 0; ni < 4; ++ni) { const int n = nb + ni * 16 + lq * 4; const f32x4 a = acc[mi][ni];
                if (n < 512) *(u32x2*)(Qn + (size_t)R * 512 + n) = (u32x2){pack2(a[0] * (0.125f * LOG2E), a[1] * (0.125f * LOG2E)), pack2(a[2] * (0.125f * LOG2E), a[3] * (0.125f * LOG2E))};
                else if (n < 1024) *(u32x2*)(Kn + (size_t)R * 512 + (n - 512)) = (u32x2){pack2(a[0], a[1]), pack2(a[2], a[3])};
                else if (n < 1536) { const int hh = (n - 1024) >> 6, d0 = (n - 1024) & 63; bf16_t* vp = VTn + ((size_t)((b * 8 + hh) * 64 + d0)) * PP + pi;
#pragma unroll
                    for (int e = 0; e < 4; ++e) vp[(size_t)e * PP] = (bf16_t)f2bf(a[e]); }
                else if (n < 2048) *(u32x2*)(XL + (size_t)R * 512 + (n - 1536)) = (u32x2){pack2(a[0], a[1]), pack2(a[2], a[3])};
                else *(u32x2*)(GG + (size_t)R * 512 + (n - 2048)) = (u32x2){pack2(gelu_tanh(a[0]), gelu_tanh(a[1])), pack2(gelu_tanh(a[2]), gelu_tanh(a[3]))};
            } }
    }
};
struct EpiLru {
    const bf16_t* XC; __half2* AB; const float *ba, *bx, *lam;
    __device__ __forceinline__ void operator()(const f32x4 (&acc)[4][4], int Rb, int nb, int lane) const {
        const int lr = lane & 15, lq = lane >> 4;
        const int h = nb >> 8, d = (nb >> 7) & 1, colb = nb & 127;
#pragma unroll
        for (int mi = 0; mi < 4; ++mi) { const int R = Rb + mi * 16 + lr;
#pragma unroll
            for (int ni = 0; ni < 4; ++ni) { const int j0 = (colb + ni * 16 + lq * 4) >> 1; const int c = h * 64 + j0; __half2 o[2];
#pragma unroll
                for (int e2 = 0; e2 < 2; ++e2) { const int cc = c + e2;
                    const float za = acc[mi][ni][2 * e2] + ba[d * 512 + cc], zx = acc[mi][ni][2 * e2 + 1] + bx[d * 512 + cc];
                    const float r = sigmoidf_(za), ig = sigmoidf_(zx);
                    const float la = -8.f * r * lam[d * 512 + cc];
                    const float xv = bf2f(XC[(size_t)R * 512 + cc]);
                    const float x2 = 2.f * la;
                    const float ser = -x2 * (1.f + x2 * 0.5f * (1.f + x2 * (1.f / 3.f) * (1.f + x2 * 0.25f * (1.f + x2 * 0.2f))));
                    const float om = (x2 > -0.25f) ? ser : 1.f - __expf(x2);
                    const float bb = __builtin_amdgcn_sqrtf(fmaxf(om, 0.f)) * ig * xv;
                    o[e2] = __floats2half2_rn(la, bb); }
                __half2* dst = AB + ((size_t)d * NR + R) * 512 + c; dst[0] = o[0]; dst[1] = o[1]; } }
    }
};
struct EpiInOdd {
    bf16_t *Gq, *Gk, *Gv, *Gg, *Qg, *Kg, *VTg; float* LR; const float *qnw, *knw; const float2* rope;
    __device__ __forceinline__ void operator()(const f32x4 (&acc)[4][4], int Rb, int nb, int lane) const {
        const int lr = lane & 15, lq = lane >> 4;
        if (nb < 1536) {
#pragma unroll
            for (int mi = 0; mi < 4; ++mi) { const int R = Rb + mi * 16 + lr;
#pragma unroll
                for (int ni = 0; ni < 4; ++ni) { const int n = nb + ni * 16 + lq * 4; const f32x4 a = acc[mi][ni];
                    if (n < 256) *(u32x2*)(Gq + (size_t)R * 256 + n) = (u32x2){pack2(a[0], a[1]), pack2(a[2], a[3])};
                    else if (n < 512) *(u32x2*)(Gk + (size_t)R * 256 + (n - 256)) = (u32x2){pack2(a[0], a[1]), pack2(a[2], a[3])};
                    else if (n < 1024) *(u32x2*)(Gv + (size_t)R * 512 + (n - 512)) = (u32x2){pack2(a[0], a[1]), pack2(a[2], a[3])};
                    else { f32x4 s;
#pragma unroll
                        for (int e = 0; e < 4; ++e) s[e] = a[e] * sigmoidf_(a[e]);
                        *(u32x2*)(Gg + (size_t)R * 512 + (n - 1024)) = (u32x2){pack2(s[0], s[1]), pack2(s[2], s[3])}; } } }
        } else if (nb < 2176) {
            const bool isq = nb < 2048; const float* nwp = isq ? qnw : knw;
#pragma unroll
            for (int mi = 0; mi < 4; ++mi) { const int R = Rb + mi * 16 + lr; const int b = R / PP, pi = R - b * PP;
                float ss = 0.f;
#pragma unroll
                for (int ni = 0; ni < 4; ++ni)
#pragma unroll
                    for (int e = 0; e < 4; ++e) ss += acc[mi][ni][e] * acc[mi][ni][e];
                ss += __shfl_xor(ss, 16); ss += __shfl_xor(ss, 32);
                const float rstd = rsqrtf(ss * (1.f / 64.f) + EPS);
                f32x4 y[4];
#pragma unroll
                for (int ni = 0; ni < 4; ++ni) { const f32x4 w4 = *(const f32x4*)(nwp + ni * 16 + lq * 4); y[ni] = acc[mi][ni] * rstd * w4; }
                if (pi >= 256) { const int t = pi - 256, prow = t >> 6, pcol = t & 63;
#pragma unroll
                    for (int e = 0; e < 4; ++e) { const int i = lq * 4 + e; const float2 cr = rope[prow * 16 + i], cc = rope[pcol * 16 + i];
                        const float a1 = y[0][e], a2 = y[1][e]; y[0][e] = a1 * cr.x - a2 * cr.y; y[1][e] = a2 * cr.x + a1 * cr.y;
                        const float b1 = y[2][e], b2 = y[3][e]; y[2][e] = b1 * cc.x - b2 * cc.y; y[3][e] = b2 * cc.x + b1 * cc.y; } }
                if (isq) {
#pragma unroll
                    for (int ni = 0; ni < 4; ++ni) { const f32x4 v = y[ni] * (0.125f * LOG2E); *(u32x2*)(Qg + (size_t)R * 512 + (nb - 1536) + ni * 16 + lq * 4) = (u32x2){pack2(v[0], v[1]), pack2(v[2], v[3])}; }
                } else {
#pragma unroll
                    for (int ni = 0; ni < 4; ++ni) { const f32x4 v = y[ni]; *(u32x2*)(Kg + (size_t)R * 128 + (nb - 2048) + ni * 16 + lq * 4) = (u32x2){pack2(v[0], v[1]), pack2(v[2], v[3])}; }
                } }
        } else if (nb < 2304) {
            const int kvh = (nb - 2176) >> 6;
#pragma unroll
            for (int mi = 0; mi < 4; ++mi) { const int R = Rb + mi * 16 + lr; const int b = R / PP, pi = R - b * PP;
#pragma unroll
                for (int ni = 0; ni < 4; ++ni) { bf16_t* vp = VTg + ((size_t)((b * 2 + kvh) * 64 + ni * 16 + lq * 4)) * PP + pi;
#pragma unroll
                    for (int e = 0; e < 4; ++e) vp[(size_t)e * PP] = (bf16_t)f2bf(acc[mi][ni][e]); } }
        } else if (nb == 2304) {
#pragma unroll
            for (int mi = 0; mi < 4; ++mi) { const int R = Rb + mi * 16 + lr;
#pragma unroll
                for (int ni = 0; ni < 2; ++ni) *(f32x4*)(LR + (size_t)R * 32 + ni * 16 + lq * 4) = acc[mi][ni]; }
        }
    }
};

#define ATT_THR 8.0f
__device__ __forceinline__ unsigned cvt_pk_bf16(float lo, float hi) { return pack2(lo, hi); }
__device__ __forceinline__ float vmax3(float a, float b, float c) { float r; asm("v_max3_f32 %0, %1, %2, %3" : "=v"(r) : "v"(a), "v"(b), "v"(c)); return r; }
__device__ __forceinline__ float vadd(float a, float b) { return a + b; }
__device__ __forceinline__ void attn_unit(char* smem, const bf16_t* __restrict__ Qp, int ldq, const bf16_t* __restrict__ Kp, int ldk, const bf16_t* __restrict__ VTp,
                                          bf16_t* __restrict__ Op, int ldo, int ntiles, int mode, int r0, int rs0, const float* __restrict__ rpb_h) {
    bf16_t* Ks = (bf16_t*)smem;
    bf16_t* Vs = Ks + 2 * 64 * 72;
    float* rp = (float*)(Vs + 2 * 64 * 72);
    const int tid = threadIdx.x, lane = tid & 63, w = tid >> 6, l31 = lane & 31, lh = lane >> 5;
    if (mode == 1) { for (int i = tid; i < 465; i += 512) rp[i] = rpb_h[i] * LOG2E; }
    bf16x8 qf[4];
    { const bf16_t* q = Qp + (size_t)(w * 32 + l31) * ldq + lh * 8;
#pragma unroll
        for (int ks = 0; ks < 4; ++ks) qf[ks] = *(const bf16x8*)(q + ks * 16); }
    f32x16 ot[2], negm;
#pragma unroll
    for (int i = 0; i < 16; ++i) { ot[0][i] = 0.f; ot[1][i] = 0.f; negm[i] = 0.f; }
    float l = 0.f;
    u32x4 rk, rv;
    const int sr = tid >> 3, scc = (tid & 7) * 8;
#define ATT_GLOAD(t_) do { const int t__ = (t_); const int pos__ = (mode == 1) ? (t__ < 4 ? t__ * 64 : 256 + (rs0 + t__ - 4) * 64) : t__ * 64; \
        rk = *(const u32x4*)(Kp + (size_t)(pos__ + sr) * ldk + scc); rv = *(const u32x4*)(VTp + (size_t)sr * PP + pos__ + scc); } while (0)
#define ATT_SSTORE(buf_) do { *(u32x4*)(Ks + (buf_) * 64 * 72 + sr * 72 + scc) = rk; *(u32x4*)(Vs + (buf_) * 64 * 72 + sr * 72 + scc) = rv; } while (0)
    ATT_GLOAD(0); ATT_SSTORE(0); __syncthreads();
    for (int t = 0; t < ntiles; ++t) {
        if (t + 1 < ntiles) ATT_GLOAD(t + 1);
        const bf16_t* ks_ = Ks + (t & 1) * 64 * 72; const bf16_t* vs_ = Vs + (t & 1) * 64 * 72;
        bool skip = false; int kr = 0, rq = 0;
        const bool local = (mode == 1) && (t >= 4);
        if (local) { kr = rs0 + t - 4; rq = r0 + (w >> 1); const int rsq = clampi(rq - 4, 0, 120); skip = (kr < rsq) || (kr >= rsq + 8); }
        if (!skip) {
            f32x16 st[2];
#pragma unroll
            for (int kt = 0; kt < 2; ++kt) {
                const bf16x8 kf0 = *(const bf16x8*)(ks_ + (kt * 32 + l31) * 72 + lh * 8);
                st[kt] = __builtin_amdgcn_mfma_f32_32x32x16_bf16(kf0, qf[0], negm, 0, 0, 0);
#pragma unroll
                for (int ks = 1; ks < 4; ++ks) { const bf16x8 kf = *(const bf16x8*)(ks_ + (kt * 32 + l31) * 72 + ks * 16 + lh * 8); st[kt] = __builtin_amdgcn_mfma_f32_32x32x16_bf16(kf, qf[ks], st[kt], 0, 0, 0); }
            }
            asm volatile("s_nop 11" : "+v"(st[0]), "+v"(st[1]));
            if (local) { const int qc = (w & 1) * 32 + l31, cs = clampi(qc - 8, 0, 48); const float* rrow = rp + (kr - rq + 7) * 31;
#pragma unroll
                for (int kt = 0; kt < 2; ++kt)
#pragma unroll
                    for (int i = 0; i < 16; ++i) { const int kc = kt * 32 + (i & 3) + 8 * (i >> 2) + 4 * lh; const bool ok = (kc >= cs) && (kc < cs + 16);
                        const float bias = rrow[clampi(kc - qc + 15, 0, 30)]; st[kt][i] = ok ? st[kt][i] + bias : -1e30f; } }
            float mx = vmax3(st[0][0], st[0][1], st[0][2]);
#pragma unroll
            for (int i = 3; i < 15; i += 2) mx = vmax3(mx, st[0][i], st[0][i + 1]);
            mx = vmax3(mx, st[0][15], st[1][0]);
#pragma unroll
            for (int i = 1; i < 15; i += 2) mx = vmax3(mx, st[1][i], st[1][i + 1]);
            mx = fmaxf(mx, st[1][15]);
            mx = fmaxf(mx, __shfl_xor(mx, 32));
            if (t == 0 || __any(mx > ATT_THR)) {
                const float adj = (t == 0) ? mx : fmaxf(mx, 0.f);
                const float sc = __builtin_amdgcn_exp2f(-adj);
                l *= sc;
#pragma unroll
                for (int i = 0; i < 16; ++i) { ot[0][i] *= sc; ot[1][i] *= sc; st[0][i] -= adj; st[1][i] -= adj; }
                const float nm = negm[0] - adj;
#pragma unroll
                for (int i = 0; i < 16; ++i) negm[i] = nm;
            }
            float ps0 = 0.f, ps1 = 0.f;
#pragma unroll
            for (int i = 0; i < 16; ++i) { st[0][i] = __builtin_amdgcn_exp2f(st[0][i]); st[1][i] = __builtin_amdgcn_exp2f(st[1][i]); ps0 = vadd(ps0, st[0][i]); ps1 = vadd(ps1, st[1][i]); }
            l += ps0 + ps1;
#pragma unroll
            for (int kt = 0; kt < 2; ++kt)
#pragma unroll
                for (int s = 0; s < 2; ++s) {
                    u32x4 pw; pw[0] = cvt_pk_bf16(st[kt][8 * s + 0], st[kt][8 * s + 1]); pw[1] = cvt_pk_bf16(st[kt][8 * s + 2], st[kt][8 * s + 3]); pw[2] = cvt_pk_bf16(st[kt][8 * s + 4], st[kt][8 * s + 5]); pw[3] = cvt_pk_bf16(st[kt][8 * s + 6], st[kt][8 * s + 7]);
                    const bf16x8 pf = __builtin_bit_cast(bf16x8, pw);
#pragma unroll
                    for (int dt = 0; dt < 2; ++dt) { const bf16_t* vp = vs_ + (dt * 32 + l31) * 72 + kt * 32 + s * 16 + lh * 4;
                        const u32x2 v0 = *(const u32x2*)vp, v1 = *(const u32x2*)(vp + 8); const u32x4 vw = (u32x4){v0[0], v0[1], v1[0], v1[1]};
                        ot[dt] = __builtin_amdgcn_mfma_f32_32x32x16_bf16(__builtin_bit_cast(bf16x8, vw), pf, ot[dt], 0, 0, 0); } }
        }
        if (t + 1 < ntiles) ATT_SSTORE((t + 1) & 1);
        __syncthreads();
    }
#undef ATT_GLOAD
#undef ATT_SSTORE
    l += __shfl_xor(l, 32);
    const float inv = 1.f / l;
    bf16_t* o = Op + (size_t)(w * 32 + l31) * ldo;
#pragma unroll
    for (int dt = 0; dt < 2; ++dt)
#pragma unroll
        for (int g = 0; g < 4; ++g) { const int d = dt * 32 + 8 * g + 4 * lh;
            *(u32x2*)(o + d) = (u32x2){cvt_pk_bf16(ot[dt][4 * g] * inv, ot[dt][4 * g + 1] * inv), cvt_pk_bf16(ot[dt][4 * g + 2] * inv, ot[dt][4 * g + 3] * inv)}; }
}

__device__ __forceinline__ void phase_na(const Params& p, char* smem) {
    unsigned char* ws = p.ws;
    const bf16_t* Qn = (const bf16_t*)(ws + R0_Q); const bf16_t* Kn = (const bf16_t*)(ws + R0_K); const bf16_t* VTn = (const bf16_t*)(ws + R0_VT);
    bf16_t* MO = (bf16_t*)(ws + WS_U);
    for (int u = blockIdx.x; u < 512 + 16; u += gridDim.x) {
        if (u < 512) { const int b = u >> 8, h = (u >> 5) & 7, qb = u & 31; const int r0 = qb * 4;
            const int rs0 = clampi(r0 - 4, 0, 120), rsl = clampi(r0 - 1, 0, 120); const int nl = rsl + 8 - rs0;
            const size_t Rq = (size_t)b * PP + 256 + qb * 256;
            attn_unit(smem, Qn + Rq * 512 + h * 64, 512, Kn + (size_t)b * PP * 512 + h * 64, 512, VTn + (size_t)((b * 8 + h) * 64) * PP, MO + Rq * 1024 + h * 64, 1024, 4 + nl, 1, r0, rs0, p.na_rpb + h * 465);
        } else { const int v = u - 512; const int b = v >> 3, h = v & 7;
            const size_t Rq = (size_t)b * PP;
            attn_unit(smem, Qn + Rq * 512 + h * 64, 512, Kn + (size_t)b * PP * 512 + h * 64, 512, VTn + (size_t)((b * 8 + h) * 64) * PP, MO + Rq * 1024 + h * 64, 1024, 4, 0, 0, 0, nullptr);
        }
    }
    const bf16_t* XL = (const bf16_t*)(ws + R0_XL); bf16_t* XC = (bf16_t*)(ws + R0_XC);
    const int gt = VB * 256 + VT, gn = NVB * 256;
    for (int idx = gt; idx < NR * 64; idx += gn) {
        const int R = idx >> 6, c8 = (idx & 63) * 8; const int b = R / PP, pi = R - b * PP; const int lo = pi < 256 ? 0 : 256, hi = pi < 256 ? 256 : PP;
        float a[8];
        { const f32x4 b0 = *(const f32x4*)(p.lru_conv_b + c8), b1 = *(const f32x4*)(p.lru_conv_b + c8 + 4); a[0] = b0[0]; a[1] = b0[1]; a[2] = b0[2]; a[3] = b0[3]; a[4] = b1[0]; a[5] = b1[1]; a[6] = b1[2]; a[7] = b1[3]; }
#pragma unroll
        for (int j = 0; j < 4; ++j) { const int pj = pi + j - 2;
            if (pj >= lo && pj < hi) { const u32x4 xv = *(const u32x4*)(XL + (size_t)(b * PP + pj) * 512 + c8);
                const f32x4 w0 = *(const f32x4*)(p.lru_conv_w + j * 512 + c8), w1 = *(const f32x4*)(p.lru_conv_w + j * 512 + c8 + 4);
                a[0] += w0[0] * bflo(xv[0]); a[1] += w0[1] * bfhi(xv[0]); a[2] += w0[2] * bflo(xv[1]); a[3] += w0[3] * bfhi(xv[1]);
                a[4] += w1[0] * bflo(xv[2]); a[5] += w1[1] * bfhi(xv[2]); a[6] += w1[2] * bflo(xv[3]); a[7] += w1[3] * bfhi(xv[3]); } }
        *(u32x4*)(XC + (size_t)R * 512 + c8) = (u32x4){pack2(a[0], a[1]), pack2(a[2], a[3]), pack2(a[4], a[5]), pack2(a[6], a[7])};
    }
}

__device__ __forceinline__ void phase_scan1(const Params& p) {
    const __half2* AB = (const __half2*)(p.ws + R0_AB); float2* SUM = (float2*)(p.ws + R0_SUM);
    for (int it = VB; it < 1056; it += NVB) {
        const int cgp = it & 1, tc = (it >> 1) % 132, db = (it >> 1) / 132, b = db & 1, d = db >> 1;
        const int c = cgp * 256 + VT;
        const __half2* ab = AB + ((size_t)d * NR + (size_t)b * PP + tc * 64) * 512 + c;
        float h = 0.f, ap = 0.f;
#pragma unroll 8
        for (int s = 0; s < 64; ++s) { const int tt = d ? 63 - s : s; const __half2 v = ab[(size_t)tt * 512]; const float la = __low2float(v), bb = __high2float(v); h = __expf(la) * h + bb; ap += la; }
        SUM[((size_t)(d * 2 + b) * 132 + tc) * 512 + c] = make_float2(__expf(ap), h);
    }
}
__device__ __forceinline__ void phase_scan2(const Params& p) {
    const __half2* AB = (const __half2*)(p.ws + R0_AB); const float2* SUM = (const float2*)(p.ws + R0_SUM);
    const bf16_t* GG = (const bf16_t*)(p.ws + R0_GG); bf16_t* MO = (bf16_t*)(p.ws + WS_U);
    for (int it = VB; it < 528; it += NVB) {
        const int cgp = it & 1, tc = (it >> 1) % 132, b = (it >> 1) / 132;
        const int c = cgp * 256 + VT; const size_t R0 = (size_t)b * PP + tc * 64;
        float hf[64];
        {
            float h = 0.f; const float2* sm = SUM + ((size_t)(0 * 2 + b) * 132) * 512 + c;
#pragma unroll 8
            for (int jj = 0; jj < tc; ++jj) { const float2 s = sm[(size_t)jj * 512]; h = s.x * h + s.y; }
            const __half2* ab = AB + ((size_t)0 * NR + R0) * 512 + c;
#pragma unroll
            for (int s = 0; s < 64; ++s) { const __half2 v = ab[(size_t)s * 512]; h = __expf(__low2float(v)) * h + __high2float(v); hf[s] = h; }
        }
        {
            const int j = tc < 4 ? 3 - tc : 135 - tc;
            float h = 0.f; const float2* sm = SUM + ((size_t)(1 * 2 + b) * 132) * 512 + c;
#pragma unroll 8
            for (int jj = 0; jj < j; ++jj) { const int tcj = jj < 4 ? 3 - jj : 135 - jj; const float2 s = sm[(size_t)tcj * 512]; h = s.x * h + s.y; }
            const __half2* ab = AB + ((size_t)1 * NR + R0) * 512 + c;
#pragma unroll
            for (int s = 0; s < 64; ++s) { const int tt = 63 - s; const __half2 v = ab[(size_t)tt * 512]; h = __expf(__low2float(v)) * h + __high2float(v);
                const float g = bf2f(GG[(R0 + tt) * 512 + c]);
                MO[(R0 + tt) * 1024 + 512 + c] = (bf16_t)f2bf((hf[tt] + h) * g); }
        }
    }
}

__device__ __forceinline__ void gla_gates(const Params& p, float* gs, float* part, const float* __restrict__ LR, size_t R0, int d, int h) {
    const int tid = VT, dk = tid & 63, tg = tid >> 6;
    float wv[16];
#pragma unroll
    for (int r = 0; r < 16; ++r) wv[r] = p.gla_wa2[(d * 16 + r) * 256 + h * 64 + dk];
    const float bav = p.gla_ba[d * 256 + h * 64 + dk];
    float run = 0.f;
    for (int ti = 0; ti < 16; ++ti) { const int t = tg * 16 + (d ? 15 - ti : ti); const float* lrp = LR + (R0 + t) * 32 + d * 16; float z = bav;
#pragma unroll
        for (int r = 0; r < 16; ++r) z += lrp[r] * wv[r];
        const float ls = fminf(z, 0.f) - __logf(1.f + __expf(-fabsf(z))); run += ls * (1.f / 16.f); gs[t * 64 + dk] = run; }
    part[tg * 64 + dk] = run;
    __syncthreads();
    float off = 0.f;
#pragma unroll
    for (int g = 0; g < 4; ++g) { const float pv = part[g * 64 + dk]; off += (d == 0 ? (g < tg) : (g > tg)) ? pv : 0.f; }
#pragma unroll
    for (int ti = 0; ti < 16; ++ti) gs[(tg * 16 + ti) * 64 + dk] += off;
    __syncthreads();
}
__device__ __forceinline__ void gla_load_vt(bf16_t* VTs, const bf16_t* __restrict__ Gv, size_t R0, int h) {
    const int tid = VT, t = tid >> 2, vq = (tid & 3) * 32; const bf16_t* src = Gv + (R0 + t) * 512 + h * 128 + vq;
#pragma unroll
    for (int q = 0; q < 4; ++q) { const u32x4 v = *(const u32x4*)(src + q * 8);
#pragma unroll
        for (int e = 0; e < 4; ++e) { VTs[(vq + q * 8 + 2 * e) * 72 + t] = (bf16_t)(v[e] & 0xffffu); VTs[(vq + q * 8 + 2 * e + 1) * 72 + t] = (bf16_t)(v[e] >> 16); } }
}
__device__ __forceinline__ void phase_gla1(const Params& p, char* smem) {
    unsigned char* ws = p.ws;
    const bf16_t* Gk = (const bf16_t*)(ws + R1_GK); const bf16_t* Gv = (const bf16_t*)(ws + R1_GV); const float* LR = (const float*)(ws + R1_LR);
    float* UC = (float*)(ws + R1_UC); float* DEC = (float*)(ws + R1_DEC);
    float* gs = (float*)smem; bf16_t* KD = (bf16_t*)(smem + 16384); bf16_t* VTs = KD + 64 * 72; float* part = (float*)(smem + 71680);
    const int tid = VT, lane = tid & 63, w = tid >> 6, lr = lane & 15, lq = lane >> 4;
    for (int it = VB; it < 2112; it += NVB) {
        const int tc = it % 132, h = (it / 132) & 3, d = (it / 528) & 1, b = it / 1056;
        const size_t R0 = (size_t)b * PP + tc * 64;
        __syncthreads();
        gla_gates(p, gs, part, LR, R0, d, h);
        const int tl = d ? 0 : 63;
        { const int t = tid >> 2, dq = (tid & 3) * 16; const bf16_t* src = Gk + (R0 + t) * 256 + h * 64 + dq;
#pragma unroll
            for (int q = 0; q < 2; ++q) { const u32x4 v = *(const u32x4*)(src + q * 8);
#pragma unroll
                for (int e = 0; e < 4; ++e) { const int dk0 = dq + q * 8 + 2 * e;
                    const float k0 = bflo(v[e]) * __expf(gs[tl * 64 + dk0] - gs[t * 64 + dk0]); const float k1 = bfhi(v[e]) * __expf(gs[tl * 64 + dk0 + 1] - gs[t * 64 + dk0 + 1]);
                    KD[dk0 * 72 + t] = (bf16_t)f2bf(k0); KD[(dk0 + 1) * 72 + t] = (bf16_t)f2bf(k1); } } }
        gla_load_vt(VTs, Gv, R0, h);
        __syncthreads();
        f32x4 acc[8];
#pragma unroll
        for (int i = 0; i < 8; ++i) acc[i] = (f32x4){0.f, 0.f, 0.f, 0.f};
#pragma unroll
        for (int ks = 0; ks < 2; ++ks) { const bf16x8 a = *(const bf16x8*)(KD + (16 * w + lr) * 72 + ks * 32 + lq * 8);
#pragma unroll
            for (int nt = 0; nt < 8; ++nt) { const bf16x8 bb = *(const bf16x8*)(VTs + (16 * nt + lr) * 72 + ks * 32 + lq * 8); acc[nt] = __builtin_amdgcn_mfma_f32_16x16x32_bf16(a, bb, acc[nt], 0, 0, 0); } }
        const int j = d == 0 ? tc : (tc < 4 ? 3 - tc : 135 - tc);
        const size_t chain = (size_t)((b * 2 + d) * 4 + h);
        float* up = UC + (chain * 132 + j) * 8192;
#pragma unroll
        for (int nt = 0; nt < 8; ++nt)
#pragma unroll
            for (int e = 0; e < 4; ++e) up[(16 * w + 4 * lq + e) * 128 + 16 * nt + lr] = acc[nt][e];
        if (tid < 64) DEC[(chain * 132 + j) * 64 + tid] = __expf(gs[tl * 64 + tid]);
    }
}
__device__ __forceinline__ void phase_gla2(const Params& p) {
    float* UC = (float*)(p.ws + R1_UC); const float* DEC = (const float*)(p.ws + R1_DEC);
    const int gt = VB * 256 + VT, gn = NVB * 256;
    for (int e = gt; e < 16 * 8192; e += gn) { const int chain = e >> 13, el = e & 8191, dk = el >> 7;
        float* u = UC + (size_t)chain * 132 * 8192 + el; const float* dec = DEC + (size_t)chain * 132 * 64 + dk; float S = 0.f;
#pragma unroll 4
        for (int j = 0; j < 132; ++j) { const float uv = u[(size_t)j * 8192]; const float dv = dec[j * 64]; u[(size_t)j * 8192] = S; S = dv * S + uv; } }
}
__device__ __forceinline__ void phase_gla3(const Params& p, char* smem) {
    unsigned char* ws = p.ws;
    const bf16_t* Gq = (const bf16_t*)(ws + R1_GQ); const bf16_t* Gk = (const bf16_t*)(ws + R1_GK); const bf16_t* Gv = (const bf16_t*)(ws + R1_GV); const bf16_t* Gg = (const bf16_t*)(ws + R1_GG);
    const float* LR = (const float*)(ws + R1_LR); const float* UC = (const float*)(ws + R1_UC); bf16_t* MO = (bf16_t*)(ws + WS_U);
    float* gs = (float*)smem; bf16_t* ATT = (bf16_t*)smem; bf16_t* QI = (bf16_t*)(smem + 16384); bf16_t* KI = QI + 64 * 72; bf16_t* VTs = KI + 64 * 72; bf16_t* SPT = VTs + 128 * 72; float* part = (float*)(smem + 71680);
    const int tid = VT, lane = tid & 63, w = tid >> 6, lr = lane & 15, lq = lane >> 4;
    for (int it = VB; it < 1024; it += NVB) {
        const int tcl = it & 127, h = (it >> 7) & 3, b = it >> 9; const int tc = 4 + tcl;
        const size_t R0 = (size_t)b * PP + tc * 64;
        __syncthreads();
        gla_load_vt(VTs, Gv, R0, h);
        f32x4 acc[8];
#pragma unroll
        for (int i = 0; i < 8; ++i) acc[i] = (f32x4){0.f, 0.f, 0.f, 0.f};
        for (int d = 0; d < 2; ++d) {
            const int j = d == 0 ? tc : 135 - tc; const size_t chain = (size_t)((b * 2 + d) * 4 + h);
            __syncthreads();
            gla_gates(p, gs, part, LR, R0, d, h);
            { const int t = tid >> 2, dq = (tid & 3) * 16; const bf16_t* qs = Gq + (R0 + t) * 256 + h * 64 + dq; const bf16_t* ksrc = Gk + (R0 + t) * 256 + h * 64 + dq;
#pragma unroll
                for (int q = 0; q < 2; ++q) { const u32x4 qv = *(const u32x4*)(qs + q * 8), kv = *(const u32x4*)(ksrc + q * 8); u32x4 qo, ko;
#pragma unroll
                    for (int e = 0; e < 4; ++e) { const int dk0 = dq + q * 8 + 2 * e; const float g0 = gs[t * 64 + dk0], g1 = gs[t * 64 + dk0 + 1];
                        const float e0 = __expf(g0), e1 = __expf(g1);
                        qo[e] = pack2(bflo(qv[e]) * 0.125f * e0, bfhi(qv[e]) * 0.125f * e1); ko[e] = pack2(bflo(kv[e]) / e0, bfhi(kv[e]) / e1); }
                    *(u32x4*)(QI + t * 72 + dq + q * 8) = qo; *(u32x4*)(KI + t * 72 + dq + q * 8) = ko; } }
            { const int dk = tid >> 2, vq = (tid & 3) * 32; const float* sp = UC + (chain * 132 + j) * 8192 + dk * 128 + vq;
#pragma unroll
                for (int q = 0; q < 8; ++q) { const f32x4 v = *(const f32x4*)(sp + q * 4);
#pragma unroll
                    for (int e = 0; e < 4; ++e) SPT[(vq + q * 4 + e) * 72 + dk] = (bf16_t)f2bf(v[e]); } }
            __syncthreads();
            f32x4 at[4];
#pragma unroll
            for (int i = 0; i < 4; ++i) at[i] = (f32x4){0.f, 0.f, 0.f, 0.f};
#pragma unroll
            for (int ks = 0; ks < 2; ++ks) { const bf16x8 a = *(const bf16x8*)(QI + (16 * w + lr) * 72 + ks * 32 + lq * 8);
#pragma unroll
                for (int nt = 0; nt < 4; ++nt) { const bf16x8 bb = *(const bf16x8*)(KI + (16 * nt + lr) * 72 + ks * 32 + lq * 8); at[nt] = __builtin_amdgcn_mfma_f32_16x16x32_bf16(a, bb, at[nt], 0, 0, 0); } }
#pragma unroll
            for (int nt = 0; nt < 4; ++nt)
#pragma unroll
                for (int e = 0; e < 4; ++e) { const int t = 16 * w + 4 * lq + e, s = 16 * nt + lr; const bool keep = d == 0 ? (s <= t) : (s >= t); ATT[t * 72 + s] = (bf16_t)f2bf(keep ? at[nt][e] : 0.f); }
            __syncthreads();
#pragma unroll
            for (int ks = 0; ks < 2; ++ks) { const bf16x8 a1 = *(const bf16x8*)(ATT + (16 * w + lr) * 72 + ks * 32 + lq * 8); const bf16x8 a2 = *(const bf16x8*)(QI + (16 * w + lr) * 72 + ks * 32 + lq * 8);
#pragma unroll
                for (int nt = 0; nt < 8; ++nt) { const bf16x8 b1 = *(const bf16x8*)(VTs + (16 * nt + lr) * 72 + ks * 32 + lq * 8); const bf16x8 b2 = *(const bf16x8*)(SPT + (16 * nt + lr) * 72 + ks * 32 + lq * 8);
                    acc[nt] = __builtin_amdgcn_mfma_f32_16x16x32_bf16(a1, b1, acc[nt], 0, 0, 0); acc[nt] = __builtin_amdgcn_mfma_f32_16x16x32_bf16(a2, b2, acc[nt], 0, 0, 0); } }
        }
#pragma unroll
        for (int e = 0; e < 4; ++e) { float ss = 0.f;
#pragma unroll
            for (int nt = 0; nt < 8; ++nt) ss += acc[nt][e] * acc[nt][e];
            ss += __shfl_xor(ss, 1); ss += __shfl_xor(ss, 2); ss += __shfl_xor(ss, 4); ss += __shfl_xor(ss, 8);
            const float rstd = rsqrtf(ss * (1.f / 128.f) + EPS); const size_t R = R0 + 16 * w + 4 * lq + e;
#pragma unroll
            for (int nt = 0; nt < 8; ++nt) { const int v = 16 * nt + lr; const float y = acc[nt][e] * rstd * p.gla_norm_w[v] * bf2f(Gg[R * 512 + h * 128 + v]); MO[R * 1024 + h * 128 + v] = (bf16_t)f2bf(y); } }
    }
}
__device__ __forceinline__ void phase_gqa(const Params& p, char* smem) {
    unsigned char* ws = p.ws;
    const bf16_t* Qg = (const bf16_t*)(ws + R1_QG); const bf16_t* Kg = (const bf16_t*)(ws + R1_KG); const bf16_t* VTg = (const bf16_t*)(ws + R1_VTG); bf16_t* MO = (bf16_t*)(ws + WS_U);
    for (int u = blockIdx.x; u < 512; u += gridDim.x) { const int b = u >> 8, hq = (u >> 5) & 7, qb = u & 31, kvh = hq >> 2;
        const size_t Rq = (size_t)b * PP + 256 + qb * 256;
        attn_unit(smem, Qg + Rq * 512 + hq * 64, 512, Kg + (size_t)b * PP * 128 + kvh * 64, 128, VTg + (size_t)((b * 2 + kvh) * 64) * PP, MO + Rq * 1024 + 512 + hq * 64, 1024, 132, 0, 0, 0, nullptr); }
}

#define XB_TMO      128
#define XB_XCNT(j)  (256  + 64 * (j))
#define XB_XSUB(j)  (1280 + 64 * (j))
#define XB_XGEN(j)  (2304 + 64 * (j))
#define XB_TOP      3328
#define XB_TOPGEN   3392
#define XCD_BAR_WORDS 3456
#define XB_SPIN_CAP (1u << 20)
#define LAS __attribute__((address_space(3)))
__device__ __forceinline__ unsigned xb_ld(unsigned* p)              { return __hip_atomic_load(p, __ATOMIC_RELAXED, __HIP_MEMORY_SCOPE_AGENT); }
__device__ __forceinline__ unsigned xb_add(unsigned* p, unsigned v) { return __hip_atomic_fetch_add(p, v, __ATOMIC_RELAXED, __HIP_MEMORY_SCOPE_AGENT); }
__device__ __forceinline__ unsigned xb_xcc_id() { return (unsigned)__builtin_amdgcn_s_getreg((3 << 11) | 20) & 0xFu; }
#define XB_SPIN(cond, bar) do { unsigned _sp = 0; while (cond) { __builtin_amdgcn_s_sleep(1); \
    if ((++_sp & 255u) == 0u) { if (xb_ld(&(bar)[XB_TMO])) break; if (_sp > XB_SPIN_CAP) { atomicAdd(&(bar)[XB_TMO], 1u); break; } } } } while (0)
struct XcdBarrier { unsigned* bar; unsigned x; volatile LAS unsigned* st; };
__device__ __forceinline__ XcdBarrier xcd_barrier_post(unsigned* bar, volatile LAS unsigned* st) {
    XcdBarrier b; b.bar = bar; b.x = xb_xcc_id(); b.st = st;
    if (threadIdx.x == 0) (void)xb_add(&bar[XB_XCNT(b.x)], 1u);
    return b;
}
__device__ __forceinline__ void xcd_barrier_complete(unsigned* bar, unsigned x, unsigned& nloc, unsigned& nx) {
    const unsigned G = gridDim.x * gridDim.y * gridDim.z;
    unsigned sum, cnt, mine, sp = 0u;
    for (;;) {
        sum = 0u; cnt = 0u; mine = 0u;
#pragma unroll
        for (unsigned j = 0; j < 16; ++j) { const unsigned c = xb_ld(&bar[XB_XCNT(j)]); sum += c; cnt += (c > 0u) ? 1u : 0u; mine = (j == x) ? c : mine; }
        if (sum == G) break;
        __builtin_amdgcn_s_sleep(1);
        if ((++sp & 255u) == 0u) { if (xb_ld(&bar[XB_TMO])) break; if (sp > XB_SPIN_CAP) { atomicAdd(&bar[XB_TMO], 1u); break; } }
    }
    nloc = mine > 0u ? mine : 1u; nx = cnt > 0u ? cnt : 1u;
}
__device__ __forceinline__ void xcd_barrier(const XcdBarrier& b) {
    asm volatile("s_waitcnt vmcnt(0)" ::: "memory");
    __syncthreads();
    if (threadIdx.x == 0) {
        unsigned* bar = b.bar;
        __builtin_amdgcn_s_waitcnt(0);
        unsigned nloc = b.st[0], nx = b.st[1];
        if (nloc == 0u) { xcd_barrier_complete(bar, b.x, nloc, nx); b.st[0] = nloc; b.st[1] = nx; }
        const unsigned old = xb_add(&bar[XB_XSUB(b.x)], 1u);
        const unsigned gen = old / nloc;
        if (old + 1u == (gen + 1u) * nloc) {
            __builtin_amdgcn_fence(__ATOMIC_RELEASE, "agent");
            asm volatile("s_waitcnt vmcnt(0)" ::: "memory");
            const unsigned og = xb_add(&bar[XB_TOP], 1u);
            const unsigned tg = og / nx;
            if (og + 1u == (tg + 1u) * nx) xb_add(&bar[XB_TOPGEN], 1u);
            else XB_SPIN(xb_ld(&bar[XB_TOPGEN]) == tg, bar);
            __builtin_amdgcn_fence(__ATOMIC_ACQUIRE, "agent");
            xb_add(&bar[XB_XGEN(b.x)], 1u);
            asm volatile("s_waitcnt vmcnt(0)" ::: "memory");
        } else {
            XB_SPIN(xb_ld(&bar[XB_XGEN(b.x)]) == gen, bar);
            __builtin_amdgcn_fence(__ATOMIC_ACQUIRE, "agent");
            asm volatile("s_waitcnt vmcnt(0)" ::: "memory");
        }
    }
    __syncthreads();
}


namespace pg8 {
#define PG8_LAS __attribute__((address_space(3)))
typedef unsigned short bf16_t;
typedef short bf16x8 __attribute__((ext_vector_type(8)));
typedef float f32x4 __attribute__((ext_vector_type(4)));
typedef unsigned u32x4 __attribute__((ext_vector_type(4)));
constexpr int BM = 256, BK = 64, HALF = 128, HTB = HALF * BK * 2  , STAGE_BYTES = 8 * HTB, NXCD = 8, WGM = 8;

__host__ __device__ __forceinline__ int lds_byte(int r, int c) { const int st = (r >> 4) * 2 + (c >> 5), rr = r & 15, cc = c & 31, ob = rr * 64 + cc * 2; return st * 1024 + (ob ^ (((ob >> 9) & 1) << 5)); }
__host__ __device__ __forceinline__ void stage_rc(int b, int& R, int& C) { const int st = b / 1024, sb = b % 1024, swz = sb ^ (((sb >> 9) & 1) << 5); R = (st >> 1) * 16 + swz / 64; C = (st & 1) * 32 + (swz % 64) / 2; }
__host__ __device__ __forceinline__ int perm32(int rho) { const int n = rho >> 4, i = rho & 15; return 8 * (i >> 2) + 4 * n + (i & 3); }

struct Unit { int pm, pn; };
struct Gemm { const bf16_t* A; const bf16_t* Bt; int M, N, K; };

struct StaticOrder {
    int nM, nN, nwg, G, c;
    __host__ __device__ void init(int M, int N, int G_, int c_) { nM = M / BM; nN = N / BM; nwg = nM * nN; G = G_; c = c_; }
    __host__ __device__ bool next(int i, Unit& u) const {
        const long L = (long)i * G + c; if (L >= nwg) return false;
        int wgid = (int)L; { const int q = nwg / NXCD, r = nwg % NXCD, xcd = wgid % NXCD, off = wgid / NXCD; wgid = (xcd < r ? xcd * (q + 1) : r * (q + 1) + (xcd - r) * q) + off; }
        const int nig = WGM * nN, gid = wgid / nig, fm = gid * WGM, gsz = (nM - fm) < WGM ? (nM - fm) : WGM;
        u.pm = fm + ((wgid % nig) % gsz); u.pn = (wgid % nig) / gsz; return true;
    }
    __device__ __forceinline__ void a_ready(const Unit&) const {}
    __device__ __forceinline__ void done(const Unit&) const {}
};
template <class Epi, class Sched, bool ALIGN_EPI = false, bool SP2 = false>
__device__ __forceinline__ void gemm_phase(PG8_LAS unsigned char* lds, const Gemm g, const Sched& S, const Epi& E) {
    const int tid = threadIdx.x, wid = __builtin_amdgcn_readfirstlane(tid >> 6), lane = tid & 63, wr = wid >> 2, wc = wid & 3, fr = lane & 15, fq = lane >> 4;
    const int K = g.K, nt = K / BK;
    unsigned voffA[2], voffB[2];
#pragma unroll
    for (int i = 0; i < 2; ++i) { int R, C; stage_rc(tid * 16 + i * 8192, R, C); const int Rb = Epi::PERM ? ((R & ~31) + perm32(R & 31)) : R;
        voffA[i] = (unsigned)(R * K + C) * 2u; voffB[i] = (unsigned)(Rb * K + C) * 2u; }
    const size_t kstep = (size_t)(BK * 2);
    const size_t hstep = (size_t)HALF * K * 2;
    const size_t tstep = 2 * hstep;
    const unsigned ldsw = (unsigned)wid * 1024u;
    const int aoff = lds_byte(wr * 64 + fr, fq * 8), boff = lds_byte(wc * 32 + fr, fq * 8);
#define PG8_SA(b, h) (((b) * 2 + (h)) * HTB)
#define PG8_SB(b, h) ((4 + (b) * 2 + (h)) * HTB)
#define PG8_STAGE(bufoff, gbase, voff) do { _Pragma("unroll") for (int _i = 0; _i < 2; ++_i) \
        __builtin_amdgcn_global_load_lds((const unsigned*)((const char*)(gbase) + (voff)[_i]), (PG8_LAS unsigned*)(lds + (bufoff) + ldsw + _i * 8192), 16, 0, 0); } while (0)
#define PG8_LDA(dst, b, h) do { _Pragma("unroll") for (int m = 0; m < 4; ++m) _Pragma("unroll") for (int k = 0; k < 2; ++k) dst[m][k] = *(const PG8_LAS bf16x8*)(lds + PG8_SA(b, h) + aoff + m * 2048 + k * 1024); } while (0)
#define PG8_LDB(dst, b, h) do { _Pragma("unroll") for (int n = 0; n < 2; ++n) _Pragma("unroll") for (int k = 0; k < 2; ++k) dst[n][k] = *(const PG8_LAS bf16x8*)(lds + PG8_SB(b, h) + boff + n * 2048 + k * 1024); } while (0)
#define PG8_MMA(ai, bj, At, Bt) do { __builtin_amdgcn_s_setprio(1); _Pragma("unroll") for (int m = 0; m < 4; ++m) _Pragma("unroll") for (int n = 0; n < 2; ++n) _Pragma("unroll") for (int k = 0; k < 2; ++k) \
        acc[ai][bj][m][n] = __builtin_amdgcn_mfma_f32_16x16x32_bf16(Bt[n][k], At[m][k], acc[ai][bj][m][n], 0, 0, 0); __builtin_amdgcn_s_setprio(0); } while (0)
#define PG8_WAIT_V(n) asm volatile("s_waitcnt vmcnt(" #n ")" ::: "memory")
#define PG8_WAIT_L(n) asm volatile("s_waitcnt lgkmcnt(" #n ")" ::: "memory")
#define PG8_BAR __builtin_amdgcn_s_barrier()
#define PG8_SCHED __builtin_amdgcn_sched_barrier(0)
    Unit cur, nxt; int ui = 0;
    if (!S.next(0, cur)) return;
    f32x4 acc[2][2][4][2];
#pragma unroll
    for (int a = 0; a < 2; ++a)
#pragma unroll
        for (int b = 0; b < 2; ++b)
#pragma unroll
            for (int m = 0; m < 4; ++m)
#pragma unroll
                for (int n = 0; n < 2; ++n) acc[a][b][m][n] = (f32x4){0.f, 0.f, 0.f, 0.f};
    bf16x8 At[4][2], B0[2][2], B1[2][2];
    const char* cA = (const char*)g.A + (size_t)cur.pm * tstep; const char* cB = (const char*)g.Bt + (size_t)cur.pn * tstep;
    S.a_ready(cur);
    if constexpr (SP2) {
        PG8_STAGE(PG8_SB(0, 0), cB, voffB); PG8_STAGE(PG8_SB(0, 1), cB + hstep, voffB); PG8_STAGE(PG8_SA(0, 0), cA, voffA); PG8_STAGE(PG8_SA(0, 1), cA + hstep, voffA);
        if (wr == 1) PG8_BAR;
        PG8_WAIT_V(2); PG8_BAR;
        PG8_STAGE(PG8_SB(1, 0), cB + kstep, voffB); PG8_STAGE(PG8_SA(1, 0), cA + kstep, voffA); PG8_STAGE(PG8_SB(1, 1), cB + hstep + kstep, voffB);
        PG8_WAIT_V(6); PG8_BAR;
    } else {
        PG8_STAGE(PG8_SB(0, 0), cB, voffB); PG8_STAGE(PG8_SA(0, 0), cA, voffA); PG8_STAGE(PG8_SB(0, 1), cB + hstep, voffB); PG8_STAGE(PG8_SA(0, 1), cA + hstep, voffA);
        if (wr == 1) PG8_BAR;
        PG8_WAIT_V(4); PG8_BAR;
        PG8_STAGE(PG8_SB(1, 0), cB + kstep, voffB); PG8_STAGE(PG8_SA(1, 0), cA + kstep, voffA); PG8_STAGE(PG8_SB(1, 1), cB + hstep + kstep, voffB);
        PG8_WAIT_V(6); PG8_BAR;
    }
    for (;;) {
        const bool has_next = S.next(ui + 1, nxt);
        const char* nA = has_next ? (const char*)g.A + (size_t)nxt.pm * tstep : cA; const char* nB = has_next ? (const char*)g.Bt + (size_t)nxt.pn * tstep : cB;
        for (int t = 0; t < nt; t += 2) {
            const bool last = (t == nt - 2);
            const char* a1 = cA + (size_t)(t + 1) * kstep;
            const char* a2 = last ? nA : cA + (size_t)(t + 2) * kstep; const char* b2 = last ? nB : cB + (size_t)(t + 2) * kstep;
            const char* a3 = a2 + kstep; const char* b3 = b2 + kstep;
            if (last && has_next) S.a_ready(nxt);
            if constexpr (SP2) {
            PG8_LDB(B0, 0, 0); PG8_LDB(B1, 0, 1); PG8_SCHED; PG8_LDA(At, 0, 0); PG8_STAGE(PG8_SA(1, 1), a1 + hstep, voffA);
            PG8_WAIT_V(8); PG8_WAIT_L(0); PG8_BAR; PG8_MMA(0, 0, At, B0); PG8_MMA(0, 1, At, B1); PG8_BAR; PG8_SCHED;
            PG8_LDA(At, 0, 1); PG8_STAGE(PG8_SB(0, 0), b2, voffB); PG8_STAGE(PG8_SB(0, 1), b2 + hstep, voffB); PG8_STAGE(PG8_SA(0, 0), a2, voffA);
            PG8_WAIT_V(8); PG8_WAIT_L(0); PG8_BAR; PG8_MMA(1, 0, At, B0); PG8_MMA(1, 1, At, B1); PG8_BAR; PG8_SCHED;
            PG8_LDB(B0, 1, 0); PG8_LDB(B1, 1, 1); PG8_SCHED; PG8_LDA(At, 1, 0); PG8_STAGE(PG8_SA(0, 1), a2 + hstep, voffA);
            PG8_WAIT_V(8); PG8_WAIT_L(0); PG8_BAR; PG8_MMA(0, 0, At, B0); PG8_MMA(0, 1, At, B1); PG8_BAR; PG8_SCHED;
            PG8_LDA(At, 1, 1); PG8_STAGE(PG8_SB(1, 0), b3, voffB); PG8_STAGE(PG8_SB(1, 1), b3 + hstep, voffB); PG8_STAGE(PG8_SA(1, 0), a3, voffA);
            PG8_WAIT_V(8); PG8_WAIT_L(0); PG8_BAR; PG8_MMA(1, 0, At, B0); PG8_MMA(1, 1, At, B1); PG8_BAR; PG8_SCHED;
            } else {
            PG8_LDB(B0, 0, 0); PG8_SCHED; PG8_LDA(At, 0, 0); PG8_STAGE(PG8_SA(1, 1), a1 + hstep, voffA);
            PG8_WAIT_L(8); PG8_BAR; PG8_WAIT_L(0); PG8_MMA(0, 0, At, B0); PG8_BAR; PG8_SCHED;
            PG8_LDB(B1, 0, 1); PG8_STAGE(PG8_SB(0, 0), b2, voffB);
            PG8_BAR; PG8_WAIT_L(0); PG8_MMA(0, 1, At, B1); PG8_BAR;
            PG8_LDA(At, 0, 1); PG8_STAGE(PG8_SA(0, 0), a2, voffA);
            PG8_BAR; PG8_WAIT_L(0); PG8_MMA(1, 0, At, B0); PG8_BAR; PG8_SCHED;
            PG8_STAGE(PG8_SB(0, 1), b2 + hstep, voffB);
            PG8_WAIT_V(6); PG8_BAR; PG8_MMA(1, 1, At, B1); PG8_BAR;
            PG8_LDB(B0, 1, 0); PG8_SCHED; PG8_LDA(At, 1, 0); PG8_STAGE(PG8_SA(0, 1), a2 + hstep, voffA);
            PG8_WAIT_L(8); PG8_BAR; PG8_WAIT_L(0); PG8_MMA(0, 0, At, B0); PG8_BAR; PG8_SCHED;
            PG8_LDB(B1, 1, 1); PG8_STAGE(PG8_SB(1, 0), b3, voffB);
            PG8_BAR; PG8_WAIT_L(0); PG8_MMA(0, 1, At, B1); PG8_BAR;
            PG8_LDA(At, 1, 1); PG8_STAGE(PG8_SA(1, 0), a3, voffA);
            PG8_BAR; PG8_WAIT_L(0); PG8_MMA(1, 0, At, B0); PG8_BAR; PG8_SCHED;
            PG8_STAGE(PG8_SB(1, 1), b3 + hstep, voffB);
            PG8_WAIT_V(6); PG8_BAR; PG8_MMA(1, 1, At, B1); PG8_BAR;
            }
        }
        if constexpr (ALIGN_EPI) { if (wr == 0) PG8_BAR; }
        if constexpr (!Epi::AFTER_DRAIN) { E(acc, cur, wr, wc, fr, fq); S.done(cur); }
        if (!has_next) break;
#pragma unroll
        for (int a = 0; a < 2; ++a)
#pragma unroll
            for (int b = 0; b < 2; ++b)
#pragma unroll
                for (int m = 0; m < 4; ++m)
#pragma unroll
                    for (int n = 0; n < 2; ++n) acc[a][b][m][n] = (f32x4){0.f, 0.f, 0.f, 0.f};
        cur = nxt; cA = nA; cB = nB; ++ui;
        if constexpr (ALIGN_EPI) { if (wr == 1) PG8_BAR; }
    }
    PG8_WAIT_V(0);
    if constexpr (!ALIGN_EPI) { if (wr == 0) PG8_BAR; }
    PG8_BAR;
    if constexpr (Epi::AFTER_DRAIN) { E.fused(acc, cur, wr, wc, fr, fq, lds, wid, lane); S.done(cur); }
#undef PG8_SA
#undef PG8_SB
#undef PG8_STAGE
#undef PG8_LDA
#undef PG8_LDB
#undef PG8_MMA
#undef PG8_WAIT_V
#undef PG8_WAIT_L
#undef PG8_BAR
#undef PG8_SCHED
}
}

template <class E> struct EpiAdapt {
    static constexpr bool PERM = false, AFTER_DRAIN = false;
    E e;
    __device__ __forceinline__ void operator()(const f32x4 (&acc)[2][2][4][2], const pg8::Unit& u, int wr, int wc, int fr, int fq) const {
        const int lane = fq * 16 + fr;
#pragma unroll
        for (int ai = 0; ai < 2; ++ai) {
            f32x4 a2[4][4];
#pragma unroll
            for (int m = 0; m < 4; ++m)
#pragma unroll
                for (int bj = 0; bj < 2; ++bj)
#pragma unroll
                    for (int n = 0; n < 2; ++n) a2[m][bj * 2 + n] = acc[ai][bj][m][n];
            e(a2, u.pm * 256 + ai * 128 + wr * 64, u.pn * 256 + wc * 64, lane);
        }
    }
};
struct LatentOrder {
    pg8::StaticOrder S;
    __device__ void init(int N, int G, int c) { S.init(64 * 256, N, G, c); }
    __device__ bool next(int i, pg8::Unit& u) const { if (!S.next(i, u)) return false; u.pm = u.pm + 1 + (u.pm >= 32 ? 1 : 0); return true; }
    __device__ __forceinline__ void a_ready(const pg8::Unit&) const {}
    __device__ __forceinline__ void done(const pg8::Unit&) const {}
};
template <class E> __device__ __forceinline__ void gemm256(char* smem_all, const bf16_t* A, const bf16_t* WT, int N, int K, bool latent_only, const E& e) {
    PG8_LAS unsigned char* lds = (PG8_LAS unsigned char*)smem_all;
    pg8::Gemm g{A, WT, NR, N, K};
    EpiAdapt<E> ea{e};
    if (latent_only) { LatentOrder S; S.init(N, (int)gridDim.x, (int)blockIdx.x); pg8::gemm_phase<EpiAdapt<E>, LatentOrder, true, true>(lds, g, S, ea); }
    else { pg8::StaticOrder S; S.init(NR, N, (int)gridDim.x, (int)blockIdx.x); pg8::gemm_phase<EpiAdapt<E>, pg8::StaticOrder, true, true>(lds, g, S, ea); }
}

template <int ph> __device__ __forceinline__ void run_phase(const Params& p, char* smem_all) {
    char* smem = smem_all + (threadIdx.x >> 8) * HALF_LDS;
    unsigned char* ws = p.ws;
    float* MOD = (float*)(ws + WS_MOD); float* Hc = (float*)(ws + WS_HC); float* Hl = p.out; bf16_t* U = (bf16_t*)(ws + WS_U);
    if constexpr (ph == 0) { phase_prologue(p, smem); }
    if constexpr (ph == 1) { phase_ln(p.x, p.ctx, p.norm1_w, MOD, 0, 1, false, U); }
    if constexpr (ph == 2) { { EpiInEven e{(bf16_t*)(ws + R0_Q), (bf16_t*)(ws + R0_K), (bf16_t*)(ws + R0_VT), (bf16_t*)(ws + R0_XL), (bf16_t*)(ws + R0_GG)};
        gemm256(smem_all, U, (const bf16_t*)(ws + WS_WINE), 2560, 1024, false, e); } }
    if constexpr (ph == 3) { phase_na(p, smem_all); }
    if constexpr (ph == 4) { { EpiLru e{(const bf16_t*)(ws + R0_XC), (__half2*)(ws + R0_AB), p.lru_ba, p.lru_bx, (const float*)(ws + WS_SP)};
        gemm128_phase(smem, (const bf16_t*)(ws + R0_XC), 512, (const bf16_t*)(ws + WS_WLRU), 64, 132, 16, 0, 1, e); } }
    if constexpr (ph == 5) { phase_scan1(p); }
    if constexpr (ph == 6) { phase_scan2(p); }
    if constexpr (ph == 7) { { EpiResid e{p.x, p.ctx, Hl, Hc, MOD, 2}; gemm256(smem_all, U, (const bf16_t*)(ws + WS_WOUTE), 1024, 1024, false, e); } }
    if constexpr (ph == 8) { phase_ln(Hl, Hc, p.norm2_w, MOD, 3, 4, false, U); }
    if constexpr (ph == 9) { { EpiFF1 e{(bf16_t*)(ws + R_FF)}; gemm256(smem_all, U, (const bf16_t*)(ws + WS_WFF1), 4096, 1024, false, e); } }
    if constexpr (ph == 10) { { EpiResid e{Hl, Hc, Hl, Hc, MOD, 5}; gemm256(smem_all, (const bf16_t*)(ws + R_FF), (const bf16_t*)(ws + WS_WFF2), 1024, 4096, false, e); } }
    if constexpr (ph == 11) { phase_ln(Hl, Hc, p.norm1_w + 1024, MOD + 3 * 6144, 0, 1, false, U); }
    if constexpr (ph == 12) { { EpiInOdd e{(bf16_t*)(ws + R1_GQ), (bf16_t*)(ws + R1_GK), (bf16_t*)(ws + R1_GV), (bf16_t*)(ws + R1_GG), (bf16_t*)(ws + R1_QG), (bf16_t*)(ws + R1_KG), (bf16_t*)(ws + R1_VTG),
                          (float*)(ws + R1_LR), p.gqa_q_norm_w, p.gqa_k_norm_w, (const float2*)(ws + WS_ROPE)};
        gemm256(smem_all, U, (const bf16_t*)(ws + WS_WINO), 2560, 1024, false, e); } }
    if constexpr (ph == 13) { phase_gla1(p, smem); }
    if constexpr (ph == 14) { phase_gla2(p); phase_gqa(p, smem_all); if constexpr ((REPMASK >> 21) & 1) phase_gqa(p, smem_all); }
    if constexpr (ph == 15) { phase_gla3(p, smem); }
    if constexpr (ph == 16) { { EpiResid e{Hl, Hc, Hl, Hc, MOD + 3 * 6144, 2}; gemm256(smem_all, U, (const bf16_t*)(ws + WS_WOUTO), 1024, 1024, true, e); } }
    if constexpr (ph == 17) { phase_ln(Hl, Hc, p.norm2_w + 1024, MOD + 3 * 6144, 3, 4, true, U); }
    if constexpr (ph == 18) { { EpiFF1 e{(bf16_t*)(ws + R_FF)}; gemm256(smem_all, U, (const bf16_t*)(ws + WS_WFF1) + (size_t)4096 * 1024, 4096, 1024, true, e); } }
    if constexpr (ph == 19) { { EpiResid e{Hl, Hc, Hl, Hc, MOD + 3 * 6144, 5}; gemm256(smem_all, (const bf16_t*)(ws + R_FF), (const bf16_t*)(ws + WS_WFF2) + (size_t)4096 * 1024, 1024, 4096, true, e); } }
    if constexpr (ph == 20) { phase_final(p.final_norm_w, Hl); }
}

#if MEGA
template <int PH> __device__ __forceinline__ void run_all(const Params& p, char* smem, cg::grid_group& grid, const XcdBarrier& xb) {
    if constexpr (PH < NPHASE) {
        run_phase<PH>(p, smem);
        if constexpr ((REPMASK >> PH) & 1) { xcd_barrier(xb); run_phase<PH>(p, smem); }
        if constexpr (PH + 1 < NPHASE) { if constexpr (PH == 0) grid.sync(); else xcd_barrier(xb); }
        run_all<PH + 1>(p, smem, grid, xb);
    }
}
__global__ void __launch_bounds__(512, 2) hybrid_fwd(Params p) {
    extern __shared__ __attribute__((aligned(16))) char smem[];
    __shared__ uint4 xb_words;
    cg::grid_group grid = cg::this_grid();
    if (threadIdx.x == 0) xb_words = make_uint4(0u, 0u, 0u, 0u);
    __syncthreads();
    const XcdBarrier xb = xcd_barrier_post((unsigned*)(p.ws + WS_BAR), (volatile LAS unsigned*)&xb_words);
    run_all<0>(p, smem, grid, xb);
}
#else
template <int PH> __global__ void __launch_bounds__(512, 2) phase_k(Params p) {
    extern __shared__ __attribute__((aligned(16))) char smem[];
    run_phase<PH>(p, smem);
}
template <int PH> static bool setup_all() {
    if constexpr (PH < NPHASE) { if (hipFuncSetAttribute((const void*)phase_k<PH>, hipFuncAttributeMaxDynamicSharedMemorySize, LDS_BYTES) != hipSuccess) return false; return setup_all<PH + 1>(); }
    else return true;
}
template <int PH> static void launch_all(const Params& p, int grid, hipStream_t stream) {
    if constexpr (PH < NPHASE) { hipLaunchKernelGGL(phase_k<PH>, dim3(grid), dim3(512), LDS_BYTES, stream, p); launch_all<PH + 1>(p, grid, stream); }
}
#endif

extern "C" void kernel_launch(void* const* d_in, const int* in_sizes, int n_in, void* d_out, int out_size, void* d_ws, size_t ws_size, hipStream_t stream) {
    static int grid_blocks = 0;
    if (grid_blocks == 0) {
        if (n_in != 28 || out_size != NB * SEQ * DM || ws_size < WS_NEED) { fprintf(stderr, "kernel_launch: unexpected shapes (n_in %d out %d ws %zu need %zu)\n", n_in, out_size, ws_size, (size_t)WS_NEED); grid_blocks = -1; return; }
        int dev = 0, cus = 0, per_cu = 0;
        if (hipGetDevice(&dev) != hipSuccess || hipDeviceGetAttribute(&cus, hipDeviceAttributeMultiprocessorCount, dev) != hipSuccess) { grid_blocks = -1; return; }
#if MEGA
        if (hipFuncSetAttribute((const void*)hybrid_fwd, hipFuncAttributeMaxDynamicSharedMemorySize, LDS_BYTES) != hipSuccess) { fprintf(stderr, "kernel_launch: hipFuncSetAttribute failed\n"); grid_blocks = -1; return; }
        if (hipOccupancyMaxActiveBlocksPerMultiprocessor(&per_cu, (const void*)hybrid_fwd, 512, LDS_BYTES) != hipSuccess || per_cu < 1) { fprintf(stderr, "kernel_launch: occupancy query failed (%d)\n", per_cu); grid_blocks = -1; return; }
        if (per_cu > 1) per_cu = 1;
#else
        if (!setup_all<0>()) { fprintf(stderr, "kernel_launch: hipFuncSetAttribute failed\n"); grid_blocks = -1; return; }
        per_cu = 1;
#endif
        grid_blocks = cus * per_cu;
    }
    if (grid_blocks < 0) return;
    Params p{};
    const float** pp = (const float**)&p;
    for (int i = 0; i < 28; ++i) pp[i] = (const float*)d_in[i];
    p.out = (float*)d_out; p.ws = (unsigned char*)d_ws;
    p.ph_lo = 0; p.ph_hi = NPHASE;
#if MEGA
    if (hipMemsetAsync((char*)d_ws + WS_BAR, 0, 16384, stream) != hipSuccess) { fprintf(stderr, "kernel_launch: memset failed\n"); return; }
    void* args[] = {&p};
    hipError_t e = hipLaunchCooperativeKernel((const void*)hybrid_fwd, dim3(grid_blocks), dim3(512), args, LDS_BYTES, stream);
    if (e != hipSuccess) fprintf(stderr, "cooperative launch failed: %s (grid %d)\n", hipGetErrorString(e), grid_blocks);
#else
    launch_all<0>(p, grid_blocks, stream);
#endif
}
```

```cpp
#include <hip/hip_runtime.h>
#include <hip/hip_cooperative_groups.h>
#include <hip/hip_fp16.h>
#include <cstdio>
#include <cstdint>
namespace cg = cooperative_groups;

#ifndef MEGA
#define MEGA 1
#endif
#ifndef REPMASK
#define REPMASK 0
#endif

typedef unsigned short bf16_t;
typedef short bf16x8 __attribute__((ext_vector_type(8)));
typedef short s16x4 __attribute__((ext_vector_type(4)));
typedef float f32x4 __attribute__((ext_vector_type(4)));
typedef float f32x16 __attribute__((ext_vector_type(16)));
typedef unsigned u32x4 __attribute__((ext_vector_type(4)));
typedef unsigned u32x2 __attribute__((ext_vector_type(2)));

constexpr int DM = 1024, NB = 2, SEQ = 8192, CTX = 256, PP = SEQ + CTX, NR = NB * PP;
constexpr float EPS = 1e-6f;
constexpr float LOG2E = 1.4426950408889634f;
constexpr int HALF_LDS = 72704;
constexpr int LDS_BYTES = 2 * HALF_LDS;
#define VT ((int)(threadIdx.x & 255))
#define VB ((int)(blockIdx.x * 2 + (threadIdx.x >> 8)))
#define NVB ((int)(gridDim.x * 2))
constexpr int NPHASE = 21;

constexpr size_t WS_WFF1 = 0;
constexpr size_t WS_WFF2 = WS_WFF1 + 2ull * 4096 * 1024 * 2;
constexpr size_t WS_WINE = WS_WFF2 + 2ull * 4096 * 1024 * 2;
constexpr size_t WS_WOUTE = WS_WINE + 2560ull * 1024 * 2;
constexpr size_t WS_WINO = WS_WOUTE + 1024ull * 1024 * 2;
constexpr size_t WS_WOUTO = WS_WINO + 2560ull * 1024 * 2;
constexpr size_t WS_WLRU = WS_WOUTO + 1024ull * 1024 * 2;
constexpr size_t WS_MOD = WS_WLRU + 2048ull * 64 * 2;
constexpr size_t WS_ROPE = WS_MOD + 2ull * 3 * 6144 * 4;
constexpr size_t WS_SP = WS_ROPE + 128ull * 16 * 8;
constexpr size_t WS_HC = WS_SP + 2ull * 512 * 4;
constexpr size_t WS_U = WS_HC + 512ull * 1024 * 4;
constexpr size_t WS_REG = WS_U + (size_t)NR * 1024 * 2;
constexpr size_t R0_Q = WS_REG;
constexpr size_t R0_K = R0_Q + (size_t)NR * 512 * 2;
constexpr size_t R0_VT = R0_K + (size_t)NR * 512 * 2;
constexpr size_t R0_XL = R0_VT + (size_t)NR * 512 * 2;
constexpr size_t R0_GG = R0_XL + (size_t)NR * 512 * 2;
constexpr size_t R0_XC = R0_GG + (size_t)NR * 512 * 2;
constexpr size_t R0_AB = R0_XC + (size_t)NR * 512 * 2;
constexpr size_t R0_SUM = R0_AB + 2ull * NR * 512 * 4;
constexpr size_t R0_END = R0_SUM + 2ull * 2 * 132 * 512 * 8;
constexpr size_t R_FF = WS_REG;
constexpr size_t RFF_END = R_FF + (size_t)NR * 4096 * 2;
constexpr size_t R1_GQ = WS_REG;
constexpr size_t R1_GK = R1_GQ + (size_t)NR * 256 * 2;
constexpr size_t R1_GV = R1_GK + (size_t)NR * 256 * 2;
constexpr size_t R1_GG = R1_GV + (size_t)NR * 512 * 2;
constexpr size_t R1_LR = R1_GG + (size_t)NR * 512 * 2;
constexpr size_t R1_QG = R1_LR + (size_t)NR * 32 * 4;
constexpr size_t R1_KG = R1_QG + (size_t)NR * 512 * 2;
constexpr size_t R1_VTG = R1_KG + (size_t)NR * 128 * 2;
constexpr size_t R1_UC = R1_VTG + (size_t)NR * 128 * 2;
constexpr size_t R1_DEC = R1_UC + 16ull * 132 * 8192 * 4;
constexpr size_t R1_END = R1_DEC + 16ull * 132 * 64 * 4;
constexpr size_t WS_P1 = R0_Q;
constexpr size_t WS_P2 = RFF_END;
constexpr size_t WS_P2_END = WS_P2 + 16ull * 512 * 1024 * 4;
constexpr size_t WS_BAR = 268435456ull - 16384ull;
constexpr size_t WS_NEED0 = (R0_END > RFF_END ? (R0_END > R1_END ? R0_END : R1_END) : (RFF_END > R1_END ? RFF_END : R1_END));
static_assert(WS_P2_END <= WS_BAR, "ff2 partials run into the barrier words");
static_assert(WS_NEED0 <= WS_BAR, "workspace overlay runs into the barrier words");
constexpr size_t WS_NEED = 268435456ull;

struct Params {
    const float *x, *c, *ctx, *c_ctx, *norm1_w, *norm2_w, *w_mod, *b_mod, *w_ff1, *w_ff2;
    const float *w_in_even, *na_rpb, *lru_conv_w, *lru_conv_b, *lru_wa, *lru_ba, *lru_wx, *lru_bx, *lru_lambda, *w_out_even;
    const float *w_in_odd, *gla_wa2, *gla_ba, *gla_norm_w, *gqa_q_norm_w, *gqa_k_norm_w, *w_out_odd, *final_norm_w;
    float* out;
    unsigned char* ws;
    int ph_lo, ph_hi;
};

__device__ __forceinline__ unsigned f2bf(float f) { unsigned u = __float_as_uint(f); u += 0x7fffu + ((u >> 16) & 1u); return u >> 16; }
typedef float f32x2_t __attribute__((ext_vector_type(2)));
typedef __bf16 bf16x2_t __attribute__((ext_vector_type(2)));
__device__ __forceinline__ unsigned pack2(float a, float b) { const f32x2_t v = {a, b}; const bf16x2_t r = __builtin_convertvector(v, bf16x2_t); return __builtin_bit_cast(unsigned, r); }
__device__ __forceinline__ float bf2f(unsigned h) { return __uint_as_float(h << 16); }
__device__ __forceinline__ float bflo(unsigned w) { return __uint_as_float(w << 16); }
__device__ __forceinline__ float bfhi(unsigned w) { return __uint_as_float(w & 0xffff0000u); }
__device__ __forceinline__ float sigmoidf_(float z) { return __builtin_amdgcn_rcpf(1.f + __expf(-z)); }
__device__ __forceinline__ float wave_sum(float v) {
#pragma unroll
    for (int o = 32; o > 0; o >>= 1) v += __shfl_xor(v, o);
    return v;
}
__device__ __forceinline__ int clampi(int v, int lo, int hi) { return v < lo ? lo : (v > hi ? hi : v); }

__host__ __device__ __forceinline__ int phys2log(int P) { const int t = P >> 8, q = P & 255, bj = q >> 7, wc = (q >> 5) & 3, r = q & 31; return (t << 8) + 64 * wc + 32 * bj + r; }
__device__ __forceinline__ void tr_job(float* tile, const float* __restrict__ src, int Nsrc, bf16_t* __restrict__ dst, int K, int Ndst, int mode) {
    const int tid = VT;
    const int nkt = K >> 6, ntiles = (Ndst >> 6) * nkt;
    for (int t = VB; t < ntiles; t += NVB) {
        const int n0 = (t / nkt) << 6, k0 = (t % nkt) << 6;
        __syncthreads();
        {
            const int n = tid & 63; const int nn = phys2log(n0 + n); bool valid = true; int on = nn;
            if (mode == 1) { if (nn >= 2336) valid = false; else if (nn >= 2304) on = nn - 2304 + 1536; else if (nn >= 1536) on = nn + 32; }
#pragma unroll
            for (int i = 0; i < 16; ++i) { const int k = i * 4 + (tid >> 6); tile[k * 65 + n] = valid ? src[(size_t)(k0 + k) * Nsrc + on] : 0.f; }
        }
        __syncthreads();
        {
            const int n = tid >> 2, kq = (tid & 3) * 16; unsigned w[8];
#pragma unroll
            for (int j = 0; j < 8; ++j) w[j] = pack2(tile[(kq + 2 * j) * 65 + n], tile[(kq + 2 * j + 1) * 65 + n]);
            u32x4* d = (u32x4*)(dst + (size_t)(n0 + n) * K + k0 + kq);
            d[0] = (u32x4){w[0], w[1], w[2], w[3]}; d[1] = (u32x4){w[4], w[5], w[6], w[7]};
        }
    }
}

__device__ __forceinline__ void phase_prologue(const Params& p, char* smem) {
    const int tid = VT, bid = VB, nblk = NVB;
    unsigned char* ws = p.ws;
    {
        float* sv = (float*)smem; float* red = sv + 3072; float* MOD = (float*)(ws + WS_MOD);
        for (int i = tid; i < 3072; i += 256) { const int j = i >> 10, k = i & 1023; const float v = j < 2 ? p.c[j * 1024 + k] : p.c_ctx[k]; sv[i] = v / (1.f + __expf(-v)); }
        __syncthreads();
        for (int it = bid; it < 192; it += nblk) {
            const int l = it / 96, n0 = (it % 96) * 64, col = tid & 63, kg = tid >> 6;
            const float* w = p.w_mod + (size_t)l * 1024 * 6144 + n0 + col;
            float a0 = 0.f, a1 = 0.f, a2 = 0.f;
#pragma unroll 8
            for (int k = kg * 256; k < kg * 256 + 256; ++k) { const float wv = w[(size_t)k * 6144]; a0 += sv[k] * wv; a1 += sv[1024 + k] * wv; a2 += sv[2048 + k] * wv; }
            red[(kg * 3 + 0) * 64 + col] = a0; red[(kg * 3 + 1) * 64 + col] = a1; red[(kg * 3 + 2) * 64 + col] = a2;
            __syncthreads();
            if (tid < 192) { const int j = tid >> 6, cc = tid & 63;
                const float s = red[(0 * 3 + j) * 64 + cc] + red[(1 * 3 + j) * 64 + cc] + red[(2 * 3 + j) * 64 + cc] + red[(3 * 3 + j) * 64 + cc];
                MOD[(l * 3 + j) * 6144 + n0 + cc] = s + p.b_mod[l * 6144 + n0 + cc]; }
            __syncthreads();
        }
    }
    {
        const int gt = bid * 256 + tid, gn = nblk * 256;
        float2* rope = (float2*)(ws + WS_ROPE);
        for (int i = gt; i < 2048; i += gn) { const int pos = i >> 4, f = i & 15; const float inv = powf(10000.f, -(float)f / 16.f); const float ang = (float)pos * inv; float s, c; sincosf(ang, &s, &c); rope[i] = make_float2(c, s); }
        float* spt = (float*)(ws + WS_SP);
        for (int i = gt; i < 1024; i += gn) spt[i] = log1pf(__expf(-p.lru_lambda[i]));
        bf16_t* wl = (bf16_t*)(ws + WS_WLRU);
        for (int i = gt; i < 2048 * 64; i += gn) { const int n = i >> 6, k = i & 63; const int h = n >> 8, d = (n >> 7) & 1, j = (n & 127) >> 1, g = n & 1;
            const float* W = g ? p.lru_wx : p.lru_wa; wl[i] = (bf16_t)f2bf(W[(((size_t)(d * 8 + h) * 64 + k) * 64) + j]); }
    }
    float* tile = (float*)smem;
    for (int l = 0; l < 2; ++l) {
        tr_job(tile, p.w_ff1 + (size_t)l * 1024 * 4096, 4096, (bf16_t*)(ws + WS_WFF1) + (size_t)l * 4096 * 1024, 1024, 4096, 0);
        tr_job(tile, p.w_ff2 + (size_t)l * 4096 * 1024, 1024, (bf16_t*)(ws + WS_WFF2) + (size_t)l * 4096 * 1024, 4096, 1024, 0);
    }
    tr_job(tile, p.w_in_even, 2560, (bf16_t*)(ws + WS_WINE), 1024, 2560, 0);
    tr_job(tile, p.w_out_even, 1024, (bf16_t*)(ws + WS_WOUTE), 1024, 1024, 0);
    tr_job(tile, p.w_in_odd, 2336, (bf16_t*)(ws + WS_WINO), 1024, 2560, 1);
    tr_job(tile, p.w_out_odd, 1024, (bf16_t*)(ws + WS_WOUTO), 1024, 1024, 0);
}

__device__ __forceinline__ void phase_ln(const float* __restrict__ srcL, const float* __restrict__ srcC, const float* __restrict__ nw, const float* __restrict__ mod, int sh_slot, int sc_slot, bool latent_only, bf16_t* __restrict__ U,
                                         const float* __restrict__ cP = nullptr, int nsplit = 0, const float* __restrict__ cG = nullptr, float* __restrict__ cW = nullptr) {
    const int lane = VT & 63, gw = VB * 4 + (VT >> 6), nwt = NVB * 4;
    const int nrows = latent_only ? NB * SEQ : NR;
    for (int idx = gw; idx < nrows; idx += nwt) {
        int b, pi; if (latent_only) { b = idx >> 13; pi = 256 + (idx & 8191); } else { b = idx / PP; pi = idx - b * PP; }
        const int R = b * PP + pi; const bool isc = pi < 256; const int ms = isc ? 2 : b;
        const float* src = isc ? srcC + (size_t)(b * 256 + pi) * 1024 : srcL + (size_t)(b * 8192 + pi - 256) * 1024;
        f32x4 v[4]; float ss = 0.f;
#pragma unroll
        for (int i = 0; i < 4; ++i) v[i] = *(const f32x4*)(src + i * 256 + lane * 4);
        if (isc && cP) { const float* g = cG; const int cr = b * 256 + pi;
#pragma unroll
            for (int i = 0; i < 4; ++i) { f32x4 a = (f32x4){0.f, 0.f, 0.f, 0.f};
                for (int s = 0; s < nsplit; ++s) a += *(const f32x4*)(cP + ((size_t)s * 512 + cr) * 1024 + i * 256 + lane * 4);
                v[i] += *(const f32x4*)(g + i * 256 + lane * 4) * a;
                if (cW) *(f32x4*)(cW + (size_t)cr * 1024 + i * 256 + lane * 4) = v[i]; } }
#pragma unroll
        for (int i = 0; i < 4; ++i) ss += v[i][0] * v[i][0] + v[i][1] * v[i][1] + v[i][2] * v[i][2] + v[i][3] * v[i][3];
        ss = wave_sum(ss);
        const float rstd = rsqrtf(ss * (1.f / 1024.f) + EPS);
        const float* sh = mod + ms * 6144 + sh_slot * 1024; const float* sc = mod + ms * 6144 + sc_slot * 1024;
#pragma unroll
        for (int i = 0; i < 4; ++i) { const int n = i * 256 + lane * 4;
            const f32x4 w4 = *(const f32x4*)(nw + n), s4 = *(const f32x4*)(sc + n), h4 = *(const f32x4*)(sh + n);
            const f32x4 y = v[i] * rstd * w4 * (s4 + 1.f) + h4;
            *(u32x2*)(U + (size_t)R * 1024 + n) = (u32x2){pack2(y[0], y[1]), pack2(y[2], y[3])}; }
    }
}

__device__ __forceinline__ void phase_final(const float* __restrict__ fw, float* __restrict__ out) {
    const int lane = VT & 63, gw = VB * 4 + (VT >> 6), nwt = NVB * 4;
    for (int idx = gw; idx < NB * SEQ; idx += nwt) {
        float* row = out + (size_t)idx * 1024;
        f32x4 v[4]; float ss = 0.f;
#pragma unroll
        for (int i = 0; i < 4; ++i) { v[i] = *(const f32x4*)(row + i * 256 + lane * 4); ss += v[i][0] * v[i][0] + v[i][1] * v[i][1] + v[i][2] * v[i][2] + v[i][3] * v[i][3]; }
        ss = wave_sum(ss);
        const float rstd = rsqrtf(ss * (1.f / 1024.f) + EPS);
#pragma unroll
        for (int i = 0; i < 4; ++i) { const int n = i * 256 + lane * 4; const f32x4 w4 = *(const f32x4*)(fw + n); *(f32x4*)(row + n) = v[i] * rstd * w4; }
    }
}

template <class Epi>
__device__ __forceinline__ void gemm128_phase(char* smem, const bf16_t* __restrict__ A, int lda, const bf16_t* __restrict__ WT, int K, int nMt, int nNt, int rowmode, int lru, const Epi& epi) {
    bf16_t* As = (bf16_t*)smem; bf16_t* Bs = As + 128 * 72;
    int tid_ = VT; asm volatile("" : "+v"(tid_));
    const int tid = tid_, lane = tid & 63, wid = tid >> 6, wm = wid >> 1, wn = wid & 1;
    const int lr = lane & 15, lq = lane >> 4;
    const int ntiles = nMt * nNt;
    for (int tile = VB; tile < ntiles; tile += NVB) {
        const int mt = tile / nNt, nt = tile - mt * nNt;
        const int row0 = rowmode ? ((mt >> 6) * PP + 256 + (mt & 63) * 128) : mt * 128;
        const bf16_t* Ag = A + (size_t)row0 * lda + (lru ? (nt >> 1) * 64 : 0);
        const bf16_t* Bg = WT + (size_t)nt * 128 * K;
        f32x4 acc[4][4];
#pragma unroll
        for (int i = 0; i < 4; ++i)
#pragma unroll
            for (int j = 0; j < 4; ++j) acc[i][j] = (f32x4){0.f, 0.f, 0.f, 0.f};
        u32x4 ra[4], rb[4];
#pragma unroll
        for (int i = 0; i < 4; ++i) { const int c = tid + 256 * i, r = c >> 3, kc = (c & 7) * 8; ra[i] = *(const u32x4*)(Ag + (size_t)r * lda + kc); rb[i] = *(const u32x4*)(Bg + (size_t)r * K + kc); }
        for (int k0 = 0; k0 < K; k0 += 64) {
            __syncthreads();
#pragma unroll
            for (int i = 0; i < 4; ++i) { const int c = tid + 256 * i, r = c >> 3, kc = (c & 7) * 8; *(u32x4*)(As + r * 72 + kc) = ra[i]; *(u32x4*)(Bs + r * 72 + kc) = rb[i]; }
            __syncthreads();
            if (k0 + 64 < K) {
#pragma unroll
                for (int i = 0; i < 4; ++i) { const int c = tid + 256 * i, r = c >> 3, kc = (c & 7) * 8 + k0 + 64; ra[i] = *(const u32x4*)(Ag + (size_t)r * lda + kc); rb[i] = *(const u32x4*)(Bg + (size_t)r * K + kc); }
            }
#pragma unroll
            for (int ks = 0; ks < 2; ++ks) {
                bf16x8 af[4], bfr[4];
#pragma unroll
                for (int i = 0; i < 4; ++i) { af[i] = *(const bf16x8*)(As + (wm * 64 + i * 16 + lr) * 72 + ks * 32 + lq * 8); bfr[i] = *(const bf16x8*)(Bs + (wn * 64 + i * 16 + lr) * 72 + ks * 32 + lq * 8); }
#pragma unroll
                for (int mi = 0; mi < 4; ++mi)
#pragma unroll
                    for (int ni = 0; ni < 4; ++ni) acc[mi][ni] = __builtin_amdgcn_mfma_f32_16x16x32_bf16(bfr[ni], af[mi], acc[mi][ni], 0, 0, 0);
            }
        }
        epi(acc, row0 + wm * 64, nt * 128 + wn * 64, lane);
    }
}

struct EpiResid {
    const float* srcL; const float* srcC; float* dstL; float* dstC; const float* mod; int slot;
    __device__ __forceinline__ void operator()(const f32x4 (&acc)[4][4], int Rb, int nb, int lane) const {
        const int lr = lane & 15, lq = lane >> 4;
#pragma unroll
        for (int mi = 0; mi < 4; ++mi) {
            const int R = Rb + mi * 16 + lr; const int b = R / PP, pi = R - b * PP; const bool isc = pi < 256; const int ms = isc ? 2 : b;
            const size_t ro = isc ? (size_t)(b * 256 + pi) * 1024 : (size_t)(b * 8192 + pi - 256) * 1024;
            const float* s = (isc ? srcC : srcL) + ro; float* d = (isc ? dstC : dstL) + ro; const float* g = mod + ms * 6144 + slot * 1024;
#pragma unroll
            for (int ni = 0; ni < 4; ++ni) { const int n = nb + ni * 16 + lq * 4; const f32x4 h = *(const f32x4*)(s + n), gg = *(const f32x4*)(g + n); *(f32x4*)(d + n) = h + gg * acc[mi][ni]; }
        }
    }
};
struct EpiFF1 {
    bf16_t* FF;
    __device__ __forceinline__ void operator()(const f32x4 (&acc)[4][4], int Rb, int nb, int lane) const {
        const int lr = lane & 15, lq = lane >> 4;
#pragma unroll
        for (int mi = 0; mi < 4; ++mi) { const int R = Rb + mi * 16 + lr;
#pragma unroll
            for (int ni = 0; ni < 4; ++ni) { const int n = nb + ni * 16 + lq * 4; f32x4 v = acc[mi][ni];
#pragma unroll
                for (int e = 0; e < 4; ++e) { const float r = fmaxf(v[e], 0.f); v[e] = r * r; }
                *(u32x2*)(FF + (size_t)R * 4096 + n) = (u32x2){pack2(v[0], v[1]), pack2(v[2], v[3])}; } }
    }
};
__device__ __forceinline__ float gelu_tanh(float x) { const float u = 0.7978845608028654f * (x + 0.044715f * x * x * x); const float t = 1.f - 2.f / (1.f + __expf(2.f * u)); return 0.5f * x * (1.f + t); }
struct EpiInEven {
    bf16_t *Qn, *Kn, *VTn, *XL, *GG;
    __device__ __forceinline__ void operator()(const f32x4 (&acc)[4][4], int Rb, int nb, int lane) const {
        const int lr = lane & 15, lq = lane >> 4;
#pragma unroll
        for (int mi = 0; mi < 4; ++mi) { const int R = Rb + mi * 16 + lr; const int b = R / PP, pi = R - b * PP;
#pragma unroll
            for (int ni = 0; ni < 4; ++ni) { const int n = nb + ni * 16 + lq * 4; const f32x4 a = acc[mi][ni];
                if (n < 512) *(u32x2*)(Qn + (size_t)R * 512 + n) = (u32x2){pack2(a[0] * (0.125f * LOG2E), a[1] * (0.125f * LOG2E)), pack2(a[2] * (0.125f * LOG2E), a[3] * (0.125f * LOG2E))};
                else if (n < 1024) *(u32x2*)(Kn + (size_t)R * 512 + (n - 512)) = (u32x2){pack2(a[0], a[1]), pack2(a[2], a[3])};
                else if (n < 1536) { const int hh = (n - 1024) >> 6, d0 = (n - 1024) & 63; bf16_t* vp = VTn + ((size_t)((b * 8 + hh) * 64 + d0)) * PP + pi;
#pragma unroll
                    for (int e = 0; e < 4; ++e) vp[(size_t)e * PP] = (bf16_t)f2bf(a[e]); }
                else if (n < 2048) *(u32x2*)(XL + (size_t)R * 512 + (n - 1536)) = (u32x2){pack2(a[0], a[1]), pack2(a[2], a[3])};
                else *(u32x2*)(GG + (size_t)R * 512 + (n - 2048)) = (u32x2){pack2(gelu_tanh(a[0]), gelu_tanh(a[1])), pack2(gelu_tanh(a[2]), gelu_tanh(a[3]))};
            } }
    }
};
struct EpiLru {
    const bf16_t* XC; __half2* AB; const float *ba, *bx, *lam;
    __device__ __forceinline__ void operator()(const f32x4 (&acc)[4][4], int Rb, int nb, int lane) const {
        const int lr = lane & 15, lq = lane >> 4;
        const int h = nb >> 8, d = (nb >> 7) & 1, colb = nb & 127;
#pragma unroll
        for (int mi = 0; mi < 4; ++mi) { const int R = Rb + mi * 16 + lr;
#pragma unroll
            for (int ni = 0; ni < 4; ++ni) { const int j0 = (colb + ni * 16 + lq * 4) >> 1; const int c = h * 64 + j0; __half2 o[2];
#pragma unroll
                for (int e2 = 0; e2 < 2; ++e2) { const int cc = c + e2;
                    const float za = acc[mi][ni][2 * e2] + ba[d * 512 + cc], zx = acc[mi][ni][2 * e2 + 1] + bx[d * 512 + cc];
                    const float r = sigmoidf_(za), ig = sigmoidf_(zx);
                    const float la = -8.f * r * lam[d * 512 + cc];
                    const float xv = bf2f(XC[(size_t)R * 512 + cc]);
                    const float x2 = 2.f * la;
                    const float ser = -x2 * (1.f + x2 * 0.5f * (1.f + x2 * (1.f / 3.f) * (1.f + x2 * 0.25f * (1.f + x2 * 0.2f))));
                    const float om = (x2 > -0.25f) ? ser : 1.f - __expf(x2);
                    const float bb = __builtin_amdgcn_sqrtf(fmaxf(om, 0.f)) * ig * xv;
                    o[e2] = __floats2half2_rn(la, bb); }
                __half2* dst = AB + ((size_t)d * NR + R) * 512 + c; dst[0] = o[0]; dst[1] = o[1]; } }
    }
};
struct EpiInOdd {
    bf16_t *Gq, *Gk, *Gv, *Gg, *Qg, *Kg, *VTg; float* LR; const float *qnw, *knw; const float2* rope;
    __device__ __forceinline__ void operator()(const f32x4 (&acc)[4][4], int Rb, int nb, int lane) const {
        const int lr = lane & 15, lq = lane >> 4;
        if (nb < 1536) {
#pragma unroll
            for (int mi = 0; mi < 4; ++mi) { const int R = Rb + mi * 16 + lr;
#pragma unroll
                for (int ni = 0; ni < 4; ++ni) { const int n = nb + ni * 16 + lq * 4; const f32x4 a = acc[mi][ni];
                    if (n < 256) *(u32x2*)(Gq + (size_t)R * 256 + n) = (u32x2){pack2(a[0], a[1]), pack2(a[2], a[3])};
                    else if (n < 512) *(u32x2*)(Gk + (size_t)R * 256 + (n - 256)) = (u32x2){pack2(a[0], a[1]), pack2(a[2], a[3])};
                    else if (n < 1024) *(u32x2*)(Gv + (size_t)R * 512 + (n - 512)) = (u32x2){pack2(a[0], a[1]), pack2(a[2], a[3])};
                    else { f32x4 s;
#pragma unroll
                        for (int e = 0; e < 4; ++e) s[e] = a[e] * sigmoidf_(a[e]);
                        *(u32x2*)(Gg + (size_t)R * 512 + (n - 1024)) = (u32x2){pack2(s[0], s[1]), pack2(s[2], s[3])}; } } }
        } else if (nb < 2176) {
            const bool isq = nb < 2048; const float* nwp = isq ? qnw : knw;
#pragma unroll
            for (int mi = 0; mi < 4; ++mi) { const int R = Rb + mi * 16 + lr; const int b = R / PP, pi = R - b * PP;
                float ss = 0.f;
#pragma unroll
                for (int ni = 0; ni < 4; ++ni)
#pragma unroll
                    for (int e = 0; e < 4; ++e) ss += acc[mi][ni][e] * acc[mi][ni][e];
                ss += __shfl_xor(ss, 16); ss += __shfl_xor(ss, 32);
                const float rstd = rsqrtf(ss * (1.f / 64.f) + EPS);
                f32x4 y[4];
#pragma unroll
                for (int ni = 0; ni < 4; ++ni) { const f32x4 w4 = *(const f32x4*)(nwp + ni * 16 + lq * 4); y[ni] = acc[mi][ni] * rstd * w4; }
                if (pi >= 256) { const int t = pi - 256, prow = t >> 6, pcol = t & 63;
#pragma unroll
                    for (int e = 0; e < 4; ++e) { const int i = lq * 4 + e; const float2 cr = rope[prow * 16 + i], cc = rope[pcol * 16 + i];
                        const float a1 = y[0][e], a2 = y[1][e]; y[0][e] = a1 * cr.x - a2 * cr.y; y[1][e] = a2 * cr.x + a1 * cr.y;
                        const float b1 = y[2][e], b2 = y[3][e]; y[2][e] = b1 * cc.x - b2 * cc.y; y[3][e] = b2 * cc.x + b1 * cc.y; } }
                if (isq) {
#pragma unroll
                    for (int ni = 0; ni < 4; ++ni) { const f32x4 v = y[ni] * (0.125f * LOG2E); *(u32x2*)(Qg + (size_t)R * 512 + (nb - 1536) + ni * 16 + lq * 4) = (u32x2){pack2(v[0], v[1]), pack2(v[2], v[3])}; }
                } else {
#pragma unroll
                    for (int ni = 0; ni < 4; ++ni) { const f32x4 v = y[ni]; *(u32x2*)(Kg + (size_t)R * 128 + (nb - 2048) + ni * 16 + lq * 4) = (u32x2){pack2(v[0], v[1]), pack2(v[2], v[3])}; }
                } }
        } else if (nb < 2304) {
            const int kvh = (nb - 2176) >> 6;
#pragma unroll
            for (int mi = 0; mi < 4; ++mi) { const int R = Rb + mi * 16 + lr; const int b = R / PP, pi = R - b * PP;
#pragma unroll
                for (int ni = 0; ni < 4; ++ni) { bf16_t* vp = VTg + ((size_t)((b * 2 + kvh) * 64 + ni * 16 + lq * 4)) * PP + pi;
#pragma unroll
                    for (int e = 0; e < 4; ++e) vp[(size_t)e * PP] = (bf16_t)f2bf(acc[mi][ni][e]); } }
        } else if (nb == 2304) {
#pragma unroll
            for (int mi = 0; mi < 4; ++mi) { const int R = Rb + mi * 16 + lr;
#pragma unroll
                for (int ni = 0; ni < 2; ++ni) *(f32x4*)(LR + (size_t)R * 32 + ni * 16 + lq * 4) = acc[mi][ni]; }
        }
    }
};

#define ATT_THR 8.0f
__device__ __forceinline__ unsigned cvt_pk_bf16(float lo, float hi) { return pack2(lo, hi); }
__device__ __forceinline__ float vmax3(float a, float b, float c) { float r; asm("v_max3_f32 %0, %1, %2, %3" : "=v"(r) : "v"(a), "v"(b), "v"(c)); return r; }
__device__ __forceinline__ float vadd(float a, float b) { return a + b; }
__device__ __forceinline__ void attn_unit(char* smem, const bf16_t* __restrict__ Qp, int ldq, const bf16_t* __restrict__ Kp, int ldk, const bf16_t* __restrict__ VTp,
                                          bf16_t* __restrict__ Op, int ldo, int ntiles, int mode, int r0, int rs0, const float* __restrict__ rpb_h) {
    bf16_t* Ks = (bf16_t*)smem;
    bf16_t* Vs = Ks + 2 * 64 * 72;
    float* rp = (float*)(Vs + 2 * 64 * 72);
    int tid_ = threadIdx.x; asm volatile("" : "+v"(tid_));
    const int tid = tid_, lane = tid & 63, w = tid >> 6, l31 = lane & 31, lh = lane >> 5;
    if (mode == 1) { for (int i = tid; i < 465; i += 512) rp[i] = rpb_h[i] * LOG2E; }
    bf16x8 qf[4];
    { const bf16_t* q = Qp + (size_t)(w * 32 + l31) * ldq + lh * 8;
#pragma unroll
        for (int ks = 0; ks < 4; ++ks) qf[ks] = *(const bf16x8*)(q + ks * 16); }
    f32x16 ot[2], negm;
#pragma unroll
    for (int i = 0; i < 16; ++i) { ot[0][i] = 0.f; ot[1][i] = 0.f; negm[i] = 0.f; }
    float l = 0.f;
    u32x4 rk, rv;
    const int sr = tid >> 3, scc = (tid & 7) * 8;
#define ATT_GLOAD(t_) do { const int t__ = (t_); const int pos__ = (mode == 1) ? (t__ < 4 ? t__ * 64 : 256 + (rs0 + t__ - 4) * 64) : t__ * 64; \
        rk = *(const u32x4*)(Kp + (size_t)(pos__ + sr) * ldk + scc); rv = *(const u32x4*)(VTp + (size_t)sr * PP + pos__ + scc); } while (0)
#define ATT_SSTORE(buf_) do { *(u32x4*)(Ks + (buf_) * 64 * 72 + sr * 72 + scc) = rk; *(u32x4*)(Vs + (buf_) * 64 * 72 + sr * 72 + scc) = rv; } while (0)
    ATT_GLOAD(0); ATT_SSTORE(0); __syncthreads();
    for (int t = 0; t < ntiles; ++t) {
        if (t + 1 < ntiles) ATT_GLOAD(t + 1);
        const bf16_t* ks_ = Ks + (t & 1) * 64 * 72; const bf16_t* vs_ = Vs + (t & 1) * 64 * 72;
        bool skip = false; int kr = 0, rq = 0;
        const bool local = (mode == 1) && (t >= 4);
        if (local) { kr = rs0 + t - 4; rq = r0 + (w >> 1); const int rsq = clampi(rq - 4, 0, 120); skip = (kr < rsq) || (kr >= rsq + 8); }
        if (!skip) {
            f32x16 st[2];
#pragma unroll
            for (int kt = 0; kt < 2; ++kt) {
                const bf16x8 kf0 = *(const bf16x8*)(ks_ + (kt * 32 + l31) * 72 + lh * 8);
                st[kt] = __builtin_amdgcn_mfma_f32_32x32x16_bf16(kf0, qf[0], negm, 0, 0, 0);
#pragma unroll
                for (int ks = 1; ks < 4; ++ks) { const bf16x8 kf = *(const bf16x8*)(ks_ + (kt * 32 + l31) * 72 + ks * 16 + lh * 8); st[kt] = __builtin_amdgcn_mfma_f32_32x32x16_bf16(kf, qf[ks], st[kt], 0, 0, 0); }
            }
            asm volatile("s_nop 11" : "+v"(st[0]), "+v"(st[1]));
            if (local) { const int qc = (w & 1) * 32 + l31, cs = clampi(qc - 8, 0, 48); const float* rrow = rp + (kr - rq + 7) * 31;
#pragma unroll
                for (int kt = 0; kt < 2; ++kt)
#pragma unroll
                    for (int i = 0; i < 16; ++i) { const int kc = kt * 32 + (i & 3) + 8 * (i >> 2) + 4 * lh; const bool ok = (kc >= cs) && (kc < cs + 16);
                        const float bias = rrow[clampi(kc - qc + 15, 0, 30)]; st[kt][i] = ok ? st[kt][i] + bias : -1e30f; } }
            float mx = vmax3(st[0][0], st[0][1], st[0][2]);
#pragma unroll
            for (int i = 3; i < 15; i += 2) mx = vmax3(mx, st[0][i], st[0][i + 1]);
            mx = vmax3(mx, st[0][15], st[1][0]);
#pragma unroll
            for (int i = 1; i < 15; i += 2) mx = vmax3(mx, st[1][i], st[1][i + 1]);
            mx = fmaxf(mx, st[1][15]);
            mx = fmaxf(mx, __shfl_xor(mx, 32));
            if (t == 0 || __any(mx > ATT_THR)) {
                const float adj = (t == 0) ? mx : fmaxf(mx, 0.f);
                const float sc = __builtin_amdgcn_exp2f(-adj);
                l *= sc;
#pragma unroll
                for (int i = 0; i < 16; ++i) { ot[0][i] *= sc; ot[1][i] *= sc; st[0][i] -= adj; st[1][i] -= adj; }
                const float nm = negm[0] - adj;
#pragma unroll
                for (int i = 0; i < 16; ++i) negm[i] = nm;
            }
            float ps0 = 0.f, ps1 = 0.f;
#pragma unroll
            for (int i = 0; i < 16; ++i) { st[0][i] = __builtin_amdgcn_exp2f(st[0][i]); st[1][i] = __builtin_amdgcn_exp2f(st[1][i]); ps0 = vadd(ps0, st[0][i]); ps1 = vadd(ps1, st[1][i]); }
            l += ps0 + ps1;
#pragma unroll
            for (int kt = 0; kt < 2; ++kt)
#pragma unroll
                for (int s = 0; s < 2; ++s) {
                    u32x4 pw; pw[0] = cvt_pk_bf16(st[kt][8 * s + 0], st[kt][8 * s + 1]); pw[1] = cvt_pk_bf16(st[kt][8 * s + 2], st[kt][8 * s + 3]); pw[2] = cvt_pk_bf16(st[kt][8 * s + 4], st[kt][8 * s + 5]); pw[3] = cvt_pk_bf16(st[kt][8 * s + 6], st[kt][8 * s + 7]);
                    const bf16x8 pf = __builtin_bit_cast(bf16x8, pw);
#pragma unroll
                    for (int dt = 0; dt < 2; ++dt) { const bf16_t* vp = vs_ + (dt * 32 + l31) * 72 + kt * 32 + s * 16 + lh * 4;
                        const u32x2 v0 = *(const u32x2*)vp, v1 = *(const u32x2*)(vp + 8); const u32x4 vw = (u32x4){v0[0], v0[1], v1[0], v1[1]};
                        ot[dt] = __builtin_amdgcn_mfma_f32_32x32x16_bf16(__builtin_bit_cast(bf16x8, vw), pf, ot[dt], 0, 0, 0); } }
        }
        if (t + 1 < ntiles) ATT_SSTORE((t + 1) & 1);
        __syncthreads();
    }
#undef ATT_GLOAD
#undef ATT_SSTORE
    l += __shfl_xor(l, 32);
    const float inv = 1.f / l;
    bf16_t* o = Op + (size_t)(w * 32 + l31) * ldo;
#pragma unroll
    for (int dt = 0; dt < 2; ++dt)
#pragma unroll
        for (int g = 0; g < 4; ++g) { const int d = dt * 32 + 8 * g + 4 * lh;
            *(u32x2*)(o + d) = (u32x2){cvt_pk_bf16(ot[dt][4 * g] * inv, ot[dt][4 * g + 1] * inv), cvt_pk_bf16(ot[dt][4 * g + 2] * inv, ot[dt][4 * g + 3] * inv)}; }
}

__device__ __forceinline__ void phase_na(const Params& p, char* smem) {
    unsigned char* ws = p.ws;
    const bf16_t* Qn = (const bf16_t*)(ws + R0_Q); const bf16_t* Kn = (const bf16_t*)(ws + R0_K); const bf16_t* VTn = (const bf16_t*)(ws + R0_VT);
    bf16_t* MO = (bf16_t*)(ws + WS_U);
    for (int u = blockIdx.x; u < 512 + 16; u += gridDim.x) {
        if (u < 512) { const int b = u >> 8, h = (u >> 5) & 7, qb = u & 31; const int r0 = qb * 4;
            const int rs0 = clampi(r0 - 4, 0, 120), rsl = clampi(r0 - 1, 0, 120); const int nl = rsl + 8 - rs0;
            const size_t Rq = (size_t)b * PP + 256 + qb * 256;
            attn_unit(smem, Qn + Rq * 512 + h * 64, 512, Kn + (size_t)b * PP * 512 + h * 64, 512, VTn + (size_t)((b * 8 + h) * 64) * PP, MO + Rq * 1024 + h * 64, 1024, 4 + nl, 1, r0, rs0, p.na_rpb + h * 465);
        } else { const int v = u - 512; const int b = v >> 3, h = v & 7;
            const size_t Rq = (size_t)b * PP;
            attn_unit(smem, Qn + Rq * 512 + h * 64, 512, Kn + (size_t)b * PP * 512 + h * 64, 512, VTn + (size_t)((b * 8 + h) * 64) * PP, MO + Rq * 1024 + h * 64, 1024, 4, 0, 0, 0, nullptr);
        }
    }
    const bf16_t* XL = (const bf16_t*)(ws + R0_XL); bf16_t* XC = (bf16_t*)(ws + R0_XC);
    const int gt = VB * 256 + VT, gn = NVB * 256;
    for (int idx = gt; idx < NR * 64; idx += gn) {
        const int R = idx >> 6, c8 = (idx & 63) * 8; const int b = R / PP, pi = R - b * PP; const int lo = pi < 256 ? 0 : 256, hi = pi < 256 ? 256 : PP;
        float a[8];
        { const f32x4 b0 = *(const f32x4*)(p.lru_conv_b + c8), b1 = *(const f32x4*)(p.lru_conv_b + c8 + 4); a[0] = b0[0]; a[1] = b0[1]; a[2] = b0[2]; a[3] = b0[3]; a[4] = b1[0]; a[5] = b1[1]; a[6] = b1[2]; a[7] = b1[3]; }
#pragma unroll
        for (int j = 0; j < 4; ++j) { const int pj = pi + j - 2;
            if (pj >= lo && pj < hi) { const u32x4 xv = *(const u32x4*)(XL + (size_t)(b * PP + pj) * 512 + c8);
                const f32x4 w0 = *(const f32x4*)(p.lru_conv_w + j * 512 + c8), w1 = *(const f32x4*)(p.lru_conv_w + j * 512 + c8 + 4);
                a[0] += w0[0] * bflo(xv[0]); a[1] += w0[1] * bfhi(xv[0]); a[2] += w0[2] * bflo(xv[1]); a[3] += w0[3] * bfhi(xv[1]);
                a[4] += w1[0] * bflo(xv[2]); a[5] += w1[1] * bfhi(xv[2]); a[6] += w1[2] * bflo(xv[3]); a[7] += w1[3] * bfhi(xv[3]); } }
        *(u32x4*)(XC + (size_t)R * 512 + c8) = (u32x4){pack2(a[0], a[1]), pack2(a[2], a[3]), pack2(a[4], a[5]), pack2(a[6], a[7])};
    }
}

__device__ __forceinline__ void phase_scan1(const Params& p) {
    const __half2* AB = (const __half2*)(p.ws + R0_AB); float2* SUM = (float2*)(p.ws + R0_SUM);
    for (int it = VB; it < 1056; it += NVB) {
        const int cgp = it & 1, tc = (it >> 1) % 132, db = (it >> 1) / 132, b = db & 1, d = db >> 1;
        const int c = cgp * 256 + VT;
        const __half2* ab = AB + ((size_t)d * NR + (size_t)b * PP + tc * 64) * 512 + c;
        float h = 0.f, ap = 0.f;
#pragma unroll 8
        for (int s = 0; s < 64; ++s) { const int tt = d ? 63 - s : s; const __half2 v = ab[(size_t)tt * 512]; const float la = __low2float(v), bb = __high2float(v); h = __expf(la) * h + bb; ap += la; }
        SUM[((size_t)(d * 2 + b) * 132 + tc) * 512 + c] = make_float2(__expf(ap), h);
    }
}
__device__ __forceinline__ void phase_scan2(const Params& p) {
    const __half2* AB = (const __half2*)(p.ws + R0_AB); const float2* SUM = (const float2*)(p.ws + R0_SUM);
    const bf16_t* GG = (const bf16_t*)(p.ws + R0_GG); bf16_t* MO = (bf16_t*)(p.ws + WS_U);
    for (int it = VB; it < 528; it += NVB) {
        const int cgp = it & 1, tc = (it >> 1) % 132, b = (it >> 1) / 132;
        const int c = cgp * 256 + VT; const size_t R0 = (size_t)b * PP + tc * 64;
        float hf[64];
        {
            float h = 0.f; const float2* sm = SUM + ((size_t)(0 * 2 + b) * 132) * 512 + c;
#pragma unroll 8
            for (int jj = 0; jj < tc; ++jj) { const float2 s = sm[(size_t)jj * 512]; h = s.x * h + s.y; }
            const __half2* ab = AB + ((size_t)0 * NR + R0) * 512 + c;
#pragma unroll
            for (int s = 0; s < 64; ++s) { const __half2 v = ab[(size_t)s * 512]; h = __expf(__low2float(v)) * h + __high2float(v); hf[s] = h; }
        }
        {
            const int j = tc < 4 ? 3 - tc : 135 - tc;
            float h = 0.f; const float2* sm = SUM + ((size_t)(1 * 2 + b) * 132) * 512 + c;
#pragma unroll 8
            for (int jj = 0; jj < j; ++jj) { const int tcj = jj < 4 ? 3 - jj : 135 - jj; const float2 s = sm[(size_t)tcj * 512]; h = s.x * h + s.y; }
            const __half2* ab = AB + ((size_t)1 * NR + R0) * 512 + c;
#pragma unroll
            for (int s = 0; s < 64; ++s) { const int tt = 63 - s; const __half2 v = ab[(size_t)tt * 512]; h = __expf(__low2float(v)) * h + __high2float(v);
                const float g = bf2f(GG[(R0 + tt) * 512 + c]);
                MO[(R0 + tt) * 1024 + 512 + c] = (bf16_t)f2bf((hf[tt] + h) * g); }
        }
    }
}

__device__ __forceinline__ void gla_gates(const Params& p, float* gs, float* part, const float* __restrict__ LR, size_t R0, int d, int h) {
    const int tid = VT, dk = tid & 63, tg = tid >> 6;
    float wv[16];
#pragma unroll
    for (int r = 0; r < 16; ++r) wv[r] = p.gla_wa2[(d * 16 + r) * 256 + h * 64 + dk];
    const float bav = p.gla_ba[d * 256 + h * 64 + dk];
    float run = 0.f;
    for (int ti = 0; ti < 16; ++ti) { const int t = tg * 16 + (d ? 15 - ti : ti); const float* lrp = LR + (R0 + t) * 32 + d * 16; float z = bav;
#pragma unroll
        for (int r = 0; r < 16; ++r) z += lrp[r] * wv[r];
        const float ls = fminf(z, 0.f) - __logf(1.f + __expf(-fabsf(z))); run += ls * (1.f / 16.f); gs[t * 64 + dk] = run; }
    part[tg * 64 + dk] = run;
    __syncthreads();
    float off = 0.f;
#pragma unroll
    for (int g = 0; g < 4; ++g) { const float pv = part[g * 64 + dk]; off += (d == 0 ? (g < tg) : (g > tg)) ? pv : 0.f; }
#pragma unroll
    for (int ti = 0; ti < 16; ++ti) gs[(tg * 16 + ti) * 64 + dk] += off;
    __syncthreads();
}
__device__ __forceinline__ void gla_load_vt(bf16_t* VTs, const bf16_t* __restrict__ Gv, size_t R0, int h) {
    const int tid = VT, t = tid >> 2, vq = (tid & 3) * 32; const bf16_t* src = Gv + (R0 + t) * 512 + h * 128 + vq;
#pragma unroll
    for (int q = 0; q < 4; ++q) { const u32x4 v = *(const u32x4*)(src + q * 8);
#pragma unroll
        for (int e = 0; e < 4; ++e) { VTs[(vq + q * 8 + 2 * e) * 72 + t] = (bf16_t)(v[e] & 0xffffu); VTs[(vq + q * 8 + 2 * e + 1) * 72 + t] = (bf16_t)(v[e] >> 16); } }
}
__device__ __forceinline__ void phase_gla1(const Params& p, char* smem) {
    unsigned char* ws = p.ws;
    const bf16_t* Gk = (const bf16_t*)(ws + R1_GK); const bf16_t* Gv = (const bf16_t*)(ws + R1_GV); const float* LR = (const float*)(ws + R1_LR);
    float* UC = (float*)(ws + R1_UC); float* DEC = (float*)(ws + R1_DEC);
    float* gs = (float*)smem; bf16_t* KD = (bf16_t*)(smem + 16384); bf16_t* VTs = KD + 64 * 72; float* part = (float*)(smem + 71680);
    const int tid = VT, lane = tid & 63, w = tid >> 6, lr = lane & 15, lq = lane >> 4;
    for (int it = VB; it < 2112; it += NVB) {
        const int tc = it % 132, h = (it / 132) & 3, d = (it / 528) & 1, b = it / 1056;
        const size_t R0 = (size_t)b * PP + tc * 64;
        __syncthreads();
        gla_gates(p, gs, part, LR, R0, d, h);
        const int tl = d ? 0 : 63;
        { const int t = tid >> 2, dq = (tid & 3) * 16; const bf16_t* src = Gk + (R0 + t) * 256 + h * 64 + dq;
#pragma unroll
            for (int q = 0; q < 2; ++q) { const u32x4 v = *(const u32x4*)(src + q * 8);
#pragma unroll
                for (int e = 0; e < 4; ++e) { const int dk0 = dq + q * 8 + 2 * e;
                    const float k0 = bflo(v[e]) * __expf(gs[tl * 64 + dk0] - gs[t * 64 + dk0]); const float k1 = bfhi(v[e]) * __expf(gs[tl * 64 + dk0 + 1] - gs[t * 64 + dk0 + 1]);
                    KD[dk0 * 72 + t] = (bf16_t)f2bf(k0); KD[(dk0 + 1) * 72 + t] = (bf16_t)f2bf(k1); } } }
        gla_load_vt(VTs, Gv, R0, h);
        __syncthreads();
        f32x4 acc[8];
#pragma unroll
        for (int i = 0; i < 8; ++i) acc[i] = (f32x4){0.f, 0.f, 0.f, 0.f};
#pragma unroll
        for (int ks = 0; ks < 2; ++ks) { const bf16x8 a = *(const bf16x8*)(KD + (16 * w + lr) * 72 + ks * 32 + lq * 8);
#pragma unroll
            for (int nt = 0; nt < 8; ++nt) { const bf16x8 bb = *(const bf16x8*)(VTs + (16 * nt + lr) * 72 + ks * 32 + lq * 8); acc[nt] = __builtin_amdgcn_mfma_f32_16x16x32_bf16(a, bb, acc[nt], 0, 0, 0); } }
        const int j = d == 0 ? tc : (tc < 4 ? 3 - tc : 135 - tc);
        const size_t chain = (size_t)((b * 2 + d) * 4 + h);
        float* up = UC + (chain * 132 + j) * 8192;
#pragma unroll
        for (int nt = 0; nt < 8; ++nt)
#pragma unroll
            for (int e = 0; e < 4; ++e) up[(16 * w + 4 * lq + e) * 128 + 16 * nt + lr] = acc[nt][e];
        if (tid < 64) DEC[(chain * 132 + j) * 64 + tid] = __expf(gs[tl * 64 + tid]);
    }
}
__device__ __forceinline__ void phase_gla2(const Params& p) {
    float* UC = (float*)(p.ws + R1_UC); const float* DEC = (const float*)(p.ws + R1_DEC);
    const int gt = VB * 256 + VT, gn = NVB * 256;
    for (int e = gt; e < 16 * 8192; e += gn) { const int chain = e >> 13, el = e & 8191, dk = el >> 7;
        float* u = UC + (size_t)chain * 132 * 8192 + el; const float* dec = DEC + (size_t)chain * 132 * 64 + dk; float S = 0.f;
#pragma unroll 4
        for (int j = 0; j < 132; ++j) { const float uv = u[(size_t)j * 8192]; const float dv = dec[j * 64]; u[(size_t)j * 8192] = S; S = dv * S + uv; } }
}
__device__ __forceinline__ void phase_gla3(const Params& p, char* smem) {
    unsigned char* ws = p.ws;
    const bf16_t* Gq = (const bf16_t*)(ws + R1_GQ); const bf16_t* Gk = (const bf16_t*)(ws + R1_GK); const bf16_t* Gv = (const bf16_t*)(ws + R1_GV); const bf16_t* Gg = (const bf16_t*)(ws + R1_GG);
    const float* LR = (const float*)(ws + R1_LR); const float* UC = (const float*)(ws + R1_UC); bf16_t* MO = (bf16_t*)(ws + WS_U);
    float* gs = (float*)smem; bf16_t* ATT = (bf16_t*)smem; bf16_t* QI = (bf16_t*)(smem + 16384); bf16_t* KI = QI + 64 * 72; bf16_t* VTs = KI + 64 * 72; bf16_t* SPT = VTs + 128 * 72; float* part = (float*)(smem + 71680);
    const int tid = VT, lane = tid & 63, w = tid >> 6, lr = lane & 15, lq = lane >> 4;
    for (int it = VB; it < 1024; it += NVB) {
        const int tcl = it & 127, h = (it >> 7) & 3, b = it >> 9; const int tc = 4 + tcl;
        const size_t R0 = (size_t)b * PP + tc * 64;
        __syncthreads();
        gla_load_vt(VTs, Gv, R0, h);
        f32x4 acc[8];
#pragma unroll
        for (int i = 0; i < 8; ++i) acc[i] = (f32x4){0.f, 0.f, 0.f, 0.f};
        for (int d = 0; d < 2; ++d) {
            const int j = d == 0 ? tc : 135 - tc; const size_t chain = (size_t)((b * 2 + d) * 4 + h);
            __syncthreads();
            gla_gates(p, gs, part, LR, R0, d, h);
            { const int t = tid >> 2, dq = (tid & 3) * 16; const bf16_t* qs = Gq + (R0 + t) * 256 + h * 64 + dq; const bf16_t* ksrc = Gk + (R0 + t) * 256 + h * 64 + dq;
#pragma unroll
                for (int q = 0; q < 2; ++q) { const u32x4 qv = *(const u32x4*)(qs + q * 8), kv = *(const u32x4*)(ksrc + q * 8); u32x4 qo, ko;
#pragma unroll
                    for (int e = 0; e < 4; ++e) { const int dk0 = dq + q * 8 + 2 * e; const float g0 = gs[t * 64 + dk0], g1 = gs[t * 64 + dk0 + 1];
                        const float e0 = __expf(g0), e1 = __expf(g1);
                        qo[e] = pack2(bflo(qv[e]) * 0.125f * e0, bfhi(qv[e]) * 0.125f * e1); ko[e] = pack2(bflo(kv[e]) / e0, bfhi(kv[e]) / e1); }
                    *(u32x4*)(QI + t * 72 + dq + q * 8) = qo; *(u32x4*)(KI + t * 72 + dq + q * 8) = ko; } }
            { const int dk = tid >> 2, vq = (tid & 3) * 32; const float* sp = UC + (chain * 132 + j) * 8192 + dk * 128 + vq;
#pragma unroll
                for (int q = 0; q < 8; ++q) { const f32x4 v = *(const f32x4*)(sp + q * 4);
#pragma unroll
                    for (int e = 0; e < 4; ++e) SPT[(vq + q * 4 + e) * 72 + dk] = (bf16_t)f2bf(v[e]); } }
            __syncthreads();
            f32x4 at[4];
#pragma unroll
            for (int i = 0; i < 4; ++i) at[i] = (f32x4){0.f, 0.f, 0.f, 0.f};
#pragma unroll
            for (int ks = 0; ks < 2; ++ks) { const bf16x8 a = *(const bf16x8*)(QI + (16 * w + lr) * 72 + ks * 32 + lq * 8);
#pragma unroll
                for (int nt = 0; nt < 4; ++nt) { const bf16x8 bb = *(const bf16x8*)(KI + (16 * nt + lr) * 72 + ks * 32 + lq * 8); at[nt] = __builtin_amdgcn_mfma_f32_16x16x32_bf16(a, bb, at[nt], 0, 0, 0); } }
#pragma unroll
            for (int nt = 0; nt < 4; ++nt)
#pragma unroll
                for (int e = 0; e < 4; ++e) { const int t = 16 * w + 4 * lq + e, s = 16 * nt + lr; const bool keep = d == 0 ? (s <= t) : (s >= t); ATT[t * 72 + s] = (bf16_t)f2bf(keep ? at[nt][e] : 0.f); }
            __syncthreads();
#pragma unroll
            for (int ks = 0; ks < 2; ++ks) { const bf16x8 a1 = *(const bf16x8*)(ATT + (16 * w + lr) * 72 + ks * 32 + lq * 8); const bf16x8 a2 = *(const bf16x8*)(QI + (16 * w + lr) * 72 + ks * 32 + lq * 8);
#pragma unroll
                for (int nt = 0; nt < 8; ++nt) { const bf16x8 b1 = *(const bf16x8*)(VTs + (16 * nt + lr) * 72 + ks * 32 + lq * 8); const bf16x8 b2 = *(const bf16x8*)(SPT + (16 * nt + lr) * 72 + ks * 32 + lq * 8);
                    acc[nt] = __builtin_amdgcn_mfma_f32_16x16x32_bf16(a1, b1, acc[nt], 0, 0, 0); acc[nt] = __builtin_amdgcn_mfma_f32_16x16x32_bf16(a2, b2, acc[nt], 0, 0, 0); } }
        }
#pragma unroll
        for (int e = 0; e < 4; ++e) { float ss = 0.f;
#pragma unroll
            for (int nt = 0; nt < 8; ++nt) ss += acc[nt][e] * acc[nt][e];
            ss += __shfl_xor(ss, 1); ss += __shfl_xor(ss, 2); ss += __shfl_xor(ss, 4); ss += __shfl_xor(ss, 8);
            const float rstd = rsqrtf(ss * (1.f / 128.f) + EPS); const size_t R = R0 + 16 * w + 4 * lq + e;
#pragma unroll
            for (int nt = 0; nt < 8; ++nt) { const int v = 16 * nt + lr; const float y = acc[nt][e] * rstd * p.gla_norm_w[v] * bf2f(Gg[R * 512 + h * 128 + v]); MO[R * 1024 + h * 128 + v] = (bf16_t)f2bf(y); } }
    }
}
__device__ __forceinline__ void phase_gqa(const Params& p, char* smem) {
    unsigned char* ws = p.ws;
    const bf16_t* Qg = (const bf16_t*)(ws + R1_QG); const bf16_t* Kg = (const bf16_t*)(ws + R1_KG); const bf16_t* VTg = (const bf16_t*)(ws + R1_VTG); bf16_t* MO = (bf16_t*)(ws + WS_U);
    for (int u = blockIdx.x; u < 512; u += gridDim.x) { const int b = u >> 8, hq = (u >> 5) & 7, qb = u & 31, kvh = hq >> 2;
        const size_t Rq = (size_t)b * PP + 256 + qb * 256;
        attn_unit(smem, Qg + Rq * 512 + hq * 64, 512, Kg + (size_t)b * PP * 128 + kvh * 64, 128, VTg + (size_t)((b * 2 + kvh) * 64) * PP, MO + Rq * 1024 + 512 + hq * 64, 1024, 132, 0, 0, 0, nullptr); }
}

#define XB_TMO      128
#define XB_XCNT(j)  (256  + 64 * (j))
#define XB_XSUB(j)  (1280 + 64 * (j))
#define XB_XGEN(j)  (2304 + 64 * (j))
#define XB_TOP      3328
#define XB_TOPGEN   3392
#define XCD_BAR_WORDS 3456
#define XB_SPIN_CAP (1u << 20)
#define LAS __attribute__((address_space(3)))
__device__ __forceinline__ unsigned xb_ld(unsigned* p)              { return __hip_atomic_load(p, __ATOMIC_RELAXED, __HIP_MEMORY_SCOPE_AGENT); }
__device__ __forceinline__ unsigned xb_add(unsigned* p, unsigned v) { return __hip_atomic_fetch_add(p, v, __ATOMIC_RELAXED, __HIP_MEMORY_SCOPE_AGENT); }
__device__ __forceinline__ unsigned xb_xcc_id() { return (unsigned)__builtin_amdgcn_s_getreg((3 << 11) | 20) & 0xFu; }
#define XB_SPIN(cond, bar) do { unsigned _sp = 0; while (cond) { __builtin_amdgcn_s_sleep(1); \
    if ((++_sp & 255u) == 0u) { if (xb_ld(&(bar)[XB_TMO])) break; if (_sp > XB_SPIN_CAP) { atomicAdd(&(bar)[XB_TMO], 1u); break; } } } } while (0)
struct XcdBarrier { unsigned* bar; unsigned x; volatile LAS unsigned* st; };
__device__ __forceinline__ XcdBarrier xcd_barrier_post(unsigned* bar, volatile LAS unsigned* st) {
    XcdBarrier b; b.bar = bar; b.x = xb_xcc_id(); b.st = st;
    if (threadIdx.x == 0) (void)xb_add(&bar[XB_XCNT(b.x)], 1u);
    return b;
}
__device__ __forceinline__ void xcd_barrier_complete(unsigned* bar, unsigned x, unsigned& nloc, unsigned& nx) {
    const unsigned G = gridDim.x * gridDim.y * gridDim.z;
    unsigned sum, cnt, mine, sp = 0u;
    for (;;) {
        sum = 0u; cnt = 0u; mine = 0u;
#pragma unroll
        for (unsigned j = 0; j < 16; ++j) { const unsigned c = xb_ld(&bar[XB_XCNT(j)]); sum += c; cnt += (c > 0u) ? 1u : 0u; mine = (j == x) ? c : mine; }
        if (sum == G) break;
        __builtin_amdgcn_s_sleep(1);
        if ((++sp & 255u) == 0u) { if (xb_ld(&bar[XB_TMO])) break; if (sp > XB_SPIN_CAP) { atomicAdd(&bar[XB_TMO], 1u); break; } }
    }
    nloc = mine > 0u ? mine : 1u; nx = cnt > 0u ? cnt : 1u;
}
__device__ __forceinline__ void xcd_barrier(const XcdBarrier& b) {
    asm volatile("s_waitcnt vmcnt(0)" ::: "memory");
    __syncthreads();
    if (threadIdx.x == 0) {
        unsigned* bar = b.bar;
        __builtin_amdgcn_s_waitcnt(0);
        unsigned nloc = b.st[0], nx = b.st[1];
        if (nloc == 0u) { xcd_barrier_complete(bar, b.x, nloc, nx); b.st[0] = nloc; b.st[1] = nx; }
        const unsigned old = xb_add(&bar[XB_XSUB(b.x)], 1u);
        const unsigned gen = old / nloc;
        if (old + 1u == (gen + 1u) * nloc) {
            __builtin_amdgcn_fence(__ATOMIC_RELEASE, "agent");
            asm volatile("s_waitcnt vmcnt(0)" ::: "memory");
            const unsigned og = xb_add(&bar[XB_TOP], 1u);
            const unsigned tg = og / nx;
            if (og + 1u == (tg + 1u) * nx) xb_add(&bar[XB_TOPGEN], 1u);
            else XB_SPIN(xb_ld(&bar[XB_TOPGEN]) == tg, bar);
            __builtin_amdgcn_fence(__ATOMIC_ACQUIRE, "agent");
            xb_add(&bar[XB_XGEN(b.x)], 1u);
            asm volatile("s_waitcnt vmcnt(0)" ::: "memory");
        } else {
            XB_SPIN(xb_ld(&bar[XB_XGEN(b.x)]) == gen, bar);
            __builtin_amdgcn_fence(__ATOMIC_ACQUIRE, "agent");
            asm volatile("s_waitcnt vmcnt(0)" ::: "memory");
        }
    }
    __syncthreads();
}


namespace pg8 {
#define PG8_LAS __attribute__((address_space(3)))
typedef unsigned short bf16_t;
typedef short bf16x8 __attribute__((ext_vector_type(8)));
typedef float f32x4 __attribute__((ext_vector_type(4)));
typedef unsigned u32x4 __attribute__((ext_vector_type(4)));
constexpr int BM = 256, BK = 64, HALF = 128, HTB = HALF * BK * 2  , STAGE_BYTES = 8 * HTB, NXCD = 8, WGM = 8;

__host__ __device__ __forceinline__ int lds_byte(int r, int c) { const int st = (r >> 4) * 2 + (c >> 5), rr = r & 15, cc = c & 31, ob = rr * 64 + cc * 2; return st * 1024 + (ob ^ (((ob >> 9) & 1) << 5)); }
__host__ __device__ __forceinline__ void stage_rc(int b, int& R, int& C) { const int st = b / 1024, sb = b % 1024, swz = sb ^ (((sb >> 9) & 1) << 5); R = (st >> 1) * 16 + swz / 64; C = (st & 1) * 32 + (swz % 64) / 2; }
__host__ __device__ __forceinline__ int perm32(int rho) { const int n = rho >> 4, i = rho & 15; return 8 * (i >> 2) + 4 * n + (i & 3); }

struct Unit { int pm, pn, ks; };
struct Gemm { const bf16_t* A; const bf16_t* Bt; int M, N, K, Kloop; };

struct StaticOrder {
    int nM, nN, nwg, G, c;
    __host__ __device__ void init(int M, int N, int G_, int c_) { nM = M / BM; nN = N / BM; nwg = nM * nN; G = G_; c = c_; }
    __host__ __device__ bool next(int i, Unit& u) const {
        const long L = (long)i * G + c; if (L >= nwg) return false;
        int wgid = (int)L; { const int q = nwg / NXCD, r = nwg % NXCD, xcd = wgid % NXCD, off = wgid / NXCD; wgid = (xcd < r ? xcd * (q + 1) : r * (q + 1) + (xcd - r) * q) + off; }
        const int nig = WGM * nN, gid = wgid / nig, fm = gid * WGM, gsz = (nM - fm) < WGM ? (nM - fm) : WGM;
        u.pm = fm + ((wgid % nig) % gsz); u.pn = (wgid % nig) / gsz; u.ks = 0; return true;
    }
    __device__ __forceinline__ void a_ready(const Unit&) const {}
    __device__ __forceinline__ void done(const Unit&) const {}
};
template <class Epi, class Sched, bool ALIGN_EPI = false, bool SP2 = false>
__device__ __forceinline__ void gemm_phase(PG8_LAS unsigned char* lds, const Gemm g, const Sched& S, const Epi& E) {
    int tid_ = threadIdx.x; asm volatile("" : "+v"(tid_));
    const int tid = tid_, wid = __builtin_amdgcn_readfirstlane(tid >> 6), lane = tid & 63, wr = wid >> 2, wc = wid & 3, fr = lane & 15, fq = lane >> 4;
    const int K = g.K, nt = g.Kloop / BK; const size_t kslice = (size_t)g.Kloop * 2;
    unsigned voffA[2], voffB[2];
#pragma unroll
    for (int i = 0; i < 2; ++i) { int R, C; stage_rc(tid * 16 + i * 8192, R, C); const int Rb = Epi::PERM ? ((R & ~31) + perm32(R & 31)) : R;
        voffA[i] = (unsigned)(R * K + C) * 2u; voffB[i] = (unsigned)(Rb * K + C) * 2u; }
    const size_t kstep = (size_t)(BK * 2);
    const size_t hstep = (size_t)HALF * K * 2;
    const size_t tstep = 2 * hstep;
    const unsigned ldsw = (unsigned)wid * 1024u;
    const int aoff = lds_byte(wr * 64 + fr, fq * 8), boff = lds_byte(wc * 32 + fr, fq * 8);
#define PG8_SA(b, h) (((b) * 2 + (h)) * HTB)
#define PG8_SB(b, h) ((4 + (b) * 2 + (h)) * HTB)
#define PG8_STAGE(bufoff, gbase, voff) do { _Pragma("unroll") for (int _i = 0; _i < 2; ++_i) \
        __builtin_amdgcn_global_load_lds((const unsigned*)((const char*)(gbase) + (voff)[_i]), (PG8_LAS unsigned*)(lds + (bufoff) + ldsw + _i * 8192), 16, 0, 0); } while (0)
#define PG8_LDA(dst, b, h) do { _Pragma("unroll") for (int m = 0; m < 4; ++m) _Pragma("unroll") for (int k = 0; k < 2; ++k) dst[m][k] = *(const PG8_LAS bf16x8*)(lds + PG8_SA(b, h) + aoff + m * 2048 + k * 1024); } while (0)
#define PG8_LDB(dst, b, h) do { _Pragma("unroll") for (int n = 0; n < 2; ++n) _Pragma("unroll") for (int k = 0; k < 2; ++k) dst[n][k] = *(const PG8_LAS bf16x8*)(lds + PG8_SB(b, h) + boff + n * 2048 + k * 1024); } while (0)
#define PG8_MMA(ai, bj, At, Bt) do { __builtin_amdgcn_s_setprio(1); _Pragma("unroll") for (int m = 0; m < 4; ++m) _Pragma("unroll") for (int n = 0; n < 2; ++n) _Pragma("unroll") for (int k = 0; k < 2; ++k) \
        acc[ai][bj][m][n] = __builtin_amdgcn_mfma_f32_16x16x32_bf16(Bt[n][k], At[m][k], acc[ai][bj][m][n], 0, 0, 0); __builtin_amdgcn_s_setprio(0); } while (0)
#define PG8_WAIT_V(n) asm volatile("s_waitcnt vmcnt(" #n ")" ::: "memory")
#define PG8_WAIT_L(n) asm volatile("s_waitcnt lgkmcnt(" #n ")" ::: "memory")
#define PG8_BAR __builtin_amdgcn_s_barrier()
#define PG8_SCHED __builtin_amdgcn_sched_barrier(0)
    Unit cur, nxt; int ui = 0;
    if (!S.next(0, cur)) return;
    f32x4 acc[2][2][4][2];
#pragma unroll
    for (int a = 0; a < 2; ++a)
#pragma unroll
        for (int b = 0; b < 2; ++b)
#pragma unroll
            for (int m = 0; m < 4; ++m)
#pragma unroll
                for (int n = 0; n < 2; ++n) acc[a][b][m][n] = (f32x4){0.f, 0.f, 0.f, 0.f};
    bf16x8 At[4][2], B0[2][2], B1[2][2];
    const char* cA = (const char*)g.A + (size_t)cur.pm * tstep + (size_t)cur.ks * kslice; const char* cB = (const char*)g.Bt + (size_t)cur.pn * tstep + (size_t)cur.ks * kslice;
    S.a_ready(cur);
    if constexpr (SP2) {
        PG8_STAGE(PG8_SB(0, 0), cB, voffB); PG8_STAGE(PG8_SB(0, 1), cB + hstep, voffB); PG8_STAGE(PG8_SA(0, 0), cA, voffA); PG8_STAGE(PG8_SA(0, 1), cA + hstep, voffA);
        if (wr == 1) PG8_BAR;
        PG8_WAIT_V(2); PG8_BAR;
        PG8_STAGE(PG8_SB(1, 0), cB + kstep, voffB); PG8_STAGE(PG8_SA(1, 0), cA + kstep, voffA); PG8_STAGE(PG8_SB(1, 1), cB + hstep + kstep, voffB);
        PG8_WAIT_V(6); PG8_BAR;
    } else {
        PG8_STAGE(PG8_SB(0, 0), cB, voffB); PG8_STAGE(PG8_SA(0, 0), cA, voffA); PG8_STAGE(PG8_SB(0, 1), cB + hstep, voffB); PG8_STAGE(PG8_SA(0, 1), cA + hstep, voffA);
        if (wr == 1) PG8_BAR;
        PG8_WAIT_V(4); PG8_BAR;
        PG8_STAGE(PG8_SB(1, 0), cB + kstep, voffB); PG8_STAGE(PG8_SA(1, 0), cA + kstep, voffA); PG8_STAGE(PG8_SB(1, 1), cB + hstep + kstep, voffB);
        PG8_WAIT_V(6); PG8_BAR;
    }
    for (;;) {
        const bool has_next = S.next(ui + 1, nxt);
        const char* nA = has_next ? (const char*)g.A + (size_t)nxt.pm * tstep + (size_t)nxt.ks * kslice : cA; const char* nB = has_next ? (const char*)g.Bt + (size_t)nxt.pn * tstep + (size_t)nxt.ks * kslice : cB;
        for (int t = 0; t < nt; t += 2) {
            const bool last = (t == nt - 2);
            const char* a1 = cA + (size_t)(t + 1) * kstep;
            const char* a2 = last ? nA : cA + (size_t)(t + 2) * kstep; const char* b2 = last ? nB : cB + (size_t)(t + 2) * kstep;
            const char* a3 = a2 + kstep; const char* b3 = b2 + kstep;
            if (last && has_next) S.a_ready(nxt);
            if constexpr (SP2) {
            PG8_LDB(B0, 0, 0); PG8_LDB(B1, 0, 1); PG8_SCHED; PG8_LDA(At, 0, 0); PG8_STAGE(PG8_SA(1, 1), a1 + hstep, voffA);
            PG8_WAIT_V(8); PG8_WAIT_L(0); PG8_BAR; PG8_MMA(0, 0, At, B0); PG8_MMA(0, 1, At, B1); PG8_BAR; PG8_SCHED;
            PG8_LDA(At, 0, 1); PG8_STAGE(PG8_SB(0, 0), b2, voffB); PG8_STAGE(PG8_SB(0, 1), b2 + hstep, voffB); PG8_STAGE(PG8_SA(0, 0), a2, voffA);
            PG8_WAIT_V(8); PG8_WAIT_L(0); PG8_BAR; PG8_MMA(1, 0, At, B0); PG8_MMA(1, 1, At, B1); PG8_BAR; PG8_SCHED;
            PG8_LDB(B0, 1, 0); PG8_LDB(B1, 1, 1); PG8_SCHED; PG8_LDA(At, 1, 0); PG8_STAGE(PG8_SA(0, 1), a2 + hstep, voffA);
            PG8_WAIT_V(8); PG8_WAIT_L(0); PG8_BAR; PG8_MMA(0, 0, At, B0); PG8_MMA(0, 1, At, B1); PG8_BAR; PG8_SCHED;
            PG8_LDA(At, 1, 1); PG8_STAGE(PG8_SB(1, 0), b3, voffB); PG8_STAGE(PG8_SB(1, 1), b3 + hstep, voffB); PG8_STAGE(PG8_SA(1, 0), a3, voffA);
            PG8_WAIT_V(8); PG8_WAIT_L(0); PG8_BAR; PG8_MMA(1, 0, At, B0); PG8_MMA(1, 1, At, B1); PG8_BAR; PG8_SCHED;
            } else {
            PG8_LDB(B0, 0, 0); PG8_SCHED; PG8_LDA(At, 0, 0); PG8_STAGE(PG8_SA(1, 1), a1 + hstep, voffA);
            PG8_WAIT_L(8); PG8_BAR; PG8_WAIT_L(0); PG8_MMA(0, 0, At, B0); PG8_BAR; PG8_SCHED;
            PG8_LDB(B1, 0, 1); PG8_STAGE(PG8_SB(0, 0), b2, voffB);
            PG8_BAR; PG8_WAIT_L(0); PG8_MMA(0, 1, At, B1); PG8_BAR;
            PG8_LDA(At, 0, 1); PG8_STAGE(PG8_SA(0, 0), a2, voffA);
            PG8_BAR; PG8_WAIT_L(0); PG8_MMA(1, 0, At, B0); PG8_BAR; PG8_SCHED;
            PG8_STAGE(PG8_SB(0, 1), b2 + hstep, voffB);
            PG8_WAIT_V(6); PG8_BAR; PG8_MMA(1, 1, At, B1); PG8_BAR;
            PG8_LDB(B0, 1, 0); PG8_SCHED; PG8_LDA(At, 1, 0); PG8_STAGE(PG8_SA(0, 1), a2 + hstep, voffA);
            PG8_WAIT_L(8); PG8_BAR; PG8_WAIT_L(0); PG8_MMA(0, 0, At, B0); PG8_BAR; PG8_SCHED;
            PG8_LDB(B1, 1, 1); PG8_STAGE(PG8_SB(1, 0), b3, voffB);
            PG8_BAR; PG8_WAIT_L(0); PG8_MMA(0, 1, At, B1); PG8_BAR;
            PG8_LDA(At, 1, 1); PG8_STAGE(PG8_SA(1, 0), a3, voffA);
            PG8_BAR; PG8_WAIT_L(0); PG8_MMA(1, 0, At, B0); PG8_BAR; PG8_SCHED;
            PG8_STAGE(PG8_SB(1, 1), b3 + hstep, voffB);
            PG8_WAIT_V(6); PG8_BAR; PG8_MMA(1, 1, At, B1); PG8_BAR;
            }
        }
        if constexpr (ALIGN_EPI) { if (wr == 0) PG8_BAR; }
        if constexpr (!Epi::AFTER_DRAIN) { E(acc, cur, wr, wc, fr, fq); S.done(cur); }
        if (!has_next) break;
#pragma unroll
        for (int a = 0; a < 2; ++a)
#pragma unroll
            for (int b = 0; b < 2; ++b)
#pragma unroll
                for (int m = 0; m < 4; ++m)
#pragma unroll
                    for (int n = 0; n < 2; ++n) acc[a][b][m][n] = (f32x4){0.f, 0.f, 0.f, 0.f};
        cur = nxt; cA = nA; cB = nB; ++ui;
        if constexpr (ALIGN_EPI) { if (wr == 1) PG8_BAR; }
    }
    PG8_WAIT_V(0);
    if constexpr (!ALIGN_EPI) { if (wr == 0) PG8_BAR; }
    PG8_BAR;
    if constexpr (Epi::AFTER_DRAIN) { E.fused(acc, cur, wr, wc, fr, fq, lds, wid, lane); S.done(cur); }
#undef PG8_SA
#undef PG8_SB
#undef PG8_STAGE
#undef PG8_LDA
#undef PG8_LDB
#undef PG8_MMA
#undef PG8_WAIT_V
#undef PG8_WAIT_L
#undef PG8_BAR
#undef PG8_SCHED
}
}

template <class E> struct EpiAdapt {
    static constexpr bool PERM = false, AFTER_DRAIN = false;
    E e;
    __device__ __forceinline__ void operator()(const f32x4 (&acc)[2][2][4][2], const pg8::Unit& u, int wr, int wc, int fr, int fq) const {
        const int lane = fq * 16 + fr;
#pragma unroll
        for (int ai = 0; ai < 2; ++ai) {
            f32x4 a2[4][4];
#pragma unroll
            for (int m = 0; m < 4; ++m)
#pragma unroll
                for (int bj = 0; bj < 2; ++bj)
#pragma unroll
                    for (int n = 0; n < 2; ++n) a2[m][bj * 2 + n] = acc[ai][bj][m][n];
            e(a2, u.pm * 256 + ai * 128 + wr * 64, u.pn * 256 + wc * 64, lane);
        }
    }
};
struct LatentOrder {
    pg8::StaticOrder S;
    __device__ void init(int N, int G, int c) { S.init(64 * 256, N, G, c); }
    __device__ bool next(int i, pg8::Unit& u) const { if (!S.next(i, u)) return false; u.pm = u.pm + 1 + (u.pm >= 32 ? 1 : 0); return true; }
    __device__ __forceinline__ void a_ready(const pg8::Unit&) const {}
    __device__ __forceinline__ void done(const pg8::Unit&) const {}
};
template <class E> __device__ __forceinline__ void gemm256(char* smem_all, const bf16_t* A, const bf16_t* WT, int N, int K, bool latent_only, const E& e) {
    PG8_LAS unsigned char* lds = (PG8_LAS unsigned char*)smem_all;
    pg8::Gemm g{A, WT, NR, N, K, K};
    EpiAdapt<E> ea{e};
    if (latent_only) { LatentOrder S; S.init(N, (int)gridDim.x, (int)blockIdx.x); pg8::gemm_phase<EpiAdapt<E>, LatentOrder, true, true>(lds, g, S, ea); }
    else { pg8::StaticOrder S; S.init(NR, N, (int)gridDim.x, (int)blockIdx.x); pg8::gemm_phase<EpiAdapt<E>, pg8::StaticOrder, true, true>(lds, g, S, ea); }
}
struct CtxSplitOrder {
    int nN, nsplit, total, G, c;
    __device__ void init(int N, int nsplit_, int G_, int c_) { nN = N / 256; nsplit = nsplit_; total = 2 * nN * nsplit; G = G_; c = c_; }
    __device__ bool next(int i, pg8::Unit& u) const { const int L = i * G + c; if (L >= total) return false; u.ks = L % nsplit; const int q = L / nsplit; u.pn = q % nN; u.pm = (q / nN) ? 33 : 0; return true; }
    __device__ __forceinline__ void a_ready(const pg8::Unit&) const {}
    __device__ __forceinline__ void done(const pg8::Unit&) const {}
};
struct EpiPartial {
    static constexpr bool PERM = false, AFTER_DRAIN = false;
    float* P; int N;
    __device__ __forceinline__ void operator()(const f32x4 (&acc)[2][2][4][2], const pg8::Unit& u, int wr, int wc, int fr, int fq) const {
        float* base = P + ((size_t)u.ks * 512 + (u.pm ? 256 : 0)) * N + u.pn * 256 + wc * 64;
#pragma unroll
        for (int ai = 0; ai < 2; ++ai)
#pragma unroll
            for (int m = 0; m < 4; ++m) { float* rowp = base + (size_t)(ai * 128 + wr * 64 + m * 16 + fr) * N;
#pragma unroll
                for (int bj = 0; bj < 2; ++bj)
#pragma unroll
                    for (int n = 0; n < 2; ++n) *(f32x4*)(rowp + (bj * 2 + n) * 16 + fq * 4) = acc[ai][bj][m][n]; }
    }
};
__device__ __forceinline__ void gemm256_ctx_splitk(char* smem_all, const bf16_t* A, const bf16_t* WT, int N, int K, int nsplit, float* P) {
    PG8_LAS unsigned char* lds = (PG8_LAS unsigned char*)smem_all;
    pg8::Gemm g{A, WT, NR, N, K, K / nsplit};
    EpiPartial ep{P, N};
    CtxSplitOrder S; S.init(N, nsplit, (int)gridDim.x, (int)blockIdx.x);
    pg8::gemm_phase<EpiPartial, CtxSplitOrder, true, true>(lds, g, S, ep);
}

template <int ph> __device__ __forceinline__ void run_phase(const Params& p, char* smem_all) {
    char* smem = smem_all + (threadIdx.x >> 8) * HALF_LDS;
    unsigned char* ws = p.ws;
    float* MOD = (float*)(ws + WS_MOD); float* Hc = (float*)(ws + WS_HC); float* Hl = p.out; bf16_t* U = (bf16_t*)(ws + WS_U);
    if constexpr (ph == 0) { phase_prologue(p, smem); }
    if constexpr (ph == 1) { phase_ln(p.x, p.ctx, p.norm1_w, MOD, 0, 1, false, U); }
    if constexpr (ph == 2) { { EpiInEven e{(bf16_t*)(ws + R0_Q), (bf16_t*)(ws + R0_K), (bf16_t*)(ws + R0_VT), (bf16_t*)(ws + R0_XL), (bf16_t*)(ws + R0_GG)};
        gemm256(smem_all, U, (const bf16_t*)(ws + WS_WINE), 2560, 1024, false, e); } }
    if constexpr (ph == 3) { phase_na(p, smem_all); }
    if constexpr (ph == 4) { { EpiLru e{(const bf16_t*)(ws + R0_XC), (__half2*)(ws + R0_AB), p.lru_ba, p.lru_bx, (const float*)(ws + WS_SP)};
        gemm128_phase(smem, (const bf16_t*)(ws + R0_XC), 512, (const bf16_t*)(ws + WS_WLRU), 64, 132, 16, 0, 1, e); } }
    if constexpr (ph == 5) { phase_scan1(p); }
    if constexpr (ph == 6) { phase_scan2(p); }
    if constexpr (ph == 7) { { EpiResid e{p.x, p.ctx, Hl, Hc, MOD, 2}; gemm256(smem_all, U, (const bf16_t*)(ws + WS_WOUTE), 1024, 1024, true, e);
        gemm256_ctx_splitk(smem_all, U, (const bf16_t*)(ws + WS_WOUTE), 1024, 1024, 4, (float*)(ws + WS_P1)); } }
    if constexpr (ph == 8) { phase_ln(Hl, p.ctx, p.norm2_w, MOD, 3, 4, false, U, (const float*)(ws + WS_P1), 4, MOD + 2 * 6144 + 2 * 1024, Hc); }
    if constexpr (ph == 9) { { EpiFF1 e{(bf16_t*)(ws + R_FF)}; gemm256(smem_all, U, (const bf16_t*)(ws + WS_WFF1), 4096, 1024, false, e); } }
    if constexpr (ph == 10) { { EpiResid e{Hl, Hc, Hl, Hc, MOD, 5}; gemm256(smem_all, (const bf16_t*)(ws + R_FF), (const bf16_t*)(ws + WS_WFF2), 1024, 4096, true, e);
        gemm256_ctx_splitk(smem_all, (const bf16_t*)(ws + R_FF), (const bf16_t*)(ws + WS_WFF2), 1024, 4096, 16, (float*)(ws + WS_P2)); } }
    if constexpr (ph == 11) { phase_ln(Hl, Hc, p.norm1_w + 1024, MOD + 3 * 6144, 0, 1, false, U, (const float*)(ws + WS_P2), 16, MOD + 2 * 6144 + 5 * 1024, nullptr); }
    if constexpr (ph == 12) { { EpiInOdd e{(bf16_t*)(ws + R1_GQ), (bf16_t*)(ws + R1_GK), (bf16_t*)(ws + R1_GV), (bf16_t*)(ws + R1_GG), (bf16_t*)(ws + R1_QG), (bf16_t*)(ws + R1_KG), (bf16_t*)(ws + R1_VTG),
                          (float*)(ws + R1_LR), p.gqa_q_norm_w, p.gqa_k_norm_w, (const float2*)(ws + WS_ROPE)};
        gemm256(smem_all, U, (const bf16_t*)(ws + WS_WINO), 2560, 1024, false, e); } }
    if constexpr (ph == 13) { phase_gla1(p, smem); }
    if constexpr (ph == 14) { phase_gla2(p); phase_gqa(p, smem_all); if constexpr ((REPMASK >> 21) & 1) phase_gqa(p, smem_all); }
    if constexpr (ph == 15) { phase_gla3(p, smem); }
    if constexpr (ph == 16) { { EpiResid e{Hl, Hc, Hl, Hc, MOD + 3 * 6144, 2}; gemm256(smem_all, U, (const bf16_t*)(ws + WS_WOUTO), 1024, 1024, true, e); } }
    if constexpr (ph == 17) { phase_ln(Hl, Hc, p.norm2_w + 1024, MOD + 3 * 6144, 3, 4, true, U); }
    if constexpr (ph == 18) { { EpiFF1 e{(bf16_t*)(ws + R_FF)}; gemm256(smem_all, U, (const bf16_t*)(ws + WS_WFF1) + (size_t)4096 * 1024, 4096, 1024, true, e); } }
    if constexpr (ph == 19) { { EpiResid e{Hl, Hc, Hl, Hc, MOD + 3 * 6144, 5}; gemm256(smem_all, (const bf16_t*)(ws + R_FF), (const bf16_t*)(ws + WS_WFF2) + (size_t)4096 * 1024, 1024, 4096, true, e); } }
    if constexpr (ph == 20) { phase_final(p.final_norm_w, Hl); }
}

#if MEGA
template <int PH> __device__ __forceinline__ void run_all(const Params& p, char* smem, cg::grid_group& grid, const XcdBarrier& xb) {
    if constexpr (PH < NPHASE) {
        run_phase<PH>(p, smem);
        if constexpr ((REPMASK >> PH) & 1) { xcd_barrier(xb); run_phase<PH>(p, smem); }
        if constexpr (PH + 1 < NPHASE) { if constexpr (PH == 0) grid.sync(); else xcd_barrier(xb); }
        run_all<PH + 1>(p, smem, grid, xb);
    }
}
__global__ void __launch_bounds__(512, 2) hybrid_fwd(Params p) {
    extern __shared__ __attribute__((aligned(16))) char smem[];
    __shared__ uint4 xb_words;
    cg::grid_group grid = cg::this_grid();
    if (threadIdx.x == 0) xb_words = make_uint4(0u, 0u, 0u, 0u);
    __syncthreads();
    const XcdBarrier xb = xcd_barrier_post((unsigned*)(p.ws + WS_BAR), (volatile LAS unsigned*)&xb_words);
    run_all<0>(p, smem, grid, xb);
}
#else
template <int PH> __global__ void __launch_bounds__(512, 2) phase_k(Params p) {
    extern __shared__ __attribute__((aligned(16))) char smem[];
    run_phase<PH>(p, smem);
}
template <int PH> static bool setup_all() {
    if constexpr (PH < NPHASE) { if (hipFuncSetAttribute((const void*)phase_k<PH>, hipFuncAttributeMaxDynamicSharedMemorySize, LDS_BYTES) != hipSuccess) return false; return setup_all<PH + 1>(); }
    else return true;
}
template <int PH> static void launch_all(const Params& p, int grid, hipStream_t stream) {
    if constexpr (PH < NPHASE) { hipLaunchKernelGGL(phase_k<PH>, dim3(grid), dim3(512), LDS_BYTES, stream, p); launch_all<PH + 1>(p, grid, stream); }
}
#endif

extern "C" void kernel_launch(void* const* d_in, const int* in_sizes, int n_in, void* d_out, int out_size, void* d_ws, size_t ws_size, hipStream_t stream) {
    static int grid_blocks = 0;
    if (grid_blocks == 0) {
        if (n_in != 28 || out_size != NB * SEQ * DM || ws_size < WS_NEED) { fprintf(stderr, "kernel_launch: unexpected shapes (n_in %d out %d ws %zu need %zu)\n", n_in, out_size, ws_size, (size_t)WS_NEED); grid_blocks = -1; return; }
        int dev = 0, cus = 0, per_cu = 0;
        if (hipGetDevice(&dev) != hipSuccess || hipDeviceGetAttribute(&cus, hipDeviceAttributeMultiprocessorCount, dev) != hipSuccess) { grid_blocks = -1; return; }
#if MEGA
        if (hipFuncSetAttribute((const void*)hybrid_fwd, hipFuncAttributeMaxDynamicSharedMemorySize, LDS_BYTES) != hipSuccess) { fprintf(stderr, "kernel_launch: hipFuncSetAttribute failed\n"); grid_blocks = -1; return; }
        if (hipOccupancyMaxActiveBlocksPerMultiprocessor(&per_cu, (const void*)hybrid_fwd, 512, LDS_BYTES) != hipSuccess || per_cu < 1) { fprintf(stderr, "kernel_launch: occupancy query failed (%d)\n", per_cu); grid_blocks = -1; return; }
        if (per_cu > 1) per_cu = 1;
#else
        if (!setup_all<0>()) { fprintf(stderr, "kernel_launch: hipFuncSetAttribute failed\n"); grid_blocks = -1; return; }
        per_cu = 1;
#endif
        grid_blocks = cus * per_cu;
    }
    if (grid_blocks < 0) return;
    Params p{};
    const float** pp = (const float**)&p;
    for (int i = 0; i < 28; ++i) pp[i] = (const float*)d_in[i];
    p.out = (float*)d_out; p.ws = (unsigned char*)d_ws;
    p.ph_lo = 0; p.ph_hi = NPHASE;
#if MEGA
    if (hipMemsetAsync((char*)d_ws + WS_BAR, 0, 16384, stream) != hipSuccess) { fprintf(stderr, "kernel_launch: memset failed\n"); return; }
    void* args[] = {&p};
    hipError_t e = hipLaunchCooperativeKernel((const void*)hybrid_fwd, dim3(grid_blocks), dim3(512), args, LDS_BYTES, stream);
    if (e != hipSuccess) fprintf(stderr, "cooperative launch failed: %s (grid %d)\n", hipGetErrorString(e), grid_blocks);
#else
    launch_all<0>(p, grid_blocks, stream);
#endif
}
```
